# Optimizing an MI355X kernel written in HIP

```python
import math
import jax, jax.numpy as jnp
from jax import lax
import numpy as np

D_MODEL = 1024
BATCH = 8
SEQ = 4096
DEPTH = 2

GRID_W = 64
CTX_LEN = 256
EPS = 1e-6

A_HEADS = 4
A_DK = 128
A_DV = 128
A_WIDTH = A_HEADS * A_DK
A_VWIDTH = A_HEADS * A_DV
A_CHUNK = 64

B_GROUPS = 4
B_GDIM = 128
B_WIDTH = B_GROUPS * B_GDIM
B_CHUNK = 128

C_HEADS = 4
C_DH = 64
C_DV = 2 * C_DH
C_QK_WIDTH = C_HEADS * 2 * C_DH
C_WIDTH = C_HEADS * C_DV
Q_BLOCK = 128
ROPE_BASE = 10000.0
ROPE_PAIRS = C_DH // 4

N_BRANCH = 3
BRANCH_WIDTH = 512
IN_SIZES = [A_WIDTH, A_WIDTH, A_WIDTH, A_VWIDTH, A_VWIDTH,
            2 * B_WIDTH,
            C_QK_WIDTH, C_QK_WIDTH, C_WIDTH,
            N_BRANCH * D_MODEL]
IN_COLS = sum(IN_SIZES)

D_FF = 2816
N_EXPERTS = 8
TOP_K = 2
D_FF_E = 3584

kernel_name = "hybrid_dit_hgrn2_gmlp_diffattn_moe"


def rmsnorm(x, g):
    xf = x.astype(jnp.float32)
    y = xf * lax.rsqrt(jnp.mean(xf * xf, axis=-1, keepdims=True) + EPS)
    return (y * g.astype(jnp.float32)).astype(x.dtype)


def adaln(cvec, w, b):
    return jax.nn.silu(cvec) @ w + b


def modulate(hn, shift, scale):
    return hn * (1.0 + scale) + shift


def split_cols(p):
    idx = np.cumsum(IN_SIZES)[:-1].tolist()
    return jnp.split(p, idx, axis=-1)


def to_heads(a, h):
    bsz, n, _ = a.shape
    return a.reshape(bsz, n, h, -1).transpose(0, 2, 1, 3)


def lower_bound(p, layer):
    cs = jnp.cumsum(jax.nn.softmax(p.astype(jnp.float32), axis=0), axis=0)
    return cs[layer] - cs[0]


def forget_gate(z, lb):
    z = z.astype(jnp.float32)
    logf = jnp.logaddexp(jnp.log(lb), jnp.log1p(-lb) + jax.nn.log_sigmoid(z))
    k = (1.0 - lb) * jax.nn.sigmoid(-z)
    return logf, k


def hgrn2_chunk_scan(q, k, v, logf, s0):
    bsz, h, n, dk = q.shape
    dv = v.shape[-1]
    nc = n // A_CHUNK

    def to_chunks(a):
        return jnp.moveaxis(a.astype(jnp.float32).reshape(bsz, h, nc, A_CHUNK, a.shape[-1]), 2, 0)

    mask = jnp.tril(jnp.ones((A_CHUNK, A_CHUNK), dtype=bool))

    def step(S, inp):
        qc, kc, vc, lf = inp
        b = jnp.cumsum(lf, axis=2)
        rel = jnp.where(mask[:, :, None], b[:, :, :, None, :] - b[:, :, None, :, :], -jnp.inf)
        decay = jnp.exp(rel)
        att = jnp.einsum('bhtk,bhsk,bhtsk->bhts', qc, kc, decay)
        o = jnp.einsum('bhts,bhsv->bhtv', att, vc) + jnp.einsum('bhtk,bhkv->bhtv', qc * jnp.exp(b), S)
        b_end = b[:, :, -1:, :]
        S_new = jnp.exp(b_end)[:, :, 0, :, None] * S + jnp.einsum('bhsk,bhsv->bhkv', kc * jnp.exp(b_end - b), vc)
        return S_new, o

    S_fin, o = lax.scan(step, s0, (to_chunks(q), to_chunks(k), to_chunks(v), to_chunks(logf)))
    o = jnp.moveaxis(o, 0, 2).reshape(bsz, h, n, dv)
    return o.astype(v.dtype), S_fin


def hgrn2_direction(q_c, z_c, v_c, q_l, z_l, v_l, lb):
    logf_c, k_c = forget_gate(z_c, lb)
    logf_l, k_l = forget_gate(z_l, lb)
    s0 = jnp.zeros((q_c.shape[0], A_HEADS, A_DK, A_DV), jnp.float32)
    o_c, s_c = hgrn2_chunk_scan(q_c, k_c, v_c, logf_c, s0)
    o_l, _ = hgrn2_chunk_scan(q_l, k_l, v_l, logf_l, s_c)
    return o_c, o_l


def hgrn2_readout(o, og, g):
    bsz, h, n, dv = o.shape
    o = rmsnorm(o.transpose(0, 2, 1, 3), g.reshape(h, dv)).reshape(bsz, n, h * dv)
    return o * jax.nn.silu(og)


def hgrn2_branch(p_l, p_c, lb_f, lb_b, gnorm, with_ctx_out):
    q_l, zf_l, zb_l, v_l, og_l = p_l
    q_c, zf_c, zb_c, v_c, og_c = p_c
    hd = lambda a: to_heads(a, A_HEADS)
    rev = lambda a: jnp.flip(a, axis=2)
    lbf = lb_f.reshape(A_HEADS, 1, A_DK)
    lbb = lb_b.reshape(A_HEADS, 1, A_DK)
    qh_l, vh_l, qh_c, vh_c = hd(q_l), hd(v_l), hd(q_c), hd(v_c)
    of_c, of_l = hgrn2_direction(qh_c, hd(zf_c), vh_c, qh_l, hd(zf_l), vh_l, lbf)
    ob_c, ob_l = hgrn2_direction(rev(qh_c), rev(hd(zb_c)), rev(vh_c), rev(qh_l), rev(hd(zb_l)), rev(vh_l), lbb)
    y_l = hgrn2_readout(of_l + rev(ob_l), og_l, gnorm)
    y_c = hgrn2_readout(of_c + rev(ob_c), og_c, gnorm) if with_ctx_out else None
    return y_l, y_c


def chunk_mlp(uv, vnorm, ws, bs):
    u, v = jnp.split(jax.nn.gelu(uv), 2, axis=-1)
    v = rmsnorm(v, vnorm)
    bsz, n, _ = v.shape
    vc = v.reshape(bsz, n // B_CHUNK, B_CHUNK, B_GROUPS, B_GDIM)
    mixed = jnp.einsum('gts,bcsgd->bctgd', ws, vc) + bs.T[None, None, :, :, None]
    return u * mixed.reshape(bsz, n, B_WIDTH)


def axial_rope_tables(rows):
    t = jnp.arange(rows * GRID_W)
    row = (t // GRID_W).astype(jnp.float32)
    col = (t % GRID_W).astype(jnp.float32)
    freqs = ROPE_BASE ** (-jnp.arange(ROPE_PAIRS, dtype=jnp.float32) / ROPE_PAIRS)
    ang = jnp.stack([row[:, None] * freqs, col[:, None] * freqs], axis=1)
    return jnp.cos(ang), jnp.sin(ang)


def apply_rope(x, cos, sin):
    xs = x.reshape(x.shape[:-1] + (2, 2, ROPE_PAIRS))
    x1, x2 = xs[..., 0, :], xs[..., 1, :]
    c, s = cos.astype(x.dtype), sin.astype(x.dtype)
    out = jnp.stack([x1 * c - x2 * s, x1 * s + x2 * c], axis=-2)
    return out.reshape(x.shape)


def qk_heads(a):
    bsz, n, _ = a.shape
    return a.reshape(bsz, n, C_HEADS, 2, C_DH).transpose(0, 2, 3, 1, 4)


def diff_softmax_attend(q, k, v, lam):
    s = jnp.einsum('bhcqd,bhckd->bhcqk', q.astype(jnp.float32), k.astype(jnp.float32)) * (C_DH ** -0.5)
    p = jax.nn.softmax(s, axis=-1)
    a = p[:, :, 0] - lam * p[:, :, 1]
    return jnp.einsum('bhqk,bhkv->bhqv', a, v.astype(jnp.float32)).astype(v.dtype)


def diff_readout(o, g, lam_init):
    bsz, h, n, dv = o.shape
    o = rmsnorm(o.transpose(0, 2, 1, 3), g.reshape(h, dv)) * (1.0 - lam_init)
    return o.reshape(bsz, n, h * dv)


def diff_attention_branch(p_l, p_c, cos, sin, lam_p, subln, layer, with_ctx_out):
    lam_init = 0.8 - 0.6 * math.exp(-0.3 * layer)
    lam = (jnp.exp(jnp.sum(lam_p[0] * lam_p[1])) - jnp.exp(jnp.sum(lam_p[2] * lam_p[3])) + lam_init).astype(jnp.float32)
    q_l, k_l, v_l = apply_rope(qk_heads(p_l[0]), cos, sin), apply_rope(qk_heads(p_l[1]), cos, sin), to_heads(p_l[2], C_HEADS)
    q_c, k_c, v_c = qk_heads(p_c[0]), qk_heads(p_c[1]), to_heads(p_c[2], C_HEADS)
    k_all = jnp.concatenate([k_l, k_c], axis=3)
    v_all = jnp.concatenate([v_l, v_c], axis=2)
    bsz, h, _, n, dh = q_l.shape
    nb = n // Q_BLOCK
    qb = jnp.moveaxis(q_l.reshape(bsz, h, 2, nb, Q_BLOCK, dh), 3, 0)
    o = lax.map(lambda qblk: diff_softmax_attend(qblk, k_all, v_all, lam), qb)
    o = jnp.moveaxis(o, 0, 2).reshape(bsz, h, n, C_DV)
    y_l = diff_readout(o, subln, lam_init)
    y_c = diff_readout(diff_softmax_attend(q_c, k_c, v_c, lam), subln, lam_init) if with_ctx_out else None
    return y_l, y_c


def merge_branches(ys, gates, w_branch, w_out):
    merged = sum(jax.nn.sigmoid(gates[..., i * D_MODEL:(i + 1) * D_MODEL]) * (ys[i] @ w_branch[i]) for i in range(N_BRANCH))
    return merged @ w_out


def token_mixer(h_l, h_c, layer, cos, sin, w_in_l, hgrn_lb, gnorm_a, vnorm_b, ws_b, bs_b,
                lam_p, subln_c, w_branch_l, w_out_l, with_ctx_out):
    pl = split_cols(h_l @ w_in_l)
    pc = split_cols(h_c @ w_in_l)
    lb_f = lower_bound(hgrn_lb[0], layer)
    lb_b = lower_bound(hgrn_lb[1], layer)
    ya_l, ya_c = hgrn2_branch(pl[0:5], pc[0:5], lb_f, lb_b, gnorm_a, with_ctx_out)
    yb_l = chunk_mlp(pl[5], vnorm_b, ws_b, bs_b)
    yc_l, yc_c = diff_attention_branch(pl[6:9], pc[6:9], cos, sin, lam_p, subln_c, layer, with_ctx_out)
    m_l = merge_branches([ya_l, yb_l, yc_l], pl[9], w_branch_l, w_out_l)
    m_c = None
    if with_ctx_out:
        yb_c = chunk_mlp(pc[5], vnorm_b, ws_b, bs_b)
        m_c = merge_branches([ya_c, yb_c, yc_c], pc[9], w_branch_l, w_out_l)
    return m_l, m_c


def swiglu(x, wg, wu, wd):
    return (jax.nn.silu(x @ wg) * (x @ wu)) @ wd


def moe_ffn(x, w_router, w_eg, w_eu, w_ed):
    logits = (x @ w_router).astype(jnp.float32)
    top_v, top_i = lax.top_k(logits, TOP_K)
    wts = jax.nn.softmax(top_v, axis=-1)
    comb = jnp.sum(jax.nn.one_hot(top_i, N_EXPERTS, dtype=jnp.float32) * wts[..., None], axis=-2)
    out = jnp.zeros_like(x)
    for e in range(N_EXPERTS):
        out = out + comb[..., e:e + 1].astype(x.dtype) * swiglu(x, w_eg[e], w_eu[e], w_ed[e])
    return out


def channel_mixer(h, layer, ffn_wg, ffn_wu, ffn_wd, moe_router, moe_wg, moe_wu, moe_wd):
    j = layer // 2
    if layer % 2 == 0:
        return swiglu(h, ffn_wg[j], ffn_wu[j], ffn_wd[j])
    return moe_ffn(h, moe_router[j], moe_wg[j], moe_wu[j], moe_wd[j])


def setup_inputs(seed: int = 0) -> dict:
    key = jax.random.key(seed)
    ks = jax.random.split(key, 32)
    nrm = lambda k, shape, scale: jax.random.normal(k, shape, jnp.float32) * scale
    n_dense = (DEPTH + 1) // 2
    n_moe = DEPTH // 2
    return {
        "x": nrm(ks[0], (BATCH, SEQ, D_MODEL), 1.0),
        "c": nrm(ks[1], (BATCH, D_MODEL), 1.0),
        "ctx": nrm(ks[2], (BATCH, CTX_LEN, D_MODEL), 1.0),
        "c_ctx": nrm(ks[3], (D_MODEL,), 1.0),
        "w_ada": nrm(ks[4], (DEPTH, D_MODEL, 6 * D_MODEL), 0.5 * D_MODEL ** -0.5),
        "b_ada": nrm(ks[5], (DEPTH, 6 * D_MODEL), 0.02),
        "g_norm1": 1.0 + nrm(ks[6], (DEPTH, D_MODEL), 0.02),
        "g_norm2": 1.0 + nrm(ks[7], (DEPTH, D_MODEL), 0.02),
        "w_in": nrm(ks[8], (DEPTH, D_MODEL, IN_COLS), D_MODEL ** -0.5),
        "hgrn_lb": nrm(ks[9], (2, DEPTH, A_WIDTH), 0.5),
        "hgrn_gnorm": 1.0 + nrm(ks[10], (DEPTH, A_VWIDTH), 0.02),
        "mlp_vnorm": 1.0 + nrm(ks[11], (DEPTH, B_WIDTH), 0.02),
        "mlp_ws": nrm(ks[12], (DEPTH, B_GROUPS, B_CHUNK, B_CHUNK), B_CHUNK ** -0.5),
        "mlp_bs": 1.0 + nrm(ks[13], (DEPTH, B_GROUPS, B_CHUNK), 0.02),
        "diff_lambda": nrm(ks[14], (DEPTH, 4, C_DH), 0.1),
        "diff_subln": 1.0 + nrm(ks[15], (DEPTH, C_WIDTH), 0.02),
        "w_branch": nrm(ks[16], (DEPTH, N_BRANCH, BRANCH_WIDTH, D_MODEL), BRANCH_WIDTH ** -0.5),
        "w_out": nrm(ks[17], (DEPTH, D_MODEL, D_MODEL), D_MODEL ** -0.5),
        "ffn_wg": nrm(ks[18], (n_dense, D_MODEL, D_FF), D_MODEL ** -0.5),
        "ffn_wu": nrm(ks[19], (n_dense, D_MODEL, D_FF), D_MODEL ** -0.5),
        "ffn_wd": nrm(ks[20], (n_dense, D_FF, D_MODEL), D_FF ** -0.5),
        "moe_router": nrm(ks[21], (n_moe, D_MODEL, N_EXPERTS), D_MODEL ** -0.5),
        "moe_wg": nrm(ks[22], (n_moe, N_EXPERTS, D_MODEL, D_FF_E), D_MODEL ** -0.5),
        "moe_wu": nrm(ks[23], (n_moe, N_EXPERTS, D_MODEL, D_FF_E), D_MODEL ** -0.5),
        "moe_wd": nrm(ks[24], (n_moe, N_EXPERTS, D_FF_E, D_MODEL), D_FF_E ** -0.5),
        "g_final": 1.0 + nrm(ks[25], (D_MODEL,), 0.02),
    }


def reference(x, c, ctx, c_ctx, w_ada, b_ada, g_norm1, g_norm2, w_in, hgrn_lb, hgrn_gnorm,
              mlp_vnorm, mlp_ws, mlp_bs, diff_lambda, diff_subln, w_branch, w_out,
              ffn_wg, ffn_wu, ffn_wd, moe_router, moe_wg, moe_wu, moe_wd, g_final):
    n_lat = x.shape[1]
    rows = n_lat // GRID_W
    cos, sin = axial_rope_tables(rows)
    for layer in range(DEPTH):
        last = layer == DEPTH - 1
        mod_l = jnp.split(adaln(c, w_ada[layer], b_ada[layer])[:, None, :], 6, axis=-1)
        mod_c = jnp.split(adaln(c_ctx, w_ada[layer], b_ada[layer]), 6, axis=-1)
        h_l = modulate(rmsnorm(x, g_norm1[layer]), mod_l[0], mod_l[1])
        h_c = modulate(rmsnorm(ctx, g_norm1[layer]), mod_c[0], mod_c[1])
        m_l, m_c = token_mixer(h_l, h_c, layer, cos, sin, w_in[layer], hgrn_lb, hgrn_gnorm[layer],
                               mlp_vnorm[layer], mlp_ws[layer], mlp_bs[layer], diff_lambda[layer],
                               diff_subln[layer], w_branch[layer], w_out[layer], not last)
        x = x + mod_l[2] * m_l
        h_l = modulate(rmsnorm(x, g_norm2[layer]), mod_l[3], mod_l[4])
        x = x + mod_l[5] * channel_mixer(h_l, layer, ffn_wg, ffn_wu, ffn_wd, moe_router, moe_wg, moe_wu, moe_wd)
        if not last:
            ctx = ctx + mod_c[2] * m_c
            h_c = modulate(rmsnorm(ctx, g_norm2[layer]), mod_c[3], mod_c[4])
            ctx = ctx + mod_c[5] * channel_mixer(h_c, layer, ffn_wg, ffn_wu, ffn_wd, moe_router, moe_wg, moe_wu, moe_wd)
    return rmsnorm(x, g_final)
```

```cpp
#include <hip/hip_runtime.h>
#include <stdint.h>
#include <stdio.h>
#include <type_traits>

#ifndef EN_MASK
#define EN_MASK 0xFFFF
#endif
#ifndef REP_MASK
#define REP_MASK 0
#endif
#ifndef MK_SPLIT
#define MK_SPLIT 0
#endif

#define DI __device__ __forceinline__
#define LAS __attribute__((address_space(3)))
typedef unsigned short bf16_t;
typedef short bf16x8 __attribute__((ext_vector_type(8)));
typedef short s16x4 __attribute__((ext_vector_type(4)));
typedef float f32x2 __attribute__((ext_vector_type(2)));
typedef float f32x4 __attribute__((ext_vector_type(4)));
typedef float f32x16 __attribute__((ext_vector_type(16)));
typedef unsigned u32x2 __attribute__((ext_vector_type(2)));
typedef unsigned u32x4 __attribute__((ext_vector_type(4)));
typedef __bf16 bf16x2_t __attribute__((ext_vector_type(2)));
typedef int v8i32 __attribute__((ext_vector_type(8)));

constexpr int D = 1024, NBATCH = 8, SEQ = 4096, CTXL = 256;
constexpr int SB = SEQ + CTXL;
constexpr int T = NBATCH * SB;
constexpr int NMT = T / 256;
constexpr int NLAT = NBATCH * SEQ;
constexpr int INCOLS = 8192, P1LD = 4608, DFF = 2816, DFFE = 3584, NEXP = 8;
constexpr float EPS = 1e-6f;
constexpr int MAXROWS_MOE = 69632;

constexpr size_t MiB = (size_t)1 << 20;
constexpr size_t WS_CTL = 0;
constexpr size_t CTL_ZERO_BYTES = 65536;
constexpr size_t WS_MOD = 1 * MiB;
constexpr size_t WS_ROPE = 1 * MiB + 512 * 1024;
constexpr size_t WS_ROUTE = 2 * MiB;
constexpr size_t WS_HIST = 3 * MiB;
constexpr size_t WS_TOK = 4 * MiB;
constexpr size_t WS_WROW = 5 * MiB;
constexpr size_t WS_GRP = 6 * MiB;
constexpr size_t WS_LB = 7 * MiB;
constexpr size_t WS_CTX = 9 * MiB;
constexpr size_t WS_WIN = 17 * MiB;
constexpr size_t WS_WBR = 49 * MiB;
constexpr size_t WS_WOUT = 55 * MiB;
constexpr size_t WS_WGU = 59 * MiB;
constexpr size_t WS_WDN = 70 * MiB;
constexpr size_t WS_H = 77 * MiB;
constexpr size_t WS_P1 = 145 * MiB;
constexpr size_t WS_OG = 451 * MiB;
constexpr size_t WS_OF = 485 * MiB;
constexpr size_t WS_OB = 519 * MiB;
constexpr size_t WS_YB = 553 * MiB;
constexpr size_t WS_YC = 587 * MiB;
constexpr size_t WS_G = 145 * MiB;
constexpr size_t WS_MRG = 383 * MiB;
constexpr size_t WS_HID = 145 * MiB;
constexpr size_t WS_WMGU = 469 * MiB;
constexpr size_t WS_WMDN = 525 * MiB;
constexpr size_t WS_XS = 333 * MiB;
constexpr size_t WS_HS = 17 * MiB;
constexpr size_t WS_Y1 = 333 * MiB;
constexpr size_t WS_Y0 = 397 * MiB;
constexpr size_t WS_END = 637 * MiB;
static_assert(WS_WDN + (size_t)1024 * DFF * 2 <= WS_H, "weights");
static_assert(WS_P1 + (size_t)T * P1LD * 2 <= WS_OG && WS_G + (size_t)T * 3072 * 2 <= WS_MRG && WS_MRG + (size_t)T * 1024 * 2 <= WS_OG, "arena");
static_assert(WS_YC + (size_t)T * 512 * 2 <= WS_END && WS_WMGU + (size_t)8 * 7168 * 1024 <= WS_WMDN && WS_WMDN + (size_t)8 * 1024 * DFFE <= WS_END, "arena end");
static_assert(WS_XS + (size_t)MAXROWS_MOE * 1024 <= WS_WMGU && WS_HS + (size_t)MAXROWS_MOE * DFFE <= WS_XS && WS_HID + (size_t)T * DFF * 2 <= WS_END, "moe");

constexpr int LDS_BYTES = 147456;
constexpr int LDS_MISC = 139264;
constexpr int LDS_BARW = LDS_BYTES - 16;

struct Params {
    const float *x, *c, *ctx, *c_ctx, *w_ada, *b_ada, *g_norm1, *g_norm2, *w_in, *hgrn_lb, *hgrn_gnorm, *mlp_vnorm, *mlp_ws, *mlp_bs,
        *diff_lambda, *diff_subln, *w_branch, *w_out, *ffn_wg, *ffn_wu, *ffn_wd, *moe_router, *moe_wg, *moe_wu, *moe_wd, *g_final;
    float* out; unsigned char* ws; int lo, hi;
};

DI unsigned pk2(float lo, float hi) { f32x2 v = {lo, hi}; bf16x2_t b = __builtin_convertvector(v, bf16x2_t); return __builtin_bit_cast(unsigned, b); }
DI float bflo(unsigned u) { return __uint_as_float(u << 16); }
DI float bfhi(unsigned u) { return __uint_as_float(u & 0xffff0000u); }
DI float bf1(bf16_t u) { return __uint_as_float((unsigned)u << 16); }
DI float wave_sum(float v) {
#pragma unroll
    for (int o = 1; o < 64; o <<= 1) v += __shfl_xor(v, o);
    return v;
}
DI float sigm(float x) { return __builtin_amdgcn_rcpf(1.f + __builtin_amdgcn_exp2f(-1.4426950408889634f * x)); }
DI float gelu_tanh(float x) { const float u = 0.7978845608028654f * (x + 0.044715f * x * x * x); return x * __builtin_amdgcn_rcpf(1.f + __builtin_amdgcn_exp2f(-2.885390081777927f * u)); }
#define LDS_WAIT() asm volatile("s_waitcnt lgkmcnt(0)" ::: "memory")
DI unsigned pk4_fp8(float a, float b, float c, float d) {
    a = __builtin_amdgcn_fmed3f(a, -448.f, 448.f); b = __builtin_amdgcn_fmed3f(b, -448.f, 448.f); c = __builtin_amdgcn_fmed3f(c, -448.f, 448.f); d = __builtin_amdgcn_fmed3f(d, -448.f, 448.f);
    int w = __builtin_amdgcn_cvt_pk_fp8_f32(a, b, 0, false); w = __builtin_amdgcn_cvt_pk_fp8_f32(c, d, w, true); return (unsigned)w; }
constexpr float W8SCALE = 64.f;

namespace pg8 {
constexpr int BM = 256, BK = 64, HALF = 128, HTB = HALF * BK * 2, STAGE_BYTES = 8 * HTB;
__host__ __device__ __forceinline__ int lds_byte(int r, int c) { const int st = (r >> 4) * 2 + (c >> 5), rr = r & 15, cc = c & 31, ob = rr * 64 + cc * 2; return st * 1024 + (ob ^ (((ob >> 9) & 1) << 5)); }
__host__ __device__ __forceinline__ void stage_rc(int b, int& R, int& C) { const int st = b / 1024, sb = b % 1024, swz = sb ^ (((sb >> 9) & 1) << 5); R = (st >> 1) * 16 + swz / 64; C = (st & 1) * 32 + (swz % 64) / 2; }
__host__ __device__ __forceinline__ int perm32(int rho) { const int n = rho >> 4, i = rho & 15; return 8 * (i >> 2) + 4 * n + (i & 3); }

struct Unit { int pm, pn, pa, pb, aux; };
struct Gemm { const bf16_t* A; const bf16_t* Bt; int K; };

template <class Epi, class Sched, bool ALIGN_EPI = true, bool FP8 = false, bool CHAIN = false>
DI void gemm_phase(LAS unsigned char* lds, const Gemm g, const Sched& S, const Epi& E) {
    int tid_ = threadIdx.x; asm volatile("" : "+v"(tid_));
    const int tid = tid_, wid = __builtin_amdgcn_readfirstlane(tid >> 6), lane = tid & 63, wr = wid >> 2, wc = wid & 3, fr = lane & 15, fq = lane >> 4;
    const int K = g.K, nt = K / BK;
    unsigned voffA[2], voffB[2];
#pragma unroll
    for (int i = 0; i < 2; ++i) { int R, C; stage_rc(tid * 16 + i * 8192, R, C); const int Rb = Epi::PERM ? ((R & ~31) + perm32(R & 31)) : R;
        voffA[i] = (unsigned)(R * K + C) * 2u; voffB[i] = (unsigned)(Rb * K + C) * 2u; }
    const size_t kstep = (size_t)(BK * 2);
    const size_t hstep = (size_t)HALF * K * 2;
    const size_t tstep = 2 * hstep;
    const unsigned ldsw = (unsigned)wid * 1024u;
    const int aoff = lds_byte(wr * 64 + fr, fq * 8), boff = lds_byte(wc * 32 + fr, fq * 8);
#define PG8_SA(b, h) (((b) * 2 + (h)) * HTB)
#define PG8_SB(b, h) ((4 + (b) * 2 + (h)) * HTB)
#define PG8_STAGE(bufoff, gbase, voff) do { _Pragma("unroll") for (int _i = 0; _i < 2; ++_i) { unsigned vo_ = (voff)[_i]; asm volatile("" : "+v"(vo_));     \
        __builtin_amdgcn_global_load_lds((const unsigned*)((const char*)(gbase) + vo_), (LAS unsigned*)(lds + (bufoff) + ldsw + _i * 8192), 16, 0, 0); } } while (0)
typedef int v4i32_ __attribute__((ext_vector_type(4)));
#define PG8_LDA(dst, b, h) do { _Pragma("unroll") for (int m = 0; m < 4; ++m) { if constexpr (FP8) { const v4i32_ lo_ = *(const LAS v4i32_*)(lds + PG8_SA(b, h) + aoff + m * 2048), hi_ = *(const LAS v4i32_*)(lds + PG8_SA(b, h) + aoff + m * 2048 + 1024); \
            dst##8[m] = __builtin_shufflevector(lo_, hi_, 0, 1, 2, 3, 4, 5, 6, 7); } else { _Pragma("unroll") for (int k = 0; k < 2; ++k) dst[m][k] = *(const LAS bf16x8*)(lds + PG8_SA(b, h) + aoff + m * 2048 + k * 1024); } } } while (0)
#define PG8_LDB(dst, b, h) do { _Pragma("unroll") for (int n = 0; n < 2; ++n) { if constexpr (FP8) { const v4i32_ lo_ = *(const LAS v4i32_*)(lds + PG8_SB(b, h) + boff + n * 2048), hi_ = *(const LAS v4i32_*)(lds + PG8_SB(b, h) + boff + n * 2048 + 1024); \
            dst##8[n] = __builtin_shufflevector(lo_, hi_, 0, 1, 2, 3, 4, 5, 6, 7); } else { _Pragma("unroll") for (int k = 0; k < 2; ++k) dst[n][k] = *(const LAS bf16x8*)(lds + PG8_SB(b, h) + boff + n * 2048 + k * 1024); } } } while (0)
#define PG8_MMA(ai, bj, At, Bt) do { __builtin_amdgcn_s_setprio(1); _Pragma("unroll") for (int m = 0; m < 4; ++m) _Pragma("unroll") for (int n = 0; n < 2; ++n) { \
        if constexpr (FP8) asm volatile("v_mfma_scale_f32_16x16x128_f8f6f4 %0, %1, %2, %0, %3, %3 op_sel_hi:[0,0,0]" : "+v"(acc[ai][bj][m][n]) : "v"(Bt##8[n]), "v"(At##8[m]), "v"(sc7f));   \
        else { _Pragma("unroll") for (int k = 0; k < 2; ++k) acc[ai][bj][m][n] = __builtin_amdgcn_mfma_f32_16x16x32_bf16(Bt[n][k], At[m][k], acc[ai][bj][m][n], 0, 0, 0); } } \
        __builtin_amdgcn_s_setprio(0); } while (0)
#define PG8_WAIT_V(n) asm volatile("s_waitcnt vmcnt(" #n ")" ::: "memory")
#define PG8_WAIT_L(n) asm volatile("s_waitcnt lgkmcnt(" #n ")" ::: "memory")
#define PG8_BAR __builtin_amdgcn_s_barrier()
#define PG8_SCHED __builtin_amdgcn_sched_barrier(0)
    Unit cur, nxt; int ui = 0;
    if (!S.next(0, cur)) return;
    f32x4 acc[2][2][4][2];
#pragma unroll
    for (int a = 0; a < 2; ++a)
#pragma unroll
        for (int b = 0; b < 2; ++b)
#pragma unroll
            for (int m = 0; m < 4; ++m)
#pragma unroll
                for (int n = 0; n < 2; ++n) acc[a][b][m][n] = (f32x4){0.f, 0.f, 0.f, 0.f};
    bf16x8 At[4][2], B0[2][2], B1[2][2]; v8i32 At8[4], B08[2], B18[2];
    const int sc7f = 0x7F7F7F7F;
    const char* cA = (const char*)g.A + (size_t)cur.pa * tstep; const char* cB = (const char*)g.Bt + (size_t)cur.pb * tstep;
    PG8_STAGE(PG8_SB(0, 0), cB, voffB); PG8_STAGE(PG8_SB(0, 1), cB + hstep, voffB); PG8_STAGE(PG8_SA(0, 0), cA, voffA); PG8_STAGE(PG8_SA(0, 1), cA + hstep, voffA);
    if (wr == 1) PG8_BAR;
    PG8_WAIT_V(2); PG8_BAR;
    PG8_STAGE(PG8_SB(1, 0), cB + kstep, voffB); PG8_STAGE(PG8_SA(1, 0), cA + kstep, voffA); PG8_STAGE(PG8_SB(1, 1), cB + hstep + kstep, voffB);
    PG8_WAIT_V(6); PG8_BAR;
    for (;;) {
        const bool has_next = S.next(ui + 1, nxt);
        const char* nA = has_next ? (const char*)g.A + (size_t)nxt.pa * tstep : cA; const char* nB = has_next ? (const char*)g.Bt + (size_t)nxt.pb * tstep : cB;
#pragma clang loop unroll(disable)
        for (int t = 0; t < nt; t += 2) {
            const bool last = (t == nt - 2);
            const char* a1 = cA + (size_t)(t + 1) * kstep;
            const char* a2 = last ? nA : cA + (size_t)(t + 2) * kstep; const char* b2 = last ? nB : cB + (size_t)(t + 2) * kstep;
            const char* a3 = a2 + kstep; const char* b3 = b2 + kstep;
            PG8_LDB(B0, 0, 0); PG8_LDB(B1, 0, 1); PG8_SCHED; PG8_LDA(At, 0, 0); PG8_STAGE(PG8_SA(1, 1), a1 + hstep, voffA);
            PG8_WAIT_V(8); PG8_WAIT_L(0); PG8_BAR; PG8_MMA(0, 0, At, B0); PG8_MMA(0, 1, At, B1); PG8_BAR; PG8_SCHED;
            PG8_LDA(At, 0, 1); PG8_STAGE(PG8_SB(0, 0), b2, voffB); PG8_STAGE(PG8_SB(0, 1), b2 + hstep, voffB); PG8_STAGE(PG8_SA(0, 0), a2, voffA);
            PG8_WAIT_V(8); PG8_WAIT_L(0); PG8_BAR; PG8_MMA(1, 0, At, B0); PG8_MMA(1, 1, At, B1); PG8_BAR; PG8_SCHED;
            PG8_LDB(B0, 1, 0); PG8_LDB(B1, 1, 1); PG8_SCHED; PG8_LDA(At, 1, 0); PG8_STAGE(PG8_SA(0, 1), a2 + hstep, voffA);
            PG8_WAIT_V(8); PG8_WAIT_L(0); PG8_BAR; PG8_MMA(0, 0, At, B0); PG8_MMA(0, 1, At, B1); PG8_BAR; PG8_SCHED;
            PG8_LDA(At, 1, 1); PG8_STAGE(PG8_SB(1, 0), b3, voffB); PG8_STAGE(PG8_SB(1, 1), b3 + hstep, voffB); PG8_STAGE(PG8_SA(1, 0), a3, voffA);
            PG8_WAIT_V(8); PG8_WAIT_L(0); PG8_BAR; PG8_MMA(1, 0, At, B0); PG8_MMA(1, 1, At, B1); PG8_BAR; PG8_SCHED;
        }
        if constexpr (ALIGN_EPI) { if (wr == 0) PG8_BAR; }
        if constexpr (FP8) asm volatile("s_nop 15\n\ts_nop 7" ::: "memory");
        E(acc, cur, wr, wc, fr, fq);
        if (!has_next) break;
        if (!(CHAIN && cur.aux < 2)) {
#pragma unroll
        for (int a = 0; a < 2; ++a)
#pragma unroll
            for (int b = 0; b < 2; ++b)
#pragma unroll
                for (int m = 0; m < 4; ++m)
#pragma unroll
                    for (int n = 0; n < 2; ++n) acc[a][b][m][n] = (f32x4){0.f, 0.f, 0.f, 0.f};
        }
        cur = nxt; cA = nA; cB = nB; ++ui;
        if constexpr (ALIGN_EPI) { if (wr == 1) PG8_BAR; }
    }
    PG8_WAIT_V(0);
    if constexpr (!ALIGN_EPI) { if (wr == 0) PG8_BAR; }
    PG8_BAR;
#undef PG8_SA
#undef PG8_SB
#undef PG8_STAGE
#undef PG8_LDA
#undef PG8_LDB
#undef PG8_MMA
#undef PG8_WAIT_V
#undef PG8_WAIT_L
#undef PG8_BAR
#undef PG8_SCHED
}
}
using pg8::Unit;

struct TileOrder {
    int nM, nN, nwg, G, c, skipctx, pboff, reps = 1;
    DI void init(int nM_, int nN_, int G_, int c_, int skipctx_, int pboff_) { nM = nM_; nN = nN_; nwg = nM * nN; G = G_; c = c_; skipctx = skipctx_; pboff = pboff_; }
    DI bool tile(long L, int& pm, int& pn) const {
        if (L >= (long)nwg * reps) return false;
        if (reps > 1) L %= nwg;
        int wgid = (int)L; { const int q = nwg / 8, r = nwg % 8, xcd = wgid % 8, off = wgid / 8; wgid = (xcd < r ? xcd * (q + 1) : r * (q + 1) + (xcd - r) * q) + off; }
        const int nig = 8 * nN, gid = wgid / nig, fm = gid * 8, gsz = (nM - fm) < 8 ? (nM - fm) : 8;
        int m = fm + ((wgid % nig) % gsz); pn = (wgid % nig) / gsz;
        pm = skipctx ? (m + (m >> 4) + 1) : m; return true;
    }
    DI bool next(int i, Unit& u) const { int pm, pn; if (!tile((long)i * G + c, pm, pn)) return false; u.pm = pm; u.pn = pn; u.pa = pm; u.pb = pboff + pn; u.aux = 0; return true; }
};
struct MergeOrder {
    TileOrder t;
    DI bool next(int i, Unit& u) const { const int br = i % 3; int pm, pn; if (!t.tile((long)(i / 3) * t.G + t.c, pm, pn)) return false;
        u.pm = pm; u.pn = pn; u.pa = br * NMT + pm; u.pb = br * 4 + pn; u.aux = br; return true; }
};
struct MoeOrder {
    const LAS int* tab;
    int ng, npn, G, c, g0;
    DI bool next(int i, Unit& u) const {
        const int L = i * G + c; if (L >= __builtin_amdgcn_readfirstlane(tab[ng])) return false;
        int ln = (int)(threadIdx.x & 63); asm volatile("" : "+v"(ln)); const int tv = tab[ln & 15];
        const int j = __builtin_amdgcn_readfirstlane((int)__popcll(__ballot(ln >= 1 && ln < ng && L >= tv)));
        const int tj = __builtin_amdgcn_readfirstlane(tab[j]), tbj = __builtin_amdgcn_readfirstlane(tab[32 + j]), e = (g0 + j) & 7;
        const int r = L - tj, mt = r / npn, pn = r % npn, gt = tbj + mt;
        u.pm = gt; u.pa = gt; u.pn = pn; u.pb = e * npn + pn; u.aux = (g0 + j) >> 3; return true;
    }
};

DI void row_bs(int R, int& b, int& s) { b = R / SB; s = R - b * SB; }

struct EpiInproj {
    static constexpr bool PERM = true;
    bf16_t* P1; bf16_t* OG; const LAS f32x2* rope; const LAS float* lbt;
    template <int OP> DI void run(const f32x4 (&acc)[2][2][4][2], const Unit& u, int wr, int wc, int fr, int fq, bf16_t* base, int ldc, int colt, float qs) const {
        f32x4 lb0[2], lb1[2];
        if (OP == 3) {
#pragma unroll
            for (int bj = 0; bj < 2; ++bj) { const LAS float* lp = lbt + (u.pn - 2) * 256 + bj * 128 + wc * 32 + 8 * fq; lb0[bj] = *(const LAS f32x4*)lp; lb1[bj] = *(const LAS f32x4*)(lp + 4); }
        }
#pragma unroll
        for (int ai = 0; ai < 2; ++ai)
#pragma unroll
            for (int m = 0; m < 4; ++m) {
                const int R = u.pm * 256 + ai * 128 + wr * 64 + m * 16 + fr;
                bf16_t* rowp = base + (size_t)R * ldc + colt + wc * 32 + 8 * fq;
                f32x4 c0 = {1.f, 1.f, 1.f, 1.f}, s0 = {0.f, 0.f, 0.f, 0.f}, c1 = c0, s1 = s0;
                if (OP == 2) {
                    int b, s; row_bs(R, b, s);
                    const int t = s - CTXL; const int pos = (wc & 1) ? (t & 63) : (t >> 6);
                    if (s >= CTXL) { const LAS f32x4* rp = (const LAS f32x4*)(rope + pos * 16 + 8 * (fq & 1)); const f32x4 a = rp[0], bq = rp[1], cq = rp[2], dq = rp[3];
                        c0 = (f32x4){a[0], a[2], bq[0], bq[2]}; s0 = (f32x4){a[1], a[3], bq[1], bq[3]}; c1 = (f32x4){cq[0], cq[2], dq[0], dq[2]}; s1 = (f32x4){cq[1], cq[3], dq[1], dq[3]}; }
                }
#pragma unroll
                for (int bj = 0; bj < 2; ++bj) {
                    f32x4 v0 = acc[ai][bj][m][0], v1 = acc[ai][bj][m][1];
                    if (OP == 1) {
#pragma unroll
                        for (int i = 0; i < 4; ++i) { v0[i] = gelu_tanh(v0[i]); v1[i] = gelu_tanh(v1[i]); }
                    } else if (OP == 3) {
#pragma unroll
                        for (int i = 0; i < 4; ++i) { v0[i] = __builtin_amdgcn_logf(lb0[bj][i] + (1.f - lb0[bj][i]) * sigm(v0[i])); v1[i] = __builtin_amdgcn_logf(lb1[bj][i] + (1.f - lb1[bj][i]) * sigm(v1[i])); }
                    } else if (OP == 2) {
                        f32x4 x1a, x2a, x1b, x2b;
#pragma unroll
                        for (int i = 0; i < 4; ++i) {
                            auto ra = __builtin_amdgcn_permlane32_swap(__float_as_uint(v0[i]), __float_as_uint(v0[i]), false, false); x1a[i] = __uint_as_float(ra[0]); x2a[i] = __uint_as_float(ra[1]);
                            auto rb = __builtin_amdgcn_permlane32_swap(__float_as_uint(v1[i]), __float_as_uint(v1[i]), false, false); x1b[i] = __uint_as_float(rb[0]); x2b[i] = __uint_as_float(rb[1]); }
                        if (fq < 2) { v0 = (x1a * c0 - x2a * s0) * qs; v1 = (x1b * c1 - x2b * s1) * qs; }
                        else { v0 = (x1a * s0 + x2a * c0) * qs; v1 = (x1b * s1 + x2b * c1) * qs; }
                    }
                    u32x4 w; w.x = pk2(v0[0], v0[1]); w.y = pk2(v0[2], v0[3]); w.z = pk2(v1[0], v1[1]); w.w = pk2(v1[2], v1[3]);
                    *(u32x4*)(rowp + bj * 128) = w;
                }
            }
    }
    DI void operator()(const f32x4 (&acc)[2][2][4][2], const Unit& u, int wr, int wc, int fr, int fq) const {
        const int pn = u.pn;
        bf16_t* base; int ldc, colt;
        if (pn == 8 || pn == 9) { base = OG; ldc = 512; colt = (pn - 8) * 256; }
        else { base = P1; ldc = P1LD; colt = pn * 256 - (pn >= 10 ? 512 : 0); }
        const float qs = (pn == 14 || pn == 15) ? 0.18033688011112042f : 1.0f;
        if (pn >= 10 && pn <= 13) run<1>(acc, u, wr, wc, fr, fq, base, ldc, colt, qs);
        else if (pn >= 14 && pn <= 17) run<2>(acc, u, wr, wc, fr, fq, base, ldc, colt, qs);
        else if (pn >= 2 && pn <= 5) run<3>(acc, u, wr, wc, fr, fq, base, ldc, colt, qs);
        else run<0>(acc, u, wr, wc, fr, fq, base, ldc, colt, qs);
    }
};

template <int ACT> struct EpiStore {
    static constexpr bool PERM = true;
    bf16_t* O; int ldc;
    DI void operator()(const f32x4 (&acc)[2][2][4][2], const Unit& u, int wr, int wc, int fr, int fq) const {
#pragma unroll
        for (int ai = 0; ai < 2; ++ai)
#pragma unroll
            for (int m = 0; m < 4; ++m) {
                bf16_t* rowp = O + (size_t)(u.pm * 256 + ai * 128 + wr * 64 + m * 16 + fr) * ldc + u.pn * 256 + wc * 32 + 8 * fq;
#pragma unroll
                for (int bj = 0; bj < 2; ++bj) {
                    f32x4 v0 = acc[ai][bj][m][0], v1 = acc[ai][bj][m][1];
                    if (ACT == 1) {
#pragma unroll
                        for (int i = 0; i < 4; ++i) { v0[i] = fmaxf(sigm(v0[i]), 1e-6f); v1[i] = fmaxf(sigm(v1[i]), 1e-6f); }
                    }
                    u32x4 w; w.x = pk2(v0[0], v0[1]); w.y = pk2(v0[2], v0[3]); w.z = pk2(v1[0], v1[1]); w.w = pk2(v1[2], v1[3]);
                    *(u32x4*)(rowp + bj * 128) = w;
                }
            }
    }
};

struct EpiMerge {
    static constexpr bool PERM = true;
    bf16_t* MRG; const bf16_t* G;
    DI void operator()(f32x4 (&acc)[2][2][4][2], const Unit& u, int wr, int wc, int fr, int fq) const {
        const int br = u.aux;
        const int c0 = u.pn * 256 + wc * 32 + 8 * fq;
#pragma unroll
        for (int ai = 0; ai < 2; ++ai) {
            u32x4 gv[4][2], hv[4][2];
#pragma unroll
            for (int m = 0; m < 4; ++m)
#pragma unroll
                for (int bj = 0; bj < 2; ++bj) { const bf16_t* gp = G + (size_t)(u.pm * 256 + ai * 128 + wr * 64 + m * 16 + fr) * 3072 + br * 1024 + c0 + bj * 128;
                    gv[m][bj] = *(const u32x4*)gp; if (br < 2) hv[m][bj] = *(const u32x4*)(gp + 1024); }
#pragma unroll
            for (int m = 0; m < 4; ++m)
#pragma unroll
                for (int bj = 0; bj < 2; ++bj) {
                    const u32x4 g4 = gv[m][bj];
                    float g[8] = {bflo(g4.x), bfhi(g4.x), bflo(g4.y), bfhi(g4.y), bflo(g4.z), bfhi(g4.z), bflo(g4.w), bfhi(g4.w)};
                    if (br < 2) {
                        const u32x4 h4 = hv[m][bj];
                        const float h[8] = {bflo(h4.x), bfhi(h4.x), bflo(h4.y), bfhi(h4.y), bflo(h4.z), bfhi(h4.z), bflo(h4.w), bfhi(h4.w)};
#pragma unroll
                        for (int i = 0; i < 8; ++i) g[i] *= __builtin_amdgcn_rcpf(h[i]);
#pragma unroll
                        for (int i = 0; i < 4; ++i) { acc[ai][bj][m][0][i] *= g[i]; acc[ai][bj][m][1][i] *= g[4 + i]; }
                    } else {
                        const f32x4 v0 = acc[ai][bj][m][0], v1 = acc[ai][bj][m][1];
                        u32x4 w; w.x = pk2(v0[0] * g[0], v0[1] * g[1]); w.y = pk2(v0[2] * g[2], v0[3] * g[3]); w.z = pk2(v1[0] * g[4], v1[1] * g[5]); w.w = pk2(v1[2] * g[6], v1[3] * g[7]);
                        *(u32x4*)(MRG + (size_t)(u.pm * 256 + ai * 128 + wr * 64 + m * 16 + fr) * 1024 + c0 + bj * 128) = w;
                    }
                }
        }
    }
};

struct EpiResid {
    static constexpr bool PERM = true;
    const float* in_l; const float* in_c; float* out_l; float* out_c; const float* gate;
    DI void operator()(const f32x4 (&acc)[2][2][4][2], const Unit& u, int wr, int wc, int fr, int fq) const {
        const int c0 = u.pn * 256 + wc * 32 + 8 * fq;
        const int bt = u.pm / 17, isc = (u.pm - bt * 17) == 0;
        const float* gp = gate + (size_t)(isc ? 8 : bt) * 6144 + c0;
        f32x4 g[2][2];
#pragma unroll
        for (int bj = 0; bj < 2; ++bj) { g[bj][0] = *(const f32x4*)(gp + bj * 128); g[bj][1] = *(const f32x4*)(gp + bj * 128 + 4); }
#pragma unroll
        for (int ai = 0; ai < 2; ++ai) {
            f32x4 xv[4][2][2]; size_t ro[4];
#pragma unroll
            for (int m = 0; m < 4; ++m) {
                const int R = u.pm * 256 + ai * 128 + wr * 64 + m * 16 + fr, s = R - bt * SB;
                ro[m] = isc ? (size_t)(bt * CTXL + s) * D : (size_t)(bt * SEQ + s - CTXL) * D;
                const float* xi = (isc ? in_c : in_l) + ro[m] + c0;
#pragma unroll
                for (int bj = 0; bj < 2; ++bj) { xv[m][bj][0] = *(const f32x4*)(xi + bj * 128); xv[m][bj][1] = *(const f32x4*)(xi + bj * 128 + 4); }
            }
#pragma unroll
            for (int m = 0; m < 4; ++m) {
                float* xo = (isc ? out_c : out_l) + ro[m] + c0;
#pragma unroll
                for (int bj = 0; bj < 2; ++bj) { *(f32x4*)(xo + bj * 128) = xv[m][bj][0] + g[bj][0] * acc[ai][bj][m][0]; *(f32x4*)(xo + bj * 128 + 4) = xv[m][bj][1] + g[bj][1] * acc[ai][bj][m][1]; }
            }
        }
    }
};

template <bool F8> struct EpiSwigluT {
    static constexpr bool PERM = true;
    bf16_t* Hd; int ldc;
    DI void operator()(const f32x4 (&acc)[2][2][4][2], const Unit& u, int wr, int wc, int fr, int fq) const {
#pragma unroll
        for (int ai = 0; ai < 2; ++ai)
#pragma unroll
            for (int m = 0; m < 4; ++m) {
                const size_t eo = (size_t)(u.pm * 256 + ai * 128 + wr * 64 + m * 16 + fr) * ldc + u.pn * 128 + wc * 32 + 8 * fq;
                constexpr float sc = F8 ? 1.f / W8SCALE : 1.f;
                float o[8];
#pragma unroll
                for (int n = 0; n < 2; ++n)
#pragma unroll
                    for (int i = 0; i < 4; ++i) { const float g = acc[ai][0][m][n][i] * sc, up = acc[ai][1][m][n][i] * sc; o[n * 4 + i] = g * sigm(g) * up; }
                if constexpr (F8) { u32x2 w; w.x = pk4_fp8(o[0], o[1], o[2], o[3]); w.y = pk4_fp8(o[4], o[5], o[6], o[7]); *(u32x2*)((unsigned char*)Hd + eo) = w; }
                else { u32x4 w; w.x = pk2(o[0], o[1]); w.y = pk2(o[2], o[3]); w.z = pk2(o[4], o[5]); w.w = pk2(o[6], o[7]); *(u32x4*)(Hd + eo) = w; }
            }
    }
};
typedef EpiSwigluT<false> EpiSwiglu;

struct EpiMoeDown {
    static constexpr bool PERM = true;
    const int* tok; const float* wrow; bf16_t* y0; bf16_t* y1;
    DI void operator()(const f32x4 (&acc)[2][2][4][2], const Unit& u, int wr, int wc, int fr, int fq) const {
        const int c0 = u.pn * 256 + wc * 32 + 8 * fq;
        bf16_t* y = u.aux ? y1 : y0;
        int nn[2][4]; float ww[2][4];
#pragma unroll
        for (int ai = 0; ai < 2; ++ai)
#pragma unroll
            for (int m = 0; m < 4; ++m) { const int row = u.pm * 256 + ai * 128 + wr * 64 + m * 16 + fr; nn[ai][m] = tok[row]; ww[ai][m] = wrow[row] * (1.f / W8SCALE); }
#pragma unroll
        for (int ai = 0; ai < 2; ++ai)
#pragma unroll
            for (int m = 0; m < 4; ++m) if (nn[ai][m] >= 0) {
                const size_t o = (size_t)nn[ai][m] * D + c0; const float w = ww[ai][m];
#pragma unroll
                for (int bj = 0; bj < 2; ++bj) {
                    const f32x4 a0 = acc[ai][bj][m][0] * w, a1 = acc[ai][bj][m][1] * w;
                    u32x4 w4; w4.x = pk2(a0[0], a0[1]); w4.y = pk2(a0[2], a0[3]); w4.z = pk2(a1[0], a1[1]); w4.w = pk2(a1[2], a1[3]); *(u32x4*)(y + o + bj * 128) = w4;
                }
            }
    }
};

struct Ctx {
    LAS unsigned char* lds; int tid, lane, wid, G, c;
    unsigned char* ws;
};

struct ConvItem { const float* W; int N, k0, n0; bf16_t* Dst; int Kd, drow; };
DI void conv_load(const ConvItem& c, int lane, f32x4 (&v)[16]) {
    const float* src = c.W + (size_t)c.k0 * c.N + c.n0 + (lane & 15) * 4;
#pragma unroll
    for (int i = 0; i < 16; ++i) { const int kk = 4 * i + (lane >> 4); v[i] = *(const f32x4*)(src + (size_t)kk * c.N); }
}
template <bool F8> DI void conv_store(const ConvItem& c, LAS float* scr, int lane, const f32x4 (&v)[16]) {
#pragma unroll
    for (int i = 0; i < 16; ++i) { const int kk = 4 * i + (lane >> 4); LAS float* d = scr + kk * 65 + (lane & 15) * 4; d[0] = v[i][0]; d[1] = v[i][1]; d[2] = v[i][2]; d[3] = v[i][3]; }
    LDS_WAIT();
    const int kc = lane & 7;
#pragma unroll
    for (int i = 0; i < 8; ++i) { const int n = i * 8 + (lane >> 3); const LAS float* s = scr + (kc * 8) * 65 + n;
        if constexpr (F8) { u32x2 o; o.x = pk4_fp8(s[0] * W8SCALE, s[65] * W8SCALE, s[2 * 65] * W8SCALE, s[3 * 65] * W8SCALE); o.y = pk4_fp8(s[4 * 65] * W8SCALE, s[5 * 65] * W8SCALE, s[6 * 65] * W8SCALE, s[7 * 65] * W8SCALE);
            *(u32x2*)((unsigned char*)c.Dst + (size_t)(c.drow + n) * c.Kd + c.k0 + kc * 8) = o; }
        else { u32x4 o; o.x = pk2(s[0], s[65]); o.y = pk2(s[2 * 65], s[3 * 65]); o.z = pk2(s[4 * 65], s[5 * 65]); o.w = pk2(s[6 * 65], s[7 * 65]);
            *(u32x4*)(c.Dst + (size_t)(c.drow + n) * c.Kd + c.k0 + kc * 8) = o; } }
    LDS_WAIT();
}
constexpr int CV_WIN = 2 * 16 * 128, CV_WBR = 6 * 128, CV_WOUT = 2 * 256, CV_FF = 704, CV_N0 = CV_WIN + CV_WBR + CV_WOUT + 3 * CV_FF;
constexpr int CV_ME = 896, CV_N1 = 3 * 8 * CV_ME;
DI void conv_decode0(const Params& p, int r, ConvItem& c) {
    unsigned char* ws = p.ws;
    if (r < CV_WIN) { const int l = r / 2048, rr = r % 2048; c.W = p.w_in + (size_t)l * 1024 * 8192; c.N = 8192; c.k0 = (rr / 128) * 64; c.n0 = (rr % 128) * 64;
        c.Dst = (bf16_t*)(ws + WS_WIN) + (size_t)l * 8192 * 1024; c.Kd = 1024; c.drow = c.n0; return; } r -= CV_WIN;
    if (r < CV_WBR) { const int m6 = r / 128, rr = r % 128; c.W = p.w_branch + (size_t)m6 * 512 * 1024; c.N = 1024; c.k0 = (rr / 16) * 64; c.n0 = (rr % 16) * 64;
        c.Dst = (bf16_t*)(ws + WS_WBR) + (size_t)m6 * 1024 * 512; c.Kd = 512; c.drow = c.n0; return; } r -= CV_WBR;
    if (r < CV_WOUT) { const int l = r / 256, rr = r % 256; c.W = p.w_out + (size_t)l * 1024 * 1024; c.N = 1024; c.k0 = (rr / 16) * 64; c.n0 = (rr % 16) * 64;
        c.Dst = (bf16_t*)(ws + WS_WOUT) + (size_t)l * 1024 * 1024; c.Kd = 1024; c.drow = c.n0; return; } r -= CV_WOUT;
    if (r < 2 * CV_FF) { const int up = r / CV_FF, rr = r % CV_FF; c.W = up ? p.ffn_wu : p.ffn_wg; c.N = DFF; c.k0 = (rr / 44) * 64; c.n0 = (rr % 44) * 64;
        c.Dst = (bf16_t*)(ws + WS_WGU); c.Kd = 1024; c.drow = (c.n0 / 128) * 256 + (c.n0 % 128) + up * 128; return; } r -= 2 * CV_FF;
    { c.W = p.ffn_wd; c.N = 1024; c.k0 = (r / 16) * 64; c.n0 = (r % 16) * 64; c.Dst = (bf16_t*)(ws + WS_WDN); c.Kd = DFF; c.drow = c.n0; }
}
DI void conv_decode1(const Params& p, int r, ConvItem& c) {
    unsigned char* ws = p.ws;
    if (r < 16 * CV_ME) { const int up = r / (8 * CV_ME), r2 = r % (8 * CV_ME), e = r2 / CV_ME, rr = r2 % CV_ME;
        c.W = (up ? p.moe_wu : p.moe_wg) + (size_t)e * 1024 * DFFE; c.N = DFFE; c.k0 = (((rr >> 1) / 56) * 2 + (rr & 1)) * 64; c.n0 = ((rr >> 1) % 56) * 64;
        c.Dst = (bf16_t*)(ws + WS_WMGU + (size_t)e * 7168 * 1024); c.Kd = 1024; c.drow = (c.n0 / 128) * 256 + (c.n0 % 128) + up * 128; return; } r -= 16 * CV_ME;
    { const int e = r / CV_ME, rr = r % CV_ME; c.W = p.moe_wd + (size_t)e * DFFE * 1024; c.N = 1024; c.k0 = (((rr >> 1) / 16) * 2 + (rr & 1)) * 64; c.n0 = ((rr >> 1) % 16) * 64;
        c.Dst = (bf16_t*)(ws + WS_WMDN + (size_t)e * 1024 * DFFE); c.Kd = DFFE; c.drow = c.n0; }
}
template <int WHICH> DI void conv_phase(const Params& p, const Ctx& X) {
    LAS float* scr = (LAS float*)(X.lds + X.wid * 16640);
    const int gw = X.c * 8 + X.wid, ngw = X.G * 8, nit = WHICH ? CV_N1 : CV_N0;
    auto item = [&](int s) { return WHICH ? ((gw + (s >> 1) * ngw) * 2 + (s & 1)) : (gw + s * ngw); };
    if (item(0) >= nit) return;
    ConvItem c; if (WHICH) conv_decode1(p, item(0), c); else conv_decode0(p, item(0), c);
    f32x4 v[16]; conv_load(c, X.lane, v);
    for (int s = 0;; ++s) {
        const int nx = item(s + 1); const bool more = nx < nit;
        ConvItem cn = c; f32x4 vn[16];
        if (more) { if (WHICH) conv_decode1(p, nx, cn); else conv_decode0(p, nx, cn); conv_load(cn, X.lane, vn); }
        conv_store<WHICH != 0>(c, scr, X.lane, v);
        if (!more) break;
        c = cn;
#pragma unroll
        for (int i = 0; i < 16; ++i) v[i] = vn[i];
    }
}

DI void adaln_phase(const Params& p, const Ctx& X) {
    LAS float* sc = (LAS float*)X.lds;
    LAS float* part = sc + 9 * 1024;
    float* mod = (float*)(p.ws + WS_MOD);
    for (int g = X.c; g < 256; g += X.G) {
        const int l = g >> 7, n0 = (g & 127) * 48;
        for (int i = X.tid; i < 9 * 1024; i += 512) { const int r = i >> 10, k = i & 1023; const float cv = r < 8 ? p.c[r * 1024 + k] : p.c_ctx[k]; sc[i] = cv * sigm(cv); }
        __syncthreads();
        const int kq = X.tid >> 4, jq = X.tid & 15;
        float acc[9][3];
#pragma unroll
        for (int r = 0; r < 9; ++r) { acc[r][0] = 0.f; acc[r][1] = 0.f; acc[r][2] = 0.f; }
        const float* w = p.w_ada + (size_t)l * 1024 * 6144 + n0 + jq;
#pragma unroll 4
        for (int i = 0; i < 32; ++i) { const int k = kq + 32 * i; const float w0 = w[(size_t)k * 6144], w1 = w[(size_t)k * 6144 + 16], w2 = w[(size_t)k * 6144 + 32];
#pragma unroll
            for (int r = 0; r < 9; ++r) { const float s = sc[r * 1024 + k]; acc[r][0] += s * w0; acc[r][1] += s * w1; acc[r][2] += s * w2; } }
#pragma unroll
        for (int r = 0; r < 9; ++r)
#pragma unroll
            for (int j = 0; j < 3; ++j) part[kq * 432 + r * 48 + j * 16 + jq] = acc[r][j];
        __syncthreads();
        if (X.tid < 432) { const int r = X.tid / 48, j = X.tid % 48; float s = 0.f;
#pragma unroll 8
            for (int q = 0; q < 32; ++q) s += part[q * 432 + X.tid];
            mod[(size_t)(l * 9 + r) * 6144 + n0 + j] = s + p.b_ada[l * 6144 + n0 + j]; }
        __syncthreads();
    }
}
DI void rope_phase(const Params& p, const Ctx& X) {
    f32x2* tab = (f32x2*)(p.ws + WS_ROPE);
    float* lbt = (float*)(p.ws + WS_LB);
    for (int i = X.c * 512 + X.tid; i < 2048; i += X.G * 512) { const int l = i >> 10, dir = (i >> 9) & 1, ch = i & 511;
        const float p0 = p.hgrn_lb[(dir * 2 + 0) * 512 + ch], p1 = p.hgrn_lb[(dir * 2 + 1) * 512 + ch]; lbt[i] = l == 0 ? 0.f : 1.f / (1.f + expf(p0 - p1)); }
    for (int i = X.c * 512 + X.tid; i < 1024; i += X.G * 512) { const int pos = i >> 4, pp = i & 15;
        const float freq = powf(10000.f, -(float)pp / 16.f), ang = (float)pos * freq; tab[i] = (f32x2){cosf(ang), sinf(ang)}; }
}

template <bool F8> DI void norm_row(const float* xr, const float* g, const float* shift, const float* scale, bf16_t* orow, int lane, f32x4 (&hv)[4]) {
    f32x4 v[4]; float ss = 0.f;
#pragma unroll
    for (int j = 0; j < 4; ++j) { v[j] = *(const f32x4*)(xr + j * 256 + lane * 4); ss += (v[j][0] * v[j][0] + v[j][1] * v[j][1]) + (v[j][2] * v[j][2] + v[j][3] * v[j][3]); }
    const float rstd = rsqrtf(wave_sum(ss) * (1.f / D) + EPS);
#pragma unroll
    for (int j = 0; j < 4; ++j) { const int c = j * 256 + lane * 4;
        const f32x4 gg = *(const f32x4*)(g + c), sh = *(const f32x4*)(shift + c), sc = *(const f32x4*)(scale + c);
        const f32x4 h = (v[j] * rstd * gg) * (sc + 1.0f) + sh; hv[j] = h;
        if constexpr (F8) *(unsigned*)((unsigned char*)orow + c) = pk4_fp8(h[0], h[1], h[2], h[3]);
        else { u32x2 w; w.x = pk2(h[0], h[1]); w.y = pk2(h[2], h[3]); *(u32x2*)(orow + c) = w; } }
}
DI void norm_phase(const Params& p, const Ctx& X, int l, int which, bool first) {
    const float* xl = first ? p.x : p.out; const float* xc = first ? p.ctx : (const float*)(p.ws + WS_CTX);
    const float* g = (which ? p.g_norm2 : p.g_norm1) + l * D;
    const float* mod = (const float*)(p.ws + WS_MOD) + (size_t)l * 9 * 6144 + (which ? 3072 : 0);
    bf16_t* H = (bf16_t*)(p.ws + WS_H);
    const int rpb = (T + X.G - 1) / X.G, r0 = X.c * rpb, r1 = (r0 + rpb < T) ? r0 + rpb : T;
    f32x4 gg[4];
#pragma unroll
    for (int j = 0; j < 4; ++j) gg[j] = *(const f32x4*)(g + j * 256 + X.lane * 4);
    for (int R = r0 + X.wid; R < r1; R += 16) {
        const int Rb = (R + 8 < r1) ? R + 8 : R;
        f32x4 v[2][4], sh[2][4], sc[2][4]; float ss[2] = {0.f, 0.f};
#pragma unroll
        for (int q = 0; q < 2; ++q) { const int Rq = q ? Rb : R; int b, s; row_bs(Rq, b, s); const bool isc = s < CTXL;
            const float* xr = isc ? xc + (size_t)(b * CTXL + s) * D : xl + (size_t)(b * SEQ + s - CTXL) * D;
            const float* mr = mod + (size_t)(isc ? 8 : b) * 6144;
#pragma unroll
            for (int j = 0; j < 4; ++j) { const int c = j * 256 + X.lane * 4; v[q][j] = *(const f32x4*)(xr + c); sh[q][j] = *(const f32x4*)(mr + c); sc[q][j] = *(const f32x4*)(mr + 1024 + c); } }
#pragma unroll
        for (int q = 0; q < 2; ++q)
#pragma unroll
            for (int j = 0; j < 4; ++j) ss[q] += (v[q][j][0] * v[q][j][0] + v[q][j][1] * v[q][j][1]) + (v[q][j][2] * v[q][j][2] + v[q][j][3] * v[q][j][3]);
#pragma unroll
        for (int o = 1; o < 64; o <<= 1) { const float a = __shfl_xor(ss[0], o), b2 = __shfl_xor(ss[1], o); ss[0] += a; ss[1] += b2; }
#pragma unroll
        for (int q = 0; q < 2; ++q) { const int Rq = q ? Rb : R; const float rstd = rsqrtf(ss[q] * (1.f / D) + EPS); bf16_t* orow = H + (size_t)Rq * D;
#pragma unroll
            for (int j = 0; j < 4; ++j) { const int c = j * 256 + X.lane * 4; const f32x4 h = (v[q][j] * rstd * gg[j]) * (sc[q][j] + 1.0f) + sh[q][j];
                u32x2 w; w.x = pk2(h[0], h[1]); w.y = pk2(h[2], h[3]); *(u32x2*)(orow + c) = w; } }
    }
}
DI void norm2_router_phase(const Params& p, const Ctx& X) {
    const int l = 1;
    const float* g = p.g_norm2 + l * D;
    const float* mod = (const float*)(p.ws + WS_MOD) + (size_t)l * 9 * 6144 + 3072;
    bf16_t* H = (bf16_t*)(p.ws + WS_H);
    LAS float* wr = (LAS float*)X.lds;
    LAS int* hist = (LAS int*)(X.lds + 32768);
    for (int i = X.tid; i < 8192; i += 512) wr[i] = p.moe_router[i];
    if (X.tid < 16) hist[X.tid] = 0;
    int* tokt = (int*)(p.ws + WS_TOK);
    for (int i = X.c * 512 + X.tid; i < MAXROWS_MOE; i += X.G * 512) tokt[i] = -1;
    __syncthreads();
    const int tpb = (NLAT + X.G - 1) / X.G, n0 = X.c * tpb, n1 = (n0 + tpb < NLAT) ? n0 + tpb : NLAT;
    f32x4* route = (f32x4*)(p.ws + WS_ROUTE);
    f32x4 gg[4];
#pragma unroll
    for (int j = 0; j < 4; ++j) gg[j] = *(const f32x4*)(g + j * 256 + X.lane * 4);
    for (int n = n0 + X.wid; n < n1; n += 16) {
        const int nb = (n + 8 < n1) ? n + 8 : n, nq = (nb == n) ? 1 : 2;
        f32x4 v[2][4], sh[2][4], sc[2][4]; float ss[2] = {0.f, 0.f};
#pragma unroll
        for (int q = 0; q < 2; ++q) { const int nn = q ? nb : n; const float* xr = p.out + (size_t)nn * D; const float* mr = mod + (size_t)(nn >> 12) * 6144;
#pragma unroll
            for (int j = 0; j < 4; ++j) { const int c = j * 256 + X.lane * 4; v[q][j] = *(const f32x4*)(xr + c); sh[q][j] = *(const f32x4*)(mr + c); sc[q][j] = *(const f32x4*)(mr + 1024 + c); } }
#pragma unroll
        for (int q = 0; q < 2; ++q)
#pragma unroll
            for (int j = 0; j < 4; ++j) ss[q] += (v[q][j][0] * v[q][j][0] + v[q][j][1] * v[q][j][1]) + (v[q][j][2] * v[q][j][2] + v[q][j][3] * v[q][j][3]);
#pragma unroll
        for (int o = 1; o < 64; o <<= 1) { const float a = __shfl_xor(ss[0], o), b2 = __shfl_xor(ss[1], o); ss[0] += a; ss[1] += b2; }
        float lg[2][8];
#pragma unroll
        for (int q = 0; q < 2; ++q) {
            const int nn = q ? nb : n; const float rstd = rsqrtf(ss[q] * (1.f / D) + EPS);
            unsigned char* orow = (unsigned char*)H + (size_t)((nn >> 12) * SB + CTXL + (nn & 4095)) * D;
#pragma unroll
            for (int j = 0; j < 4; ++j) { const f32x4 h = (v[q][j] * rstd * gg[j]) * (sc[q][j] + 1.0f) + sh[q][j]; v[q][j] = h;
                if (q < nq) *(unsigned*)(orow + j * 256 + X.lane * 4) = pk4_fp8(h[0], h[1], h[2], h[3]); }
#pragma unroll
            for (int e = 0; e < 8; ++e) lg[q][e] = 0.f;
        }
#pragma unroll
        for (int j = 0; j < 4; ++j)
#pragma unroll
            for (int i = 0; i < 4; ++i) { const LAS f32x4* wp = (const LAS f32x4*)(wr + (j * 256 + X.lane * 4 + i) * 8); const f32x4 w0 = wp[0], w1 = wp[1];
#pragma unroll
                for (int q = 0; q < 2; ++q) { const float h = v[q][j][i];
                    lg[q][0] += h * w0[0]; lg[q][1] += h * w0[1]; lg[q][2] += h * w0[2]; lg[q][3] += h * w0[3]; lg[q][4] += h * w1[0]; lg[q][5] += h * w1[1]; lg[q][6] += h * w1[2]; lg[q][7] += h * w1[3]; } }
#pragma unroll
        for (int o = 1; o < 64; o <<= 1)
#pragma unroll
            for (int q = 0; q < 2; ++q)
#pragma unroll
                for (int e = 0; e < 8; ++e) lg[q][e] += __shfl_xor(lg[q][e], o);
        for (int q = 0; q < nq; ++q) {
            int e1 = 0; float v1 = lg[q][0];
#pragma unroll
            for (int e = 1; e < 8; ++e) if (lg[q][e] > v1) { v1 = lg[q][e]; e1 = e; }
            int e2 = -1; float v2 = -3.0e38f;
#pragma unroll
            for (int e = 0; e < 8; ++e) if (e != e1 && lg[q][e] > v2) { v2 = lg[q][e]; e2 = e; }
            const float w2 = 1.f / (1.f + expf(v1 - v2)), w1 = 1.f - w2;
            if (X.lane == 0) { route[q ? nb : n] = (f32x4){__int_as_float(e1), __int_as_float(e2), w1, w2}; atomicAdd((int*)&hist[e1], 1); atomicAdd((int*)&hist[8 + e2], 1); }
        }
    }
    __syncthreads();
    if (X.tid < 16) ((int*)(p.ws + WS_HIST))[X.c * 16 + X.tid] = hist[X.tid];
}

DI void readout_phase(const Params& p, const Ctx& X, int l) {
    const bf16_t* OF = (const bf16_t*)(p.ws + WS_OF); bf16_t* OB = (bf16_t*)(p.ws + WS_OB); const bf16_t* OG = (const bf16_t*)(p.ws + WS_OG);
    const float* gn = p.hgrn_gnorm + l * 512 + X.lane * 8;
    const f32x4 g0 = *(const f32x4*)gn, g1 = *(const f32x4*)(gn + 4);
    const int rpb = (T + X.G - 1) / X.G, r0 = X.c * rpb, r1 = (r0 + rpb < T) ? r0 + rpb : T;
    for (int R = r0 + X.wid; R < r1; R += 16) {
        const int Rb = (R + 8 < r1) ? R + 8 : R;
        u32x4 a[2], bb[2], gg[2];
#pragma unroll
        for (int q = 0; q < 2; ++q) { const size_t o = (size_t)(q ? Rb : R) * 512 + X.lane * 8; a[q] = *(const u32x4*)(OF + o); bb[q] = *(const u32x4*)(OB + o); gg[q] = *(const u32x4*)(OG + o); }
        const int nq = (Rb == R) ? 1 : 2;
        for (int q = 0; q < nq; ++q) {
            const int Rq = q ? Rb : R;
            if (l == 1) { int b, s; row_bs(Rq, b, s); if (s < CTXL) continue; }
            float v[8], qv[8];
            v[0] = bflo(a[q].x) + bflo(bb[q].x); v[1] = bfhi(a[q].x) + bfhi(bb[q].x); v[2] = bflo(a[q].y) + bflo(bb[q].y); v[3] = bfhi(a[q].y) + bfhi(bb[q].y);
            v[4] = bflo(a[q].z) + bflo(bb[q].z); v[5] = bfhi(a[q].z) + bfhi(bb[q].z); v[6] = bflo(a[q].w) + bflo(bb[q].w); v[7] = bfhi(a[q].w) + bfhi(bb[q].w);
            qv[0] = bflo(gg[q].x); qv[1] = bfhi(gg[q].x); qv[2] = bflo(gg[q].y); qv[3] = bfhi(gg[q].y); qv[4] = bflo(gg[q].z); qv[5] = bfhi(gg[q].z); qv[6] = bflo(gg[q].w); qv[7] = bfhi(gg[q].w);
            float ss = 0.f;
#pragma unroll
            for (int i = 0; i < 8; ++i) ss += v[i] * v[i];
            ss += __shfl_xor(ss, 1); ss += __shfl_xor(ss, 2); ss += __shfl_xor(ss, 4); ss += __shfl_xor(ss, 8);
            const float rstd = rsqrtf(ss * (1.f / 128.f) + EPS);
            float y[8];
#pragma unroll
            for (int i = 0; i < 8; ++i) y[i] = v[i] * rstd * (i < 4 ? g0[i] : g1[i - 4]) * (qv[i] * sigm(qv[i]));
            u32x4 w; w.x = pk2(y[0], y[1]); w.y = pk2(y[2], y[3]); w.z = pk2(y[4], y[5]); w.w = pk2(y[6], y[7]);
            *(u32x4*)(OB + (size_t)Rq * 512 + X.lane * 8) = w;
        }
    }
}

DI void final_phase(const Params& p, const Ctx& X) {
    const bf16_t* y0 = (const bf16_t*)(p.ws + WS_Y0); const bf16_t* y1 = (const bf16_t*)(p.ws + WS_Y1);
    const float* gate = (const float*)(p.ws + WS_MOD) + (size_t)9 * 6144 + 5120;
    const int rpb = (NLAT + X.G - 1) / X.G, r0 = X.c * rpb, r1 = (r0 + rpb < NLAT) ? r0 + rpb : NLAT;
    f32x4 gf[4];
#pragma unroll
    for (int j = 0; j < 4; ++j) gf[j] = *(const f32x4*)(p.g_final + j * 256 + X.lane * 4);
    for (int n = r0 + X.wid; n < r1; n += 16) {
        const int nb = (n + 8 < r1) ? n + 8 : n;
        f32x4 v[2][4], gt[2][4]; u32x2 ya[2][4], yb[2][4]; float ss[2] = {0.f, 0.f};
#pragma unroll
        for (int q = 0; q < 2; ++q) { const int nq_ = q ? nb : n; const size_t o = (size_t)nq_ * D; const float* gr = gate + (size_t)(nq_ >> 12) * 6144;
#pragma unroll
            for (int j = 0; j < 4; ++j) { const int c = j * 256 + X.lane * 4; v[q][j] = *(const f32x4*)(p.out + o + c); ya[q][j] = *(const u32x2*)(y0 + o + c); yb[q][j] = *(const u32x2*)(y1 + o + c); gt[q][j] = *(const f32x4*)(gr + c); } }
#pragma unroll
        for (int q = 0; q < 2; ++q)
#pragma unroll
            for (int j = 0; j < 4; ++j) {
                const f32x4 ys = (f32x4){bflo(ya[q][j].x), bfhi(ya[q][j].x), bflo(ya[q][j].y), bfhi(ya[q][j].y)} + (f32x4){bflo(yb[q][j].x), bfhi(yb[q][j].x), bflo(yb[q][j].y), bfhi(yb[q][j].y)};
                v[q][j] = v[q][j] + gt[q][j] * ys;
                ss[q] += (v[q][j][0] * v[q][j][0] + v[q][j][1] * v[q][j][1]) + (v[q][j][2] * v[q][j][2] + v[q][j][3] * v[q][j][3]); }
#pragma unroll
        for (int o = 1; o < 64; o <<= 1) { const float a = __shfl_xor(ss[0], o), b2 = __shfl_xor(ss[1], o); ss[0] += a; ss[1] += b2; }
        const int nq = (nb == n) ? 1 : 2;
        for (int q = 0; q < nq; ++q) { const float rstd = rsqrtf(ss[q] * (1.f / D) + EPS); float* xr = p.out + (size_t)(q ? nb : n) * D;
#pragma unroll
            for (int j = 0; j < 4; ++j) *(f32x4*)(xr + j * 256 + X.lane * 4) = v[q][j] * rstd * gf[j]; }
    }
}

DI int crow(int r, int hi) { return (r & 3) + 8 * (r >> 2) + 4 * hi; }
DI void hgrn_phase(const Params& p, const Ctx& X, int l) {
    const bf16_t* P1 = (const bf16_t*)(p.ws + WS_P1);
    constexpr int BUFB = 54272;
    LAS unsigned char* SFb = X.lds + 2 * BUFB;
    const int tid = X.tid, lane = X.lane, wid = X.wid, l31 = lane & 31, hi = lane >> 5;
    const int pw = wid - 4;
    for (int un = X.c; un < 256; un += X.G) {
        const int unit = (X.G == 256) ? ((((un & 7) * 4 + (un >> 6)) << 3) | ((un >> 3) & 7)) : un;
        const int b = unit >> 5, h = (unit >> 3) & 3, dir = (unit >> 2) & 1, vs = unit & 3;
        bf16_t* O = (bf16_t*)(p.ws + (dir ? WS_OB : WS_OF));
        const size_t rowbase = (size_t)b * SB;
        auto srcrow = [&](int jp) -> int { return dir == 0 ? jp : (jp < CTXL ? (CTXL - 1 - jp) : (SB + CTXL - 1 - jp)); };
        struct Pref { u32x4 rl[4], rqv[4]; };
        Pref PA, PB;
        const int half = pw >> 1, khalf = pw & 1, sgn = dir ? -1 : 1;
        auto gload = [&](int c, Pref& P) {
            int ln = lane; asm volatile("" : "+v"(ln)); const int kch = ln & 7, tseg = ln >> 3;
            const size_t R0 = rowbase + srcrow(c * 64 + 32 * half + 4 * tseg); const bf16_t* rp = P1 + R0 * P1LD + h * 128 + 64 * khalf + 8 * kch;
#pragma unroll
            for (int i = 0; i < 4; ++i) { P.rl[i] = *(const u32x4*)(rp + (ptrdiff_t)(i * sgn) * P1LD + 512 + dir * 512); P.rqv[i] = *(const u32x4*)(rp + (ptrdiff_t)(i * sgn) * P1LD); }
        };
        constexpr int NCH = SB / 64;
        if (wid >= 4) {
            auto produce = [&](int c, Pref& P) {
                if (c < NCH) {
                    LAS unsigned char* B = X.lds + (c & 1) * BUFB;
#pragma unroll
                    for (int i = 0; i < 4; ++i) asm volatile("" : "+v"(P.rl[i]), "+v"(P.rqv[i]) :: "memory");
                    int ln = lane; asm volatile("" : "+v"(ln)); const int kch = ln & 7, tseg = ln >> 3;
                    const bool first = half == 0; const int sig = first ? 7 - tseg : tseg, sdir = first ? 8 : -8;
                    float f[4][8];
#pragma unroll
                    for (int i = 0; i < 4; ++i) { const unsigned w[4] = {P.rl[i].x, P.rl[i].y, P.rl[i].z, P.rl[i].w};
#pragma unroll
                        for (int e = 0; e < 8; ++e) f[i][e] = __builtin_amdgcn_exp2f((e & 1) ? bfhi(w[e >> 1]) : bflo(w[e >> 1])); }
                    u32x4 qraw[4];
#pragma unroll
                    for (int i = 0; i < 4; ++i) qraw[i] = P.rqv[i];
                    if (c + 2 < NCH) gload(c + 2, P);
                    float Xp[8], Tt[8], yy[8];
                    const int a1 = (ln + sdir) << 2, a2 = (ln + 2 * sdir) << 2, a4 = (ln + 4 * sdir) << 2;
#pragma unroll
                    for (int e = 0; e < 8; ++e) Tt[e] = (f[0][e] * f[1][e]) * (f[2][e] * f[3][e]);
#pragma unroll
                    for (int e = 0; e < 8; ++e) yy[e] = __int_as_float(__builtin_amdgcn_ds_bpermute(a1, __float_as_int(Tt[e])));
#pragma unroll
                    for (int e = 0; e < 8; ++e) Xp[e] = (sig >= 1) ? yy[e] : 1.f;
#pragma unroll
                    for (int e = 0; e < 8; ++e) yy[e] = __int_as_float(__builtin_amdgcn_ds_bpermute(a1, __float_as_int(Xp[e])));
#pragma unroll
                    for (int e = 0; e < 8; ++e) Xp[e] = (sig >= 1) ? Xp[e] * yy[e] : Xp[e];
#pragma unroll
                    for (int e = 0; e < 8; ++e) yy[e] = __int_as_float(__builtin_amdgcn_ds_bpermute(a2, __float_as_int(Xp[e])));
#pragma unroll
                    for (int e = 0; e < 8; ++e) Xp[e] = (sig >= 2) ? Xp[e] * yy[e] : Xp[e];
#pragma unroll
                    for (int e = 0; e < 8; ++e) yy[e] = __int_as_float(__builtin_amdgcn_ds_bpermute(a4, __float_as_int(Xp[e])));
#pragma unroll
                    for (int e = 0; e < 8; ++e) Xp[e] = (sig >= 4) ? Xp[e] * yy[e] : Xp[e];
                    if (sig == 7) {
                        LAS f32x4* ep = (LAS f32x4*)(B + 53248) + (128 * half + 64 * khalf + 8 * kch) / 4;
                        ep[0] = (f32x4){Xp[0] * Tt[0], Xp[1] * Tt[1], Xp[2] * Tt[2], Xp[3] * Tt[3]}; ep[1] = (f32x4){Xp[4] * Tt[4], Xp[5] * Tt[5], Xp[6] * Tt[6], Xp[7] * Tt[7]};
                    }
                    const int g16 = 4 * khalf + (kch >> 1), ka = kch & 1, sg = 2 * half + (tseg >> 2), sa = (tseg >> 1) & 1, sh = tseg & 1;
                    auto emit = [&](auto firstc) {
                        constexpr bool FIRST = decltype(firstc)::value;
#pragma unroll
                        for (int eh = 0; eh < 2; ++eh) {
                            float kt[4][4];
#pragma unroll
                            for (int i = 0; i < 4; ++i) {
                                const unsigned qw0 = eh ? qraw[i].z : qraw[i].x, qw1 = eh ? qraw[i].w : qraw[i].y;
                                float qt[4];
#pragma unroll
                                for (int e4 = 0; e4 < 4; ++e4) { const int e = 4 * eh + e4;
                                    const float pre = (i == 0) ? f[0][e] : (i == 1) ? f[0][e] * f[1][e] : (i == 2) ? (f[0][e] * f[1][e]) * f[2][e] : (f[0][e] * f[1][e]) * (f[2][e] * f[3][e]);
                                    const float suf = (i == 3) ? 1.f : (i == 2) ? f[3][e] : (i == 1) ? f[3][e] * f[2][e] : (f[3][e] * f[2][e]) * f[1][e];
                                    const float esm = (FIRST ? suf : pre) * Xp[e], ebig = __builtin_amdgcn_rcpf(fmaxf(esm, 1e-30f));
                                    const float qq = (e4 == 0) ? bflo(qw0) : (e4 == 1) ? bfhi(qw0) : (e4 == 2) ? bflo(qw1) : bfhi(qw1);
                                    qt[e4] = qq * (FIRST ? ebig : esm); kt[i][e4] = (1.f - f[i][e]) * (FIRST ? esm : ebig); }
                                const int t = 32 * half + 4 * tseg + i, o = t * 256 + (((2 * g16 + eh) ^ (t & 15)) << 4) + ka * 8;
                                u32x2 qv, kv; qv.x = pk2(qt[0], qt[1]); qv.y = pk2(qt[2], qt[3]); kv.x = pk2(kt[i][0], kt[i][1]); kv.y = pk2(kt[i][2], kt[i][3]);
                                *(LAS u32x2*)(B + o) = qv; *(LAS u32x2*)(B + 16384 + o) = kv;
                            }
#pragma unroll
                            for (int e4 = 0; e4 < 4; ++e4) { const int k = 64 * khalf + 8 * kch + 4 * eh + e4; u32x2 w2; w2.x = pk2(kt[0][e4], kt[1][e4]); w2.y = pk2(kt[2][e4], kt[3][e4]);
                                *(LAS u32x2*)(B + 32768 + k * 128 + (((2 * sg + sh) ^ ((k >> 1) & 7)) << 4) + sa * 8) = w2; }
                        }
                    };
                    if (first) emit(std::true_type{}); else emit(std::false_type{});
                }
            };
            static_assert(NCH % 2 == 0, "producer loop is unrolled by two");
            gload(0, PA); gload(1, PB);
            for (int c = 0; c < NCH; c += 2) { produce(c, PA); __syncthreads(); produce(c + 1, PB); __syncthreads(); }
            __syncthreads();
        } else if (wid < 2) {
            f32x16 S[2];
#pragma unroll
            for (int r = 0; r < 16; ++r) { S[0][r] = 0.f; S[1][r] = 0.f; }
            u32x4 rvv[2];
            auto vload = [&](int c) {
                int tq = tid; asm volatile("" : "+v"(tq));
#pragma unroll
                for (int j = 0; j < 2; ++j) { const int pc = tq + 128 * j; const size_t Rv = rowbase + srcrow(c * 64 + (pc >> 2));
                    rvv[j] = *(const u32x4*)(P1 + Rv * P1LD + 1536 + h * 128 + vs * 32 + (pc & 3) * 8); }
            };
            vload(0);
            for (int c = 0; c <= NCH; ++c) {
                if (c < NCH) {
                    asm volatile("" : "+v"(rvv[0]), "+v"(rvv[1]) :: "memory");
                    LAS unsigned char* Bw = X.lds + (c & 1) * BUFB;
                    int tq = tid; asm volatile("" : "+v"(tq));
#pragma unroll
                    for (int j = 0; j < 2; ++j) { const int pc = tq + 128 * j, s = pc >> 2, sl = s & 15, sa = sl >> 3, sh = (sl >> 2) & 1, si = sl & 3, sc = (s >> 4) * 2 + sh;
                        const unsigned w[4] = {rvv[j].x, rvv[j].y, rvv[j].z, rvv[j].w};
#pragma unroll
                        for (int e = 0; e < 8; ++e) { const int v = (pc & 3) * 8 + e; const bf16_t val = (bf16_t)((e & 1) ? (w[e >> 1] >> 16) : (w[e >> 1] & 0xffffu));
                            *(LAS bf16_t*)(Bw + 49152 + v * 128 + ((sc ^ ((v >> 1) & 7)) << 4) + (4 * sa + si) * 2) = val; } }
                    if (c + 1 < NCH) vload(c + 1);
                }
                if (c >= 1) {
                    const LAS unsigned char* B = X.lds + ((c - 1) & 1) * BUFB;
                    const LAS float* ERC = (const LAS float*)(B + 53248);
#pragma unroll
                    for (int j = 0; j < 2; ++j) {
                        const int kr = 32 * (2 * wid + j), k = kr + l31;
                        f32x16 W;
#pragma unroll
                        for (int g = 0; g < 4; ++g) { const f32x4 er = *(const LAS f32x4*)(ERC + kr + 8 * g + 4 * hi);
#pragma unroll
                            for (int i = 0; i < 4; ++i) W[4 * g + i] = S[j][4 * g + i] * er[i]; }
#pragma unroll
                        for (int ks = 0; ks < 4; ++ks) {
                            const bf16x8 ak = *(const LAS bf16x8*)(B + 32768 + k * 128 + (((2 * ks + hi) ^ ((k >> 1) & 7)) << 4));
                            const bf16x8 bv = *(const LAS bf16x8*)(B + 49152 + l31 * 128 + (((2 * ks + hi) ^ ((l31 >> 1) & 7)) << 4));
                            W = __builtin_amdgcn_mfma_f32_32x32x16_bf16(ak, bv, W, 0, 0, 0);
                        }
#pragma unroll
                        for (int g = 0; g < 4; ++g) { const f32x4 ec = *(const LAS f32x4*)(ERC + 128 + kr + 8 * g + 4 * hi);
#pragma unroll
                            for (int i = 0; i < 4; ++i) S[j][4 * g + i] = W[4 * g + i] * ec[i]; }
                    }
                }
                if (c < NCH) {
                    LAS unsigned char* SF = SFb + (c & 1) * 8192;
#pragma unroll
                    for (int j = 0; j < 2; ++j)
#pragma unroll
                        for (int s = 0; s < 2; ++s) { u32x4 aw; aw.x = pk2(S[j][8 * s], S[j][8 * s + 1]); aw.y = pk2(S[j][8 * s + 2], S[j][8 * s + 3]);
                            aw.z = pk2(S[j][8 * s + 4], S[j][8 * s + 5]); aw.w = pk2(S[j][8 * s + 6], S[j][8 * s + 7]);
                            *(LAS u32x4*)(SF + (((2 * wid + j) * 2 + s) * 64 + lane) * 16) = aw; }
                }
                __syncthreads();
            }
        } else {
            for (int c = 0; c <= NCH; ++c) {
                if (c >= 1) {
                    const LAS unsigned char* B = X.lds + ((c - 1) & 1) * BUFB;
                    const LAS float* ERC = (const LAS float*)(B + 53248);
                    const LAS unsigned char* SF = SFb + ((c - 1) & 1) * 8192;
                    const int tb = wid - 2, t = 32 * tb + l31;
                    f32x16 oacc;
#pragma unroll
                    for (int r = 0; r < 16; ++r) oacc[r] = 0.f;
                    for (int sb = 0; sb <= tb; ++sb) {
                        f32x16 at;
#pragma unroll
                        for (int r = 0; r < 16; ++r) at[r] = 0.f;
                        const int s = 32 * sb + l31;
#pragma unroll
                        for (int ks = 0; ks < 8; ++ks) {
                            const bf16x8 ak = *(const LAS bf16x8*)(B + 16384 + s * 256 + (((2 * ks + hi) ^ (s & 15)) << 4));
                            const bf16x8 bq = *(const LAS bf16x8*)(B + t * 256 + (((2 * ks + hi) ^ (t & 15)) << 4));
                            at = __builtin_amdgcn_mfma_f32_32x32x16_bf16(ak, bq, at, 0, 0, 0);
                        }
                        if (sb == tb) {
#pragma unroll
                            for (int r = 0; r < 16; ++r) at[r] = (crow(r, hi) <= l31) ? at[r] : 0.f;
                        }
#pragma unroll
                        for (int s2 = 0; s2 < 2; ++s2) {
                            u32x4 pw4; pw4.x = pk2(at[8 * s2], at[8 * s2 + 1]); pw4.y = pk2(at[8 * s2 + 2], at[8 * s2 + 3]); pw4.z = pk2(at[8 * s2 + 4], at[8 * s2 + 5]); pw4.w = pk2(at[8 * s2 + 6], at[8 * s2 + 7]);
                            const bf16x8 av = *(const LAS bf16x8*)(B + 49152 + l31 * 128 + ((((2 * sb + s2) * 2 + hi) ^ ((l31 >> 1) & 7)) << 4));
                            oacc = __builtin_amdgcn_mfma_f32_32x32x16_bf16(av, __builtin_bit_cast(bf16x8, pw4), oacc, 0, 0, 0);
                        }
                    }
#pragma unroll
                    for (int kb = 0; kb < 4; ++kb)
#pragma unroll
                        for (int s = 0; s < 2; ++s) {
                            const bf16x8 as = *(const LAS bf16x8*)(SF + ((kb * 2 + s) * 64 + lane) * 16);
                            const u32x4 bw = *(const LAS u32x4*)(B + t * 256 + ((((2 * kb + s) * 2 + hi) ^ (t & 15)) << 4));
                            const f32x4 e0 = *(const LAS f32x4*)(ERC + 32 * kb + 16 * s + 4 * hi), e1 = *(const LAS f32x4*)(ERC + 32 * kb + 16 * s + 8 + 4 * hi);
                            u32x4 bs; bs.x = pk2(bflo(bw.x) * e0[0], bfhi(bw.x) * e0[1]); bs.y = pk2(bflo(bw.y) * e0[2], bfhi(bw.y) * e0[3]);
                            bs.z = pk2(bflo(bw.z) * e1[0], bfhi(bw.z) * e1[1]); bs.w = pk2(bflo(bw.w) * e1[2], bfhi(bw.w) * e1[3]);
                            oacc = __builtin_amdgcn_mfma_f32_32x32x16_bf16(as, __builtin_bit_cast(bf16x8, bs), oacc, 0, 0, 0);
                        }
                    const size_t R = rowbase + srcrow((c - 1) * 64 + t);
                    bf16_t* orow = O + R * 512 + h * 128 + vs * 32 + 4 * hi;
#pragma unroll
                    for (int g = 0; g < 4; ++g) { u32x2 w2; w2.x = pk2(oacc[4 * g], oacc[4 * g + 1]); w2.y = pk2(oacc[4 * g + 2], oacc[4 * g + 3]); *(u32x2*)(orow + 8 * g) = w2; }
                }
                __syncthreads();
            }
        }
    }
}

DI void mlp_phase(const Params& p, const Ctx& X, int l) {
    const bf16_t* P1 = (const bf16_t*)(p.ws + WS_P1); bf16_t* YB = (bf16_t*)(p.ws + WS_YB);
    LAS unsigned char* vT = X.lds;
    const int tid = X.tid, lane = X.lane, wid = X.wid, hi = lane >> 5, l31 = lane & 31;
    const int nch = l ? 32 : 34, nunits = NBATCH * nch;
    for (int u = X.c; u < nunits; u += X.G) {
        const int b = u / nch, ch = u % nch + (l ? 2 : 0);
        const size_t R0 = (size_t)b * SB + ch * 128;
        const int tok = tid >> 2, part = tid & 3;
        const bf16_t* vrow = P1 + (R0 + tok) * P1LD + 2560;
        float ss = 0.f;
#pragma unroll 4
        for (int q = 0; q < 16; ++q) { const u32x4 raw = *(const u32x4*)(vrow + part * 128 + q * 8);
            const float a0 = bflo(raw.x), a1 = bfhi(raw.x), a2 = bflo(raw.y), a3 = bfhi(raw.y), a4 = bflo(raw.z), a5 = bfhi(raw.z), a6 = bflo(raw.w), a7 = bfhi(raw.w);
            ss += (a0 * a0 + a1 * a1) + (a2 * a2 + a3 * a3) + (a4 * a4 + a5 * a5) + (a6 * a6 + a7 * a7); }
        ss += __shfl_xor(ss, 1); ss += __shfl_xor(ss, 2);
        const float rstd = rsqrtf(ss * (1.f / 512.f) + EPS);
        for (int g = 0; g < 4; ++g) {
            __syncthreads();
#pragma unroll
            for (int q = 0; q < 4; ++q) {
                const int d0 = part * 32 + q * 8;
                const u32x4 raw = *(const u32x4*)(vrow + g * 128 + d0);
                const float* vn = p.mlp_vnorm + l * 512 + g * 128 + d0;
                float a[8]; a[0] = bflo(raw.x); a[1] = bfhi(raw.x); a[2] = bflo(raw.y); a[3] = bfhi(raw.y); a[4] = bflo(raw.z); a[5] = bfhi(raw.z); a[6] = bflo(raw.w); a[7] = bfhi(raw.w);
#pragma unroll
                for (int e = 0; e < 8; ++e) { const int d = d0 + e; const unsigned w = pk2(a[e] * rstd * vn[e], 0.f);
                    *(LAS bf16_t*)(vT + d * 256 + (((tok >> 3) ^ (d & 15)) << 4) + (tok & 7) * 2) = (bf16_t)(w & 0xffffu); }
            }
            __syncthreads();
            const int tblk = wid & 3, dp = wid >> 2;
            f32x16 acc[2];
#pragma unroll
            for (int r = 0; r < 16; ++r) { acc[0][r] = 0.f; acc[1][r] = 0.f; }
            const float* wsr = p.mlp_ws + ((size_t)(l * 4 + g) * 128 + tblk * 32 + l31) * 128 + 8 * hi;
#pragma unroll
            for (int ks = 0; ks < 8; ++ks) {
                const f32x4 w0 = *(const f32x4*)(wsr + ks * 16), w1 = *(const f32x4*)(wsr + ks * 16 + 4);
                u32x4 aw; aw.x = pk2(w0[0], w0[1]); aw.y = pk2(w0[2], w0[3]); aw.z = pk2(w1[0], w1[1]); aw.w = pk2(w1[2], w1[3]);
                const bf16x8 A = __builtin_bit_cast(bf16x8, aw);
#pragma unroll
                for (int j2 = 0; j2 < 2; ++j2) { const int d = (dp * 2 + j2) * 32 + l31;
                    const bf16x8 Bf = *(const LAS bf16x8*)(vT + d * 256 + (((2 * ks + hi) ^ (d & 15)) << 4));
                    acc[j2] = __builtin_amdgcn_mfma_f32_32x32x16_bf16(A, Bf, acc[j2], 0, 0, 0); }
            }
#pragma unroll
            for (int j2 = 0; j2 < 2; ++j2) { const int d = (dp * 2 + j2) * 32 + l31;
#pragma unroll
                for (int r = 0; r < 16; ++r) { const int t = tblk * 32 + crow(r, hi);
                    const float mixed = acc[j2][r] + p.mlp_bs[(l * 4 + g) * 128 + t];
                    const float uu = bf1(P1[(R0 + t) * P1LD + 2048 + g * 128 + d]);
                    YB[(R0 + t) * 512 + g * 128 + d] = (bf16_t)(pk2(uu * mixed, 0.f) & 0xffffu); } }
        }
        __syncthreads();
    }
}

typedef short v4i16_t __attribute__((ext_vector_type(4)));
DI s16x4 vtr(const LAS unsigned char* pp) { return __builtin_bit_cast(s16x4, __builtin_amdgcn_ds_read_tr16_b64_v4i16((LAS v4i16_t*)pp)); }
DI void glds16(const void* gsrc, unsigned lds_dst) { unsigned keep;
    asm volatile("s_mov_b32 %0, m0\n\ts_mov_b32 m0, %2\n\ts_nop 0\n\tglobal_load_lds_dwordx4 %1, off\n\ts_mov_b32 m0, %0" : "=&s"(keep) : "v"(gsrc), "s"(lds_dst) : "memory"); }
DI void attn_unit(const Params& p, const Ctx& X, int l, int b, int h, int s0, int kbeg, int nk, float lam, float lam_init) {
    const bf16_t* P1 = (const bf16_t*)(p.ws + WS_P1); bf16_t* YC = (bf16_t*)(p.ws + WS_YC);
    int ln_ = X.lane; asm volatile("" : "+v"(ln_));
    const int lane = ln_, wid = X.wid, hi = lane >> 5, l31 = lane & 31;
    const int cc = wid >> 2, qs = s0 + (wid & 3) * 32;
    const size_t rowbase = (size_t)b * SB;
    LAS unsigned char* Kbuf = X.lds;
    LAS unsigned char* Vbuf = X.lds + 49152;
    LAS float* Xb = (LAS float*)X.lds + (wid & 3) * 4096;
    bf16x8 bq[4];
    { const bf16_t* qp = P1 + (rowbase + qs + l31) * P1LD + 3072 + h * 128 + cc * 64 + 8 * hi;
#pragma unroll
      for (int s = 0; s < 4; ++s) bq[s] = *(const bf16x8*)(qp + 16 * s); }
    const bf16_t* kbase = P1 + (rowbase + kbeg) * P1LD + 3584 + h * 128;
    const int krow = 8 * wid + (lane >> 3), kch = (lane & 7) ^ ((krow >> 1) & 7);
    const unsigned koff = (unsigned)(krow * P1LD + kch * 8) * 2u;
    const unsigned voff0 = (unsigned)((((wid & 3) * 16 + (lane >> 2)) * P1LD) + 512 + (wid >> 2) * 32 + (lane & 3) * 8) * 2u;
    const unsigned kl0 = (unsigned)(size_t)Kbuf + wid * 1024, vl0 = (unsigned)(size_t)Vbuf + wid * 1024;
    auto dma_k = [&](int kt, int slot) {
        const char* g = (const char*)(kbase + (size_t)kt * 64 * P1LD);
#pragma unroll
        for (int c2 = 0; c2 < 2; ++c2) glds16(g + koff + c2 * 128, (unsigned)__builtin_amdgcn_readfirstlane((int)(kl0 + slot * 16384 + c2 * 8192)));
    };
    auto dma_v = [&](int kt, int slot) {
        const char* g = (const char*)(kbase + (size_t)kt * 64 * P1LD);
#pragma unroll
        for (int j = 0; j < 2; ++j) glds16(g + voff0 + j * 128, (unsigned)__builtin_amdgcn_readfirstlane((int)(vl0 + slot * 16384 + j * 8192)));
    };
    auto qk = [&](f32x16 (&st)[2], int slot) {
        const LAS unsigned char* Kb = Kbuf + slot * 16384 + cc * 8192;
#pragma unroll
        for (int kb = 0; kb < 2; ++kb) {
#pragma unroll
            for (int r = 0; r < 16; ++r) st[kb][r] = 0.f;
            const int row = 32 * kb + l31;
#pragma unroll
            for (int s = 0; s < 4; ++s) { const bf16x8 a = *(const LAS bf16x8*)(Kb + row * 128 + (((2 * s + hi) ^ ((row >> 1) & 7)) << 4));
                st[kb] = __builtin_amdgcn_mfma_f32_32x32x16_bf16(a, bq[s], st[kb], 0, 0, 0); }
        }
    };
    float m = -1.0e30f, lsum = 0.f;
    f32x16 ot[4];
#pragma unroll
    for (int k = 0; k < 4; ++k)
#pragma unroll
        for (int r = 0; r < 16; ++r) ot[k][r] = 0.f;
    const int vbase = (4 * hi + ((lane & 15) >> 2)) * 64 + ((lane >> 4) & 1) * 32 + (lane & 3) * 8;
    f32x16 sc[2], sn[2];
    dma_k(0, 0); dma_v(0, 0); dma_k(1, 1);
    dma_k(2, 2); dma_v(1, 1);
    asm volatile("s_waitcnt vmcnt(4)" ::: "memory"); __builtin_amdgcn_s_barrier();
    qk(sc, 0);
    asm volatile("s_waitcnt lgkmcnt(0)" ::: "memory"); __builtin_amdgcn_s_barrier();
    int s0k = 0, s1k = 1;
    for (int kt = 0; kt < nk; ++kt) {
        const int s2k = 3 - s0k - s1k;
        const bool full = kt + 3 < nk;
        if (full) { dma_k(kt + 3, s0k); dma_v(kt + 2, s2k); }
        else if (kt + 2 < nk) dma_v(kt + 2, s2k);
        if (kt + 1 < nk) qk(sn, s1k);
        const LAS unsigned char* Vb = Vbuf + s0k * 16384 + vbase;
        bf16x8 vf[4][4];
#pragma unroll
        for (int ks = 0; ks < 4; ++ks)
#pragma unroll
            for (int blk = 0; blk < 4; ++blk) { const s16x4 lo = vtr(Vb + (blk * 4 + ks) * 1024), hh = vtr(Vb + (blk * 4 + ks) * 1024 + 512);
                vf[ks][blk] = (bf16x8){lo[0], lo[1], lo[2], lo[3], hh[0], hh[1], hh[2], hh[3]}; }
        float mx = sc[0][0];
#pragma unroll
        for (int r = 0; r < 16; ++r) { mx = fmaxf(mx, sc[0][r]); mx = fmaxf(mx, sc[1][r]); }
        mx = fmaxf(mx, __shfl_xor(mx, 32));
        if (__any(mx > m)) {
            const float mnew = fmaxf(m, mx), alpha = __builtin_amdgcn_exp2f(m - mnew); m = mnew; lsum *= alpha;
#pragma unroll
            for (int k = 0; k < 4; ++k)
#pragma unroll
                for (int r = 0; r < 16; ++r) ot[k][r] *= alpha;
        }
        float ps = 0.f;
#pragma unroll
        for (int kb = 0; kb < 2; ++kb)
#pragma unroll
            for (int r = 0; r < 16; ++r) { const float e = __builtin_amdgcn_exp2f(sc[kb][r] - m); sc[kb][r] = e; ps += e; }
        lsum += ps;
#pragma unroll
        for (int ks = 0; ks < 4; ++ks)
#pragma unroll
            for (int blk = 0; blk < 4; ++blk) asm volatile("" : "+v"(vf[ks][blk]));
#pragma unroll
        for (int ks = 0; ks < 4; ++ks) {
            const int kb = ks >> 1, s2 = ks & 1;
            u32x4 pw; pw.x = pk2(sc[kb][8 * s2 + 0], sc[kb][8 * s2 + 1]); pw.y = pk2(sc[kb][8 * s2 + 2], sc[kb][8 * s2 + 3]);
            pw.z = pk2(sc[kb][8 * s2 + 4], sc[kb][8 * s2 + 5]); pw.w = pk2(sc[kb][8 * s2 + 6], sc[kb][8 * s2 + 7]);
            const bf16x8 pf = __builtin_bit_cast(bf16x8, pw);
#pragma unroll
            for (int blk = 0; blk < 4; ++blk) ot[blk] = __builtin_amdgcn_mfma_f32_32x32x16_bf16(vf[ks][blk], pf, ot[blk], 0, 0, 0);
        }
#pragma unroll
        for (int kb = 0; kb < 2; ++kb) sc[kb] = sn[kb];
        if (full) asm volatile("s_waitcnt vmcnt(4) lgkmcnt(0)" ::: "memory"); else asm volatile("s_waitcnt vmcnt(0) lgkmcnt(0)" ::: "memory");
        __builtin_amdgcn_s_barrier();
        s0k = s1k; s1k = s2k;
    }
    const float ltot = lsum + __shfl_xor(lsum, 32), inv = 1.f / ltot;
    if (cc == 1) {
#pragma unroll
        for (int k = 0; k < 4; ++k)
#pragma unroll
            for (int r = 0; r < 16; ++r) Xb[(k * 16 + r) * 64 + lane] = ot[k][r] * inv;
    }
    __syncthreads();
    if (cc == 0) {
        float ss = 0.f;
#pragma unroll
        for (int k = 0; k < 4; ++k)
#pragma unroll
            for (int r = 0; r < 16; ++r) { const float o = ot[k][r] * inv - lam * Xb[(k * 16 + r) * 64 + lane]; ot[k][r] = o; ss += o * o; }
        ss += __shfl_xor(ss, 32);
        const float scl = rsqrtf(ss * (1.f / 128.f) + EPS) * (1.f - lam_init);
        bf16_t* yrow = YC + (rowbase + qs + l31) * 512 + h * 128;
        const float* gsub = p.diff_subln + l * 512 + h * 128;
#pragma unroll
        for (int k = 0; k < 4; ++k)
#pragma unroll
            for (int r4 = 0; r4 < 4; ++r4) { const int dv = 32 * k + 8 * r4 + 4 * hi; const f32x4 gg = *(const f32x4*)(gsub + dv);
                u32x2 w; w.x = pk2(ot[k][4 * r4] * scl * gg[0], ot[k][4 * r4 + 1] * scl * gg[1]); w.y = pk2(ot[k][4 * r4 + 2] * scl * gg[2], ot[k][4 * r4 + 3] * scl * gg[3]);
                *(u32x2*)(yrow + dv) = w; }
    }
    __syncthreads();
}
DI void attn_phase(const Params& p, const Ctx& X, int l) {
    const float lam_init = 0.8f - 0.6f * expf(-0.3f * (float)l);
    LAS float* misc = (LAS float*)(X.lds + LDS_MISC);
    if (X.wid == 0) { const float* lp = p.diff_lambda + l * 256; float a = lp[X.lane] * lp[64 + X.lane], b2 = lp[128 + X.lane] * lp[192 + X.lane];
        a = wave_sum(a); b2 = wave_sum(b2); if (X.lane == 0) misc[0] = expf(a) - expf(b2) + lam_init; }
    __syncthreads();
    const float lam = misc[0];
    const int nlat = (1024 - X.c + X.G - 1) / X.G, nctx = (l == 0 && X.c < 64) ? (64 - X.c + X.G - 1) / X.G : 0;
    for (int it = 0; it < nlat + nctx; ++it) {
        int b, h, s0, nk;
        if (it < nlat) {
            int bh, qb;
            if (X.G == 256) { bh = 4 * (X.c & 7) + it; qb = X.c >> 3; } else { const int U = it * X.G + X.c; bh = U >> 5; qb = U & 31; }
            b = bh >> 2; h = bh & 3; s0 = CTXL + qb * 128; nk = SB / 64;
        } else { const int U = (it - nlat) * X.G + X.c; b = U >> 3; h = (U >> 1) & 3; s0 = (U & 1) * 128; nk = CTXL / 64; }
        attn_unit(p, X, l, b, h, s0, 0, nk, lam, lam_init);
    }
}

DI void moe_scatter_phase(const Params& p, const Ctx& X) {
    LAS int* tot = (LAS int*)X.lds;
    LAS int* e1s = tot + 64;
    LAS int* e2s = e1s + 128;
    LAS int* pos0 = e2s + 128;
    LAS int* pos1 = pos0 + 128;
    const int* hist = (const int*)(p.ws + WS_HIST);
    const int tid = X.tid;
    LAS int* hl = tot + 1024;
    LAS int* ps = hl + 4096;
    for (int i = tid; i < X.G * 4; i += 512) ((LAS u32x4*)hl)[i] = ((const u32x4*)hist)[i];
    __syncthreads();
    { const int g = tid & 15, part = tid >> 4; int t = 0, mb = 0;
#pragma unroll
        for (int k = 0; k < 8; ++k) { const int cb = part * 8 + k; if (cb < X.G) { const int v = hl[cb * 16 + g]; t += v; mb += (cb < X.c) ? v : 0; } }
        ps[part * 32 + g] = t; ps[part * 32 + 16 + g] = mb; }
    __syncthreads();
    if (tid < 16) { int t = 0, mb = 0;
        for (int part = 0; part < 32; ++part) { t += ps[part * 32 + tid]; mb += ps[part * 32 + 16 + tid]; }
        tot[tid] = t; tot[16 + tid] = mb; }
    __syncthreads();
    if (tid == 0) { int tb = 0; for (int g = 0; g < 16; ++g) { tot[32 + g] = tb; tot[48 + g] = tb * 256; tb += (tot[g] + 255) >> 8; }
        if (X.c == 0) { int* grp = (int*)(p.ws + WS_GRP); for (int g = 0; g < 16; ++g) { grp[g] = tot[32 + g]; grp[16 + g] = (tot[g] + 255) >> 8; } } }
    const int tpb = (NLAT + X.G - 1) / X.G, n0 = X.c * tpb, n1 = (n0 + tpb < NLAT) ? n0 + tpb : NLAT, cnt = n1 - n0;
    const f32x4* route = (const f32x4*)(p.ws + WS_ROUTE);
    f32x4 rt = (f32x4){0.f, 0.f, 0.f, 0.f};
    if (tid < cnt) { rt = route[n0 + tid]; e1s[tid] = __float_as_int(rt[0]); e2s[tid] = __float_as_int(rt[1]); }
    __syncthreads();
    if (tid < cnt) {
        const int e1 = __float_as_int(rt[0]), e2 = __float_as_int(rt[1]); int r0 = 0, r1 = 0;
        for (int j = 0; j < tid; ++j) { r0 += (e1s[j] == e1) ? 1 : 0; r1 += (e2s[j] == e2) ? 1 : 0; }
        const int q0 = tot[48 + e1] + tot[16 + e1] + r0, q1 = tot[48 + 8 + e2] + tot[16 + 8 + e2] + r1;
        pos0[tid] = q0; pos1[tid] = q1;
        int* tokt = (int*)(p.ws + WS_TOK); float* wrow = (float*)(p.ws + WS_WROW);
        tokt[q0] = n0 + tid; wrow[q0] = rt[2]; tokt[q1] = n0 + tid; wrow[q1] = rt[3];
    }
    __syncthreads();
    const unsigned char* H = p.ws + WS_H; unsigned char* Xs = p.ws + WS_XS;
    for (int j = X.wid; j < cnt; j += 32) {
        u32x4 v0[4];
#pragma unroll
        for (int q = 0; q < 4; ++q) { const int jq = j + 8 * q; if (jq < cnt) { const int n = n0 + jq, b = n >> 12, t = n & 4095; const size_t R = (size_t)b * SB + CTXL + t; v0[q] = *(const u32x4*)(H + R * D + X.lane * 16); } }
#pragma unroll
        for (int q = 0; q < 4; ++q) { const int jq = j + 8 * q; if (jq < cnt) { *(u32x4*)(Xs + (size_t)pos0[jq] * D + X.lane * 16) = v0[q]; *(u32x4*)(Xs + (size_t)pos1[jq] * D + X.lane * 16) = v0[q]; } }
    }
}
DI void moe_order_setup(const Params& p, const Ctx& X, int g0, int ng, int npn, LAS int* tab) {
    const int* grp = (const int*)(p.ws + WS_GRP);
    if (X.tid == 0) { int cu = 0; for (int j = 0; j < ng; ++j) { tab[j] = cu; cu += grp[16 + g0 + j] * npn; tab[32 + j] = grp[g0 + j]; } tab[ng] = cu; }
    __syncthreads();
}

#define XB_TMO      128
#define XB_XCNT(j)  (256  + 64 * (j))
#define XB_XSUB(j)  (1280 + 64 * (j))
#define XB_XGEN(j)  (2304 + 64 * (j))
#define XB_TOP      3328
#define XB_TOPGEN   3392
#define XCD_BAR_WORDS 3456
#define XB_SPIN_CAP (1u << 18)
__device__ __forceinline__ unsigned xb_ld(unsigned* p)              { return __hip_atomic_load(p, __ATOMIC_RELAXED, __HIP_MEMORY_SCOPE_AGENT); }
__device__ __forceinline__ unsigned xb_add(unsigned* p, unsigned v) { return __hip_atomic_fetch_add(p, v, __ATOMIC_RELAXED, __HIP_MEMORY_SCOPE_AGENT); }
__device__ __forceinline__ unsigned xb_xcc_id() { return (unsigned)__builtin_amdgcn_s_getreg((3 << 11) | 20) & 0xFu; }
#define XB_SPIN(cond, bar) do { unsigned _sp = 0; while (cond) { __builtin_amdgcn_s_sleep(1); \
    if ((++_sp & 255u) == 0u) { if (xb_ld(&(bar)[XB_TMO])) break; if (_sp > XB_SPIN_CAP) { atomicAdd(&(bar)[XB_TMO], 1u); break; } } } } while (0)
struct XcdBarrier { unsigned* bar; unsigned x; volatile LAS unsigned* st; };
__device__ __forceinline__ XcdBarrier xcd_barrier_post(unsigned* bar, volatile LAS unsigned* st) {
    XcdBarrier b; b.bar = bar; b.x = xb_xcc_id(); b.st = st;
    if (threadIdx.x == 0) (void)xb_add(&bar[XB_XCNT(b.x)], 1u);
    return b;
}
__device__ __forceinline__ void xcd_barrier_complete(unsigned* bar, unsigned x, unsigned& nloc, unsigned& nx) {
    const unsigned G = gridDim.x * gridDim.y * gridDim.z;
    unsigned sum, cnt, mine, sp = 0u;
    for (;;) {
        sum = 0u; cnt = 0u; mine = 0u;
#pragma unroll 1
        for (unsigned j = 0; j < 16; ++j) { const unsigned c = xb_ld(&bar[XB_XCNT(j)]); sum += c; cnt += (c > 0u) ? 1u : 0u; mine = (j == x) ? c : mine; }
        if (sum == G) break;
        __builtin_amdgcn_s_sleep(1);
        if ((++sp & 255u) == 0u) { if (xb_ld(&bar[XB_TMO])) break; if (sp > XB_SPIN_CAP) { atomicAdd(&bar[XB_TMO], 1u); break; } }
    }
    nloc = mine > 0u ? mine : 1u; nx = cnt > 0u ? cnt : 1u;
}
__device__ __forceinline__ void xcd_barrier(const XcdBarrier& b) {
    asm volatile("s_waitcnt vmcnt(0)" ::: "memory");
    __syncthreads();
    if (threadIdx.x == 0) {
        unsigned* bar = b.bar;
        __builtin_amdgcn_s_waitcnt(0);
        unsigned nloc = b.st[0], nx = b.st[1];
        if (nloc == 0u) { xcd_barrier_complete(bar, b.x, nloc, nx); b.st[0] = nloc; b.st[1] = nx; }
        const unsigned old = xb_add(&bar[XB_XSUB(b.x)], 1u);
        const unsigned gen = old / nloc;
        if (old + 1u == (gen + 1u) * nloc) {
            __builtin_amdgcn_fence(__ATOMIC_RELEASE, "agent");
            asm volatile("s_waitcnt vmcnt(0)" ::: "memory");
            const unsigned og = xb_add(&bar[XB_TOP], 1u);
            const unsigned tg = og / nx;
            if (og + 1u == (tg + 1u) * nx) xb_add(&bar[XB_TOPGEN], 1u);
            else XB_SPIN(xb_ld(&bar[XB_TOPGEN]) == tg, bar);
            __builtin_amdgcn_fence(__ATOMIC_ACQUIRE, "agent");
            xb_add(&bar[XB_XGEN(b.x)], 1u);
            asm volatile("s_waitcnt vmcnt(0)" ::: "memory");
        } else {
            XB_SPIN(xb_ld(&bar[XB_XGEN(b.x)]) == gen, bar);
            __builtin_amdgcn_fence(__ATOMIC_ACQUIRE, "agent");
            asm volatile("s_waitcnt vmcnt(0)" ::: "memory");
        }
    }
    __syncthreads();
}

constexpr int NPHASE = 21;
__global__ void __launch_bounds__(512, 2) mega(Params p) {
    extern __shared__ __attribute__((aligned(16))) unsigned char smem[];
    Ctx X; X.lds = (LAS unsigned char*)smem; X.tid = threadIdx.x; X.lane = X.tid & 63; X.wid = __builtin_amdgcn_readfirstlane(X.tid >> 6); X.G = gridDim.x; X.c = blockIdx.x; X.ws = p.ws;
    volatile LAS unsigned* barw = (volatile LAS unsigned*)(X.lds + LDS_BARW);
    if (X.tid < 4) barw[X.tid] = 0u;
    __syncthreads();
    XcdBarrier bar; bar.bar = (unsigned*)(p.ws + WS_CTL); bar.x = 0; bar.st = barw;
    const int lo = p.lo, hi = p.hi;
    if (hi - lo > 1) bar = xcd_barrier_post((unsigned*)(p.ws + WS_CTL), barw);
#define IN(k) (lo <= (k) && (k) < hi)
#define FRESH() do { int t_ = threadIdx.x; asm volatile("" : "+v"(t_)); X.tid = t_; X.lane = t_ & 63; X.wid = __builtin_amdgcn_readfirstlane(t_ >> 6); } while (0)
#define EN(s) (((EN_MASK) >> (s)) & 1)
#define NREP(s) ((((REP_MASK) >> (s)) & 1) ? 2 : 1)
#define SEAM(k) do { if (IN(k) && IN((k) + 1)) xcd_barrier(bar); } while (0)
#define SITE_PTRS() unsigned char* ws = p.ws; asm volatile("" : "+s"(ws)); float* mod = (float*)(ws + WS_MOD); bf16_t* Hb = (bf16_t*)(ws + WS_H); (void)mod; (void)Hb

    if (EN(0) && IN(0)) { FRESH(); conv_phase<0>(p, X); __syncthreads(); if (NREP(0) == 2) { conv_phase<0>(p, X); __syncthreads(); } adaln_phase(p, X); rope_phase(p, X); __syncthreads(); }
    SEAM(0);
    auto layer = [&](auto lc) {
        constexpr int l = decltype(lc)::value;
        const int pb = 1 + 9 * l;
        if (EN(1) && IN(pb + 0)) for (int rep = 0; rep < NREP(1); ++rep) { FRESH(); norm_phase(p, X, l, 0, l == 0); }
        SEAM(pb + 0);
        if (EN(2) && IN(pb + 1)) {
            SITE_PTRS(); const bf16_t* Win = (const bf16_t*)(ws + WS_WIN) + (size_t)l * 8192 * 1024;
            pg8::Gemm g{Hb, Win, 1024}; TileOrder S; S.init(NMT, 20, X.G, X.c, 0, 0); S.reps = NREP(2);
            LAS float* ropeL = (LAS float*)(X.lds + 131072); LAS float* lbL = (LAS float*)(X.lds + LDS_MISC + 2048);
            __syncthreads();
            for (int i = threadIdx.x; i < 2048; i += 512) ropeL[i] = ((const float*)(ws + WS_ROPE))[i];
            for (int i = threadIdx.x; i < 1024; i += 512) lbL[i] = ((const float*)(ws + WS_LB))[l * 1024 + i];
            __syncthreads();
            EpiInproj E{(bf16_t*)(ws + WS_P1), (bf16_t*)(ws + WS_OG), (const LAS f32x2*)ropeL, (const LAS float*)lbL};
            pg8::gemm_phase<EpiInproj, TileOrder>(X.lds, g, S, E);
        }
        SEAM(pb + 1);
        if (IN(pb + 2)) { if (EN(3)) for (int rep = 0; rep < NREP(3); ++rep) { FRESH(); hgrn_phase(p, X, l); } __syncthreads(); if (EN(4)) for (int rep = 0; rep < NREP(4); ++rep) { FRESH(); mlp_phase(p, X, l); } __syncthreads(); if (EN(5)) for (int rep = 0; rep < NREP(5); ++rep) { FRESH(); attn_phase(p, X, l); } }
        SEAM(pb + 2);
        if (EN(6) && IN(pb + 3)) {
            SITE_PTRS(); const bf16_t* Win = (const bf16_t*)(ws + WS_WIN) + (size_t)l * 8192 * 1024;
            FRESH(); readout_phase(p, X, l);
            pg8::Gemm g{Hb, Win, 1024}; TileOrder S; S.init(l ? 128 : NMT, 12, X.G, X.c, l, 20);
            EpiStore<1> E{(bf16_t*)(ws + WS_G), 3072};
            S.reps = NREP(6); pg8::gemm_phase<EpiStore<1>, TileOrder>(X.lds, g, S, E);
        }
        SEAM(pb + 3);
        if (EN(7) && IN(pb + 4)) for (int rep = 0; rep < NREP(7); ++rep) {
            SITE_PTRS();
            pg8::Gemm g{(const bf16_t*)(ws + WS_OB), (const bf16_t*)(ws + WS_WBR) + (size_t)l * 3 * 1024 * 512, 512};
            MergeOrder S; S.t.init(l ? 128 : NMT, 4, X.G, X.c, l, 0);
            EpiMerge E{(bf16_t*)(ws + WS_MRG), (const bf16_t*)(ws + WS_G)};
            pg8::gemm_phase<EpiMerge, MergeOrder, true, false, true>(X.lds, g, S, E);
        }
        SEAM(pb + 4);
        if (EN(8) && IN(pb + 5)) {
            SITE_PTRS();
            pg8::Gemm g{(const bf16_t*)(ws + WS_MRG), (const bf16_t*)(ws + WS_WOUT) + (size_t)l * 1024 * 1024, 1024};
            TileOrder S; S.init(l ? 128 : NMT, 4, X.G, X.c, l, 0);
            EpiResid E{l == 0 ? p.x : p.out, l == 0 ? p.ctx : (const float*)(ws + WS_CTX), p.out, (float*)(ws + WS_CTX), mod + (size_t)l * 9 * 6144 + 2048};
            pg8::gemm_phase<EpiResid, TileOrder>(X.lds, g, S, E);
        }
        SEAM(pb + 5);
        if (EN(9) && IN(pb + 6)) { __syncthreads(); FRESH(); if (l == 0) norm_phase(p, X, 0, 1, false); else { norm2_router_phase(p, X); __syncthreads(); conv_phase<1>(p, X); if (NREP(9) == 2) { __syncthreads(); conv_phase<1>(p, X); } } }
        SEAM(pb + 6);
        if constexpr (l == 0) {
            if (EN(10) && IN(8)) {
                SITE_PTRS();
                pg8::Gemm g{Hb, (const bf16_t*)(ws + WS_WGU), 1024}; TileOrder S; S.init(NMT, 22, X.G, X.c, 0, 0); S.reps = NREP(10);
                EpiSwiglu E{(bf16_t*)(ws + WS_HID), DFF};
                pg8::gemm_phase<EpiSwiglu, TileOrder>(X.lds, g, S, E);
            }
            SEAM(8);
            if (EN(11) && IN(9)) {
                SITE_PTRS();
                pg8::Gemm g{(const bf16_t*)(ws + WS_HID), (const bf16_t*)(ws + WS_WDN), DFF}; TileOrder S; S.init(NMT, 4, X.G, X.c, 0, 0);
                EpiResid E{p.out, (const float*)(ws + WS_CTX), p.out, (float*)(ws + WS_CTX), mod + 5120};
                pg8::gemm_phase<EpiResid, TileOrder>(X.lds, g, S, E);
            }
            SEAM(9);
        }
    };
    layer(std::integral_constant<int, 0>{}); layer(std::integral_constant<int, 1>{});
    if (EN(12) && IN(17)) for (int rep = 0; rep < NREP(12); ++rep) { __syncthreads(); FRESH(); moe_scatter_phase(p, X); }
    SEAM(17);
    {
        LAS int* tab = (LAS int*)(X.lds + LDS_MISC + 1024);
        if (EN(13) && IN(18)) for (int rep = 0; rep < NREP(13); ++rep) {
            SITE_PTRS();
            __syncthreads(); moe_order_setup(p, X, 0, 16, 28, tab);
            pg8::Gemm g{(const bf16_t*)(ws + WS_XS), (const bf16_t*)(ws + WS_WMGU), 512};
            MoeOrder S{tab, 16, 28, X.G, X.c, 0};
            EpiSwigluT<true> E{(bf16_t*)(ws + WS_HS), DFFE};
            pg8::gemm_phase<EpiSwigluT<true>, MoeOrder, true, true>(X.lds, g, S, E);
        }
        SEAM(18);
        if (EN(14) && IN(19)) {
            SITE_PTRS();
            __syncthreads(); moe_order_setup(p, X, 0, 16, 4, tab);
            pg8::Gemm g{(const bf16_t*)(ws + WS_HS), (const bf16_t*)(ws + WS_WMDN), DFFE / 2};
            MoeOrder S{tab, 16, 4, X.G, X.c, 0};
            EpiMoeDown E{(const int*)(ws + WS_TOK), (const float*)(ws + WS_WROW), (bf16_t*)(ws + WS_Y0), (bf16_t*)(ws + WS_Y1)};
            pg8::gemm_phase<EpiMoeDown, MoeOrder, true, true>(X.lds, g, S, E);
        }
        SEAM(19);
    }
    if (EN(15) && IN(20)) { FRESH(); final_phase(p, X); }
#undef IN
#undef SEAM
}

extern "C" void kernel_launch(void* const* d_in, const int* in_sizes, int n_in, void* d_out, int out_size, void* d_ws, size_t ws_size, hipStream_t stream) {
    static int grid = 0;
    if (grid == 0) {
        if (n_in != 26 || ws_size < WS_END) { fprintf(stderr, "kernel_launch: unexpected n_in %d / ws_size %zu (need %zu)\n", n_in, ws_size, (size_t)WS_END); grid = -1; return; }
        int dev = 0, cus = 0;
        if (hipGetDevice(&dev) != hipSuccess || hipDeviceGetAttribute(&cus, hipDeviceAttributeMultiprocessorCount, dev) != hipSuccess) { grid = -1; return; }
        if (hipFuncSetAttribute((const void*)mega, hipFuncAttributeMaxDynamicSharedMemorySize, LDS_BYTES) != hipSuccess) { fprintf(stderr, "kernel_launch: hipFuncSetAttribute failed\n"); grid = -1; return; }
        int per_cu = 0;
        if (hipOccupancyMaxActiveBlocksPerMultiprocessor(&per_cu, (const void*)mega, 512, LDS_BYTES) != hipSuccess || per_cu < 1) fprintf(stderr, "kernel_launch: occupancy query reports %d\n", per_cu);
        (void)hipGetLastError();
        grid = cus < 256 ? cus : 256;
    }
    if (grid < 0) return;
    (void)hipMemsetAsync((char*)d_ws + WS_CTL, 0, CTL_ZERO_BYTES, stream);
    Params p{};
    const float** pp = (const float**)&p;
    for (int i = 0; i < 26; ++i) pp[i] = (const float*)d_in[i];
    p.out = (float*)d_out; p.ws = (unsigned char*)d_ws;
#if MK_SPLIT
    for (int k = 0; k < NPHASE; ++k) { if (k == 16) {} p.lo = k; p.hi = k + 1; hipLaunchKernelGGL(mega, dim3(grid), dim3(512), LDS_BYTES, stream, p); }
#else
    p.lo = 0; p.hi = NPHASE;
    hipLaunchKernelGGL(mega, dim3(grid), dim3(512), LDS_BYTES, stream, p);
#endif
}
```

```cpp
#include <hip/hip_runtime.h>
#include <stdint.h>
#include <stdio.h>
#include <type_traits>

#ifndef EN_MASK
#define EN_MASK 0xFFFF
#endif
#ifndef REP_MASK
#define REP_MASK 0
#endif
#ifndef MK_SPLIT
#define MK_SPLIT 0
#endif

#define DI __device__ __forceinline__
#define LAS __attribute__((address_space(3)))
typedef unsigned short bf16_t;
typedef short bf16x8 __attribute__((ext_vector_type(8)));
typedef short s16x4 __attribute__((ext_vector_type(4)));
typedef float f32x2 __attribute__((ext_vector_type(2)));
typedef float f32x4 __attribute__((ext_vector_type(4)));
typedef float f32x16 __attribute__((ext_vector_type(16)));
typedef unsigned u32x2 __attribute__((ext_vector_type(2)));
typedef unsigned u32x4 __attribute__((ext_vector_type(4)));
typedef __bf16 bf16x2_t __attribute__((ext_vector_type(2)));
typedef int v8i32 __attribute__((ext_vector_type(8)));

constexpr int D = 1024, NBATCH = 8, SEQ = 4096, CTXL = 256;
constexpr int SB = SEQ + CTXL;
constexpr int T = NBATCH * SB;
constexpr int NMT = T / 256;
constexpr int NLAT = NBATCH * SEQ;
constexpr int INCOLS = 8192, P1LD = 4608, DFF = 2816, DFFE = 3584, NEXP = 8;
constexpr float EPS = 1e-6f;
constexpr int MAXROWS_MOE = 69632;

constexpr size_t MiB = (size_t)1 << 20;
constexpr size_t WS_CTL = 0;
constexpr size_t CTL_ZERO_BYTES = 65536;
constexpr size_t WS_MOD = 1 * MiB;
constexpr size_t WS_ROPE = 1 * MiB + 512 * 1024;
constexpr size_t WS_ROUTE = 2 * MiB;
constexpr size_t WS_HIST = 3 * MiB;
constexpr size_t WS_TOK = 4 * MiB;
constexpr size_t WS_WROW = 5 * MiB;
constexpr size_t WS_GRP = 6 * MiB;
constexpr size_t WS_LB = 7 * MiB;
constexpr size_t WS_CTX = 9 * MiB;
constexpr size_t WS_WIN = 17 * MiB;
constexpr size_t WS_WBR = 49 * MiB;
constexpr size_t WS_WOUT = 55 * MiB;
constexpr size_t WS_WGU = 59 * MiB;
constexpr size_t WS_WDN = 70 * MiB;
constexpr size_t WS_H = 77 * MiB;
constexpr size_t WS_P1 = 145 * MiB;
constexpr size_t WS_OG = 451 * MiB;
constexpr size_t WS_OF = 485 * MiB;
constexpr size_t WS_OB = 519 * MiB;
constexpr size_t WS_YB = 553 * MiB;
constexpr size_t WS_YC = 587 * MiB;
constexpr size_t WS_G = 145 * MiB;
constexpr size_t WS_MRG = 383 * MiB;
constexpr size_t WS_HID = 145 * MiB;
constexpr size_t WS_WMGU = 469 * MiB;
constexpr size_t WS_WMDN = 525 * MiB;
constexpr size_t WS_XS = 333 * MiB;
constexpr size_t WS_HS = 17 * MiB;
constexpr size_t WS_Y1 = 333 * MiB;
constexpr size_t WS_Y0 = 397 * MiB;
constexpr size_t WS_END = 637 * MiB;
static_assert(WS_WDN + (size_t)1024 * DFF * 2 <= WS_H, "weights");
static_assert(WS_P1 + (size_t)T * P1LD * 2 <= WS_OG && WS_G + (size_t)T * 3072 * 2 <= WS_MRG && WS_MRG + (size_t)T * 1024 * 2 <= WS_OG, "arena");
static_assert(WS_YC + (size_t)T * 512 * 2 <= WS_END && WS_WMGU + (size_t)8 * 7168 * 1024 <= WS_WMDN && WS_WMDN + (size_t)8 * 1024 * DFFE <= WS_END, "arena end");
static_assert(WS_XS + (size_t)MAXROWS_MOE * 1024 <= WS_WMGU && WS_HS + (size_t)MAXROWS_MOE * DFFE <= WS_XS && WS_HID + (size_t)T * DFF * 2 <= WS_END, "moe");

constexpr int LDS_BYTES = 147456;
constexpr int LDS_MISC = 139264;
constexpr int LDS_BARW = LDS_BYTES - 16;

struct Params {
    const float *x, *c, *ctx, *c_ctx, *w_ada, *b_ada, *g_norm1, *g_norm2, *w_in, *hgrn_lb, *hgrn_gnorm, *mlp_vnorm, *mlp_ws, *mlp_bs,
        *diff_lambda, *diff_subln, *w_branch, *w_out, *ffn_wg, *ffn_wu, *ffn_wd, *moe_router, *moe_wg, *moe_wu, *moe_wd, *g_final;
    float* out; unsigned char* ws; int lo, hi;
};

DI unsigned pk2(float lo, float hi) { f32x2 v = {lo, hi}; bf16x2_t b = __builtin_convertvector(v, bf16x2_t); return __builtin_bit_cast(unsigned, b); }
DI float bflo(unsigned u) { return __uint_as_float(u << 16); }
DI float bfhi(unsigned u) { return __uint_as_float(u & 0xffff0000u); }
DI float bf1(bf16_t u) { return __uint_as_float((unsigned)u << 16); }
DI float wave_sum(float v) {
#pragma unroll
    for (int o = 1; o < 64; o <<= 1) v += __shfl_xor(v, o);
    return v;
}
DI float sigm(float x) { return __builtin_amdgcn_rcpf(1.f + __builtin_amdgcn_exp2f(-1.4426950408889634f * x)); }
DI float gelu_tanh(float x) { const float u = 0.7978845608028654f * (x + 0.044715f * x * x * x); return x * __builtin_amdgcn_rcpf(1.f + __builtin_amdgcn_exp2f(-2.885390081777927f * u)); }
#define LDS_WAIT() asm volatile("s_waitcnt lgkmcnt(0)" ::: "memory")
DI unsigned pk4_fp8(float a, float b, float c, float d) {
    a = __builtin_amdgcn_fmed3f(a, -448.f, 448.f); b = __builtin_amdgcn_fmed3f(b, -448.f, 448.f); c = __builtin_amdgcn_fmed3f(c, -448.f, 448.f); d = __builtin_amdgcn_fmed3f(d, -448.f, 448.f);
    int w = __builtin_amdgcn_cvt_pk_fp8_f32(a, b, 0, false); w = __builtin_amdgcn_cvt_pk_fp8_f32(c, d, w, true); return (unsigned)w; }
constexpr float W8SCALE = 64.f;

namespace pg8 {
constexpr int BM = 256, BK = 64, HALF = 128, HTB = HALF * BK * 2, STAGE_BYTES = 8 * HTB;
__host__ __device__ __forceinline__ int lds_byte(int r, int c) { const int st = (r >> 4) * 2 + (c >> 5), rr = r & 15, cc = c & 31, ob = rr * 64 + cc * 2; return st * 1024 + (ob ^ (((ob >> 9) & 1) << 5)); }
__host__ __device__ __forceinline__ void stage_rc(int b, int& R, int& C) { const int st = b / 1024, sb = b % 1024, swz = sb ^ (((sb >> 9) & 1) << 5); R = (st >> 1) * 16 + swz / 64; C = (st & 1) * 32 + (swz % 64) / 2; }
__host__ __device__ __forceinline__ int perm32(int rho) { const int n = rho >> 4, i = rho & 15; return 8 * (i >> 2) + 4 * n + (i & 3); }

struct Unit { int pm, pn, pa, pb, aux; };
struct Gemm { const bf16_t* A; const bf16_t* Bt; int K; };

template <class Epi, class Sched, bool ALIGN_EPI = true, bool FP8 = false, bool CHAIN = false>
DI void gemm_phase(LAS unsigned char* lds, const Gemm g, const Sched& S, const Epi& E) {
    int tid_ = threadIdx.x; asm volatile("" : "+v"(tid_));
    const int tid = tid_, wid = __builtin_amdgcn_readfirstlane(tid >> 6), lane = tid & 63, wr = wid >> 2, wc = wid & 3, fr = lane & 15, fq = lane >> 4;
    const int K = g.K, nt = K / BK;
    unsigned voffA[2], voffB[2];
#pragma unroll
    for (int i = 0; i < 2; ++i) { int R, C; stage_rc(tid * 16 + i * 8192, R, C); const int Rb = Epi::PERM ? ((R & ~31) + perm32(R & 31)) : R;
        voffA[i] = (unsigned)(R * K + C) * 2u; voffB[i] = (unsigned)(Rb * K + C) * 2u; }
    const size_t kstep = (size_t)(BK * 2);
    const size_t hstep = (size_t)HALF * K * 2;
    const size_t tstep = 2 * hstep;
    const unsigned ldsw = (unsigned)wid * 1024u;
    const int aoff = lds_byte(wr * 64 + fr, fq * 8), boff = lds_byte(wc * 32 + fr, fq * 8);
#define PG8_SA(b, h) (((b) * 2 + (h)) * HTB)
#define PG8_SB(b, h) ((4 + (b) * 2 + (h)) * HTB)
#define PG8_STAGE(bufoff, gbase, voff) do { _Pragma("unroll") for (int _i = 0; _i < 2; ++_i) { unsigned vo_ = (voff)[_i]; asm volatile("" : "+v"(vo_));     \
        __builtin_amdgcn_global_load_lds((const unsigned*)((const char*)(gbase) + vo_), (LAS unsigned*)(lds + (bufoff) + ldsw + _i * 8192), 16, 0, 0); } } while (0)
typedef int v4i32_ __attribute__((ext_vector_type(4)));
#define PG8_LDA(dst, b, h) do { _Pragma("unroll") for (int m = 0; m < 4; ++m) { if constexpr (FP8) { const v4i32_ lo_ = *(const LAS v4i32_*)(lds + PG8_SA(b, h) + aoff + m * 2048), hi_ = *(const LAS v4i32_*)(lds + PG8_SA(b, h) + aoff + m * 2048 + 1024); \
            dst##8[m] = __builtin_shufflevector(lo_, hi_, 0, 1, 2, 3, 4, 5, 6, 7); } else { _Pragma("unroll") for (int k = 0; k < 2; ++k) dst[m][k] = *(const LAS bf16x8*)(lds + PG8_SA(b, h) + aoff + m * 2048 + k * 1024); } } } while (0)
#define PG8_LDB(dst, b, h) do { _Pragma("unroll") for (int n = 0; n < 2; ++n) { if constexpr (FP8) { const v4i32_ lo_ = *(const LAS v4i32_*)(lds + PG8_SB(b, h) + boff + n * 2048), hi_ = *(const LAS v4i32_*)(lds + PG8_SB(b, h) + boff + n * 2048 + 1024); \
            dst##8[n] = __builtin_shufflevector(lo_, hi_, 0, 1, 2, 3, 4, 5, 6, 7); } else { _Pragma("unroll") for (int k = 0; k < 2; ++k) dst[n][k] = *(const LAS bf16x8*)(lds + PG8_SB(b, h) + boff + n * 2048 + k * 1024); } } } while (0)
#define PG8_MMA(ai, bj, At, Bt) do { __builtin_amdgcn_s_setprio(1); _Pragma("unroll") for (int m = 0; m < 4; ++m) _Pragma("unroll") for (int n = 0; n < 2; ++n) { \
        if constexpr (FP8) asm volatile("v_mfma_scale_f32_16x16x128_f8f6f4 %0, %1, %2, %0, %3, %3 op_sel_hi:[0,0,0]" : "+v"(acc[ai][bj][m][n]) : "v"(Bt##8[n]), "v"(At##8[m]), "v"(sc7f));   \
        else { _Pragma("unroll") for (int k = 0; k < 2; ++k) acc[ai][bj][m][n] = __builtin_amdgcn_mfma_f32_16x16x32_bf16(Bt[n][k], At[m][k], acc[ai][bj][m][n], 0, 0, 0); } } \
        __builtin_amdgcn_s_setprio(0); } while (0)
#define PG8_WAIT_V(n) asm volatile("s_waitcnt vmcnt(" #n ")" ::: "memory")
#define PG8_WAIT_L(n) asm volatile("s_waitcnt lgkmcnt(" #n ")" ::: "memory")
#define PG8_BAR __builtin_amdgcn_s_barrier()
#define PG8_SCHED __builtin_amdgcn_sched_barrier(0)
    Unit cur, nxt; int ui = 0;
    if (!S.next(0, cur)) return;
    f32x4 acc[2][2][4][2];
#pragma unroll
    for (int a = 0; a < 2; ++a)
#pragma unroll
        for (int b = 0; b < 2; ++b)
#pragma unroll
            for (int m = 0; m < 4; ++m)
#pragma unroll
                for (int n = 0; n < 2; ++n) acc[a][b][m][n] = (f32x4){0.f, 0.f, 0.f, 0.f};
    bf16x8 At[4][2], B0[2][2], B1[2][2]; v8i32 At8[4], B08[2], B18[2];
    const int sc7f = 0x7F7F7F7F;
    const char* cA = (const char*)g.A + (size_t)cur.pa * tstep; const char* cB = (const char*)g.Bt + (size_t)cur.pb * tstep;
    PG8_STAGE(PG8_SB(0, 0), cB, voffB); PG8_STAGE(PG8_SB(0, 1), cB + hstep, voffB); PG8_STAGE(PG8_SA(0, 0), cA, voffA); PG8_STAGE(PG8_SA(0, 1), cA + hstep, voffA);
    if (wr == 1) PG8_BAR;
    PG8_WAIT_V(2); PG8_BAR;
    PG8_STAGE(PG8_SB(1, 0), cB + kstep, voffB); PG8_STAGE(PG8_SA(1, 0), cA + kstep, voffA); PG8_STAGE(PG8_SB(1, 1), cB + hstep + kstep, voffB);
    PG8_WAIT_V(6); PG8_BAR;
    for (;;) {
        const bool has_next = S.next(ui + 1, nxt);
        const char* nA = has_next ? (const char*)g.A + (size_t)nxt.pa * tstep : cA; const char* nB = has_next ? (const char*)g.Bt + (size_t)nxt.pb * tstep : cB;
#pragma clang loop unroll(disable)
        for (int t = 0; t < nt; t += 2) {
            const bool last = (t == nt - 2);
            const char* a1 = cA + (size_t)(t + 1) * kstep;
            const char* a2 = last ? nA : cA + (size_t)(t + 2) * kstep; const char* b2 = last ? nB : cB + (size_t)(t + 2) * kstep;
            const char* a3 = a2 + kstep; const char* b3 = b2 + kstep;
            PG8_LDB(B0, 0, 0); PG8_LDB(B1, 0, 1); PG8_SCHED; PG8_LDA(At, 0, 0); PG8_STAGE(PG8_SA(1, 1), a1 + hstep, voffA);
            PG8_WAIT_V(8); PG8_WAIT_L(0); PG8_BAR; PG8_MMA(0, 0, At, B0); PG8_MMA(0, 1, At, B1); PG8_BAR; PG8_SCHED;
            PG8_LDA(At, 0, 1); PG8_STAGE(PG8_SB(0, 0), b2, voffB); PG8_STAGE(PG8_SB(0, 1), b2 + hstep, voffB); PG8_STAGE(PG8_SA(0, 0), a2, voffA);
            PG8_WAIT_V(8); PG8_WAIT_L(0); PG8_BAR; PG8_MMA(1, 0, At, B0); PG8_MMA(1, 1, At, B1); PG8_BAR; PG8_SCHED;
            PG8_LDB(B0, 1, 0); PG8_LDB(B1, 1, 1); PG8_SCHED; PG8_LDA(At, 1, 0); PG8_STAGE(PG8_SA(0, 1), a2 + hstep, voffA);
            PG8_WAIT_V(8); PG8_WAIT_L(0); PG8_BAR; PG8_MMA(0, 0, At, B0); PG8_MMA(0, 1, At, B1); PG8_BAR; PG8_SCHED;
            PG8_LDA(At, 1, 1); PG8_STAGE(PG8_SB(1, 0), b3, voffB); PG8_STAGE(PG8_SB(1, 1), b3 + hstep, voffB); PG8_STAGE(PG8_SA(1, 0), a3, voffA);
            PG8_WAIT_V(8); PG8_WAIT_L(0); PG8_BAR; PG8_MMA(1, 0, At, B0); PG8_MMA(1, 1, At, B1); PG8_BAR; PG8_SCHED;
        }
        if constexpr (ALIGN_EPI) { if (wr == 0) PG8_BAR; }
        if constexpr (FP8) asm volatile("s_nop 15\n\ts_nop 7" ::: "memory");
        E(acc, cur, wr, wc, fr, fq);
        if (!has_next) break;
        if (!(CHAIN && cur.aux < 2)) {
#pragma unroll
        for (int a = 0; a < 2; ++a)
#pragma unroll
            for (int b = 0; b < 2; ++b)
#pragma unroll
                for (int m = 0; m < 4; ++m)
#pragma unroll
                    for (int n = 0; n < 2; ++n) acc[a][b][m][n] = (f32x4){0.f, 0.f, 0.f, 0.f};
        }
        cur = nxt; cA = nA; cB = nB; ++ui;
        if constexpr (ALIGN_EPI) { if (wr == 1) PG8_BAR; }
    }
    PG8_WAIT_V(0);
    if constexpr (!ALIGN_EPI) { if (wr == 0) PG8_BAR; }
    PG8_BAR;
#undef PG8_SA
#undef PG8_SB
#undef PG8_STAGE
#undef PG8_LDA
#undef PG8_LDB
#undef PG8_MMA
#undef PG8_WAIT_V
#undef PG8_WAIT_L
#undef PG8_BAR
#undef PG8_SCHED
}
}
using pg8::Unit;

struct TileOrder {
    int nM, nN, nwg, G, c, skipctx, pboff, reps = 1;
    DI void init(int nM_, int nN_, int G_, int c_, int skipctx_, int pboff_) { nM = nM_; nN = nN_; nwg = nM * nN; G = G_; c = c_; skipctx = skipctx_; pboff = pboff_; }
    DI bool tile(long L, int& pm, int& pn) const {
        if (L >= (long)nwg * reps) return false;
        if (reps > 1) L %= nwg;
        int wgid = (int)L; { const int q = nwg / 8, r = nwg % 8, xcd = wgid % 8, off = wgid / 8; wgid = (xcd < r ? xcd * (q + 1) : r * (q + 1) + (xcd - r) * q) + off; }
        const int nig = 8 * nN, gid = wgid / nig, fm = gid * 8, gsz = (nM - fm) < 8 ? (nM - fm) : 8;
        int m = fm + ((wgid % nig) % gsz); pn = (wgid % nig) / gsz;
        pm = skipctx ? (m + (m >> 4) + 1) : m; return true;
    }
    DI bool next(int i, Unit& u) const { int pm, pn; if (!tile((long)i * G + c, pm, pn)) return false; u.pm = pm; u.pn = pn; u.pa = pm; u.pb = pboff + pn; u.aux = 0; return true; }
};
struct MergeOrder {
    TileOrder t;
    DI bool next(int i, Unit& u) const { const int br = i % 3; int pm, pn; if (!t.tile((long)(i / 3) * t.G + t.c, pm, pn)) return false;
        u.pm = pm; u.pn = pn; u.pa = br * NMT + pm; u.pb = br * 4 + pn; u.aux = br; return true; }
};
struct MoeOrder {
    const LAS int* tab;
    int ng, npn, G, c, g0;
    DI bool next(int i, Unit& u) const {
        const int L = i * G + c; if (L >= __builtin_amdgcn_readfirstlane(tab[ng])) return false;
        int ln = (int)(threadIdx.x & 63); asm volatile("" : "+v"(ln)); const int tv = tab[ln & 15];
        const int j = __builtin_amdgcn_readfirstlane((int)__popcll(__ballot(ln >= 1 && ln < ng && L >= tv)));
        const int tj = __builtin_amdgcn_readfirstlane(tab[j]), tbj = __builtin_amdgcn_readfirstlane(tab[32 + j]), e = (g0 + j) & 7;
        const int r = L - tj, mt = r / npn, pn = r % npn, gt = tbj + mt;
        u.pm = gt; u.pa = gt; u.pn = pn; u.pb = e * npn + pn; u.aux = (g0 + j) >> 3; return true;
    }
};

DI void row_bs(int R, int& b, int& s) { b = R / SB; s = R - b * SB; }

struct EpiInproj {
    static constexpr bool PERM = true;
    bf16_t* P1; bf16_t* OG; const LAS f32x2* rope; const LAS float* lbt;
    template <int OP> DI void run(const f32x4 (&acc)[2][2][4][2], const Unit& u, int wr, int wc, int fr, int fq, bf16_t* base, int ldc, int colt, float qs) const {
        f32x4 lb0[2], lb1[2];
        if (OP == 3) {
#pragma unroll
            for (int bj = 0; bj < 2; ++bj) { const LAS float* lp = lbt + (u.pn - 2) * 256 + bj * 128 + wc * 32 + 8 * fq; lb0[bj] = *(const LAS f32x4*)lp; lb1[bj] = *(const LAS f32x4*)(lp + 4); }
        }
#pragma unroll
        for (int ai = 0; ai < 2; ++ai)
#pragma unroll
            for (int m = 0; m < 4; ++m) {
                const int R = u.pm * 256 + ai * 128 + wr * 64 + m * 16 + fr;
                bf16_t* rowp = base + (size_t)R * ldc + colt + wc * 32 + 8 * fq;
                f32x4 c0 = {1.f, 1.f, 1.f, 1.f}, s0 = {0.f, 0.f, 0.f, 0.f}, c1 = c0, s1 = s0;
                if (OP == 2) {
                    int b, s; row_bs(R, b, s);
                    const int t = s - CTXL; const int pos = (wc & 1) ? (t & 63) : (t >> 6);
                    if (s >= CTXL) { const LAS f32x4* rp = (const LAS f32x4*)(rope + pos * 16 + 8 * (fq & 1)); const f32x4 a = rp[0], bq = rp[1], cq = rp[2], dq = rp[3];
                        c0 = (f32x4){a[0], a[2], bq[0], bq[2]}; s0 = (f32x4){a[1], a[3], bq[1], bq[3]}; c1 = (f32x4){cq[0], cq[2], dq[0], dq[2]}; s1 = (f32x4){cq[1], cq[3], dq[1], dq[3]}; }
                }
#pragma unroll
                for (int bj = 0; bj < 2; ++bj) {
                    f32x4 v0 = acc[ai][bj][m][0], v1 = acc[ai][bj][m][1];
                    if (OP == 1) {
#pragma unroll
                        for (int i = 0; i < 4; ++i) { v0[i] = gelu_tanh(v0[i]); v1[i] = gelu_tanh(v1[i]); }
                    } else if (OP == 3) {
#pragma unroll
                        for (int i = 0; i < 4; ++i) { v0[i] = __builtin_amdgcn_logf(lb0[bj][i] + (1.f - lb0[bj][i]) * sigm(v0[i])); v1[i] = __builtin_amdgcn_logf(lb1[bj][i] + (1.f - lb1[bj][i]) * sigm(v1[i])); }
                    } else if (OP == 2) {
                        f32x4 x1a, x2a, x1b, x2b;
#pragma unroll
                        for (int i = 0; i < 4; ++i) {
                            auto ra = __builtin_amdgcn_permlane32_swap(__float_as_uint(v0[i]), __float_as_uint(v0[i]), false, false); x1a[i] = __uint_as_float(ra[0]); x2a[i] = __uint_as_float(ra[1]);
                            auto rb = __builtin_amdgcn_permlane32_swap(__float_as_uint(v1[i]), __float_as_uint(v1[i]), false, false); x1b[i] = __uint_as_float(rb[0]); x2b[i] = __uint_as_float(rb[1]); }
                        if (fq < 2) { v0 = (x1a * c0 - x2a * s0) * qs; v1 = (x1b * c1 - x2b * s1) * qs; }
                        else { v0 = (x1a * s0 + x2a * c0) * qs; v1 = (x1b * s1 + x2b * c1) * qs; }
                    }
                    u32x4 w; w.x = pk2(v0[0], v0[1]); w.y = pk2(v0[2], v0[3]); w.z = pk2(v1[0], v1[1]); w.w = pk2(v1[2], v1[3]);
                    *(u32x4*)(rowp + bj * 128) = w;
                }
            }
    }
    DI void operator()(const f32x4 (&acc)[2][2][4][2], const Unit& u, int wr, int wc, int fr, int fq) const {
        const int pn = u.pn;
        bf16_t* base; int ldc, colt;
        if (pn == 8 || pn == 9) { base = OG; ldc = 512; colt = (pn - 8) * 256; }
        else { base = P1; ldc = P1LD; colt = pn * 256 - (pn >= 10 ? 512 : 0); }
        const float qs = (pn == 14 || pn == 15) ? 0.18033688011112042f : 1.0f;
        if (pn >= 10 && pn <= 13) run<1>(acc, u, wr, wc, fr, fq, base, ldc, colt, qs);
        else if (pn >= 14 && pn <= 17) run<2>(acc, u, wr, wc, fr, fq, base, ldc, colt, qs);
        else if (pn >= 2 && pn <= 5) run<3>(acc, u, wr, wc, fr, fq, base, ldc, colt, qs);
        else run<0>(acc, u, wr, wc, fr, fq, base, ldc, colt, qs);
    }
};

template <int ACT> struct EpiStore {
    static constexpr bool PERM = true;
    bf16_t* O; int ldc;
    DI void operator()(const f32x4 (&acc)[2][2][4][2], const Unit& u, int wr, int wc, int fr, int fq) const {
#pragma unroll
        for (int ai = 0; ai < 2; ++ai)
#pragma unroll
            for (int m = 0; m < 4; ++m) {
                bf16_t* rowp = O + (size_t)(u.pm * 256 + ai * 128 + wr * 64 + m * 16 + fr) * ldc + u.pn * 256 + wc * 32 + 8 * fq;
#pragma unroll
                for (int bj = 0; bj < 2; ++bj) {
                    f32x4 v0 = acc[ai][bj][m][0], v1 = acc[ai][bj][m][1];
                    if (ACT == 1) {
#pragma unroll
                        for (int i = 0; i < 4; ++i) { v0[i] = fmaxf(sigm(v0[i]), 1e-6f); v1[i] = fmaxf(sigm(v1[i]), 1e-6f); }
                    }
                    u32x4 w; w.x = pk2(v0[0], v0[1]); w.y = pk2(v0[2], v0[3]); w.z = pk2(v1[0], v1[1]); w.w = pk2(v1[2], v1[3]);
                    *(u32x4*)(rowp + bj * 128) = w;
                }
            }
    }
};

struct EpiMerge {
    static constexpr bool PERM = true;
    bf16_t* MRG; const bf16_t* G;
    DI void operator()(f32x4 (&acc)[2][2][4][2], const Unit& u, int wr, int wc, int fr, int fq) const {
        const int br = u.aux;
        const int c0 = u.pn * 256 + wc * 32 + 8 * fq;
#pragma unroll
        for (int ai = 0; ai < 2; ++ai) {
            u32x4 gv[4][2], hv[4][2];
#pragma unroll
            for (int m = 0; m < 4; ++m)
#pragma unroll
                for (int bj = 0; bj < 2; ++bj) { const bf16_t* gp = G + (size_t)(u.pm * 256 + ai * 128 + wr * 64 + m * 16 + fr) * 3072 + br * 1024 + c0 + bj * 128;
                    gv[m][bj] = *(const u32x4*)gp; if (br < 2) hv[m][bj] = *(const u32x4*)(gp + 1024); }
#pragma unroll
            for (int m = 0; m < 4; ++m)
#pragma unroll
                for (int bj = 0; bj < 2; ++bj) {
                    const u32x4 g4 = gv[m][bj];
                    float g[8] = {bflo(g4.x), bfhi(g4.x), bflo(g4.y), bfhi(g4.y), bflo(g4.z), bfhi(g4.z), bflo(g4.w), bfhi(g4.w)};
                    if (br < 2) {
                        const u32x4 h4 = hv[m][bj];
                        const float h[8] = {bflo(h4.x), bfhi(h4.x), bflo(h4.y), bfhi(h4.y), bflo(h4.z), bfhi(h4.z), bflo(h4.w), bfhi(h4.w)};
#pragma unroll
                        for (int i = 0; i < 8; ++i) g[i] *= __builtin_amdgcn_rcpf(h[i]);
#pragma unroll
                        for (int i = 0; i < 4; ++i) { acc[ai][bj][m][0][i] *= g[i]; acc[ai][bj][m][1][i] *= g[4 + i]; }
                    } else {
                        const f32x4 v0 = acc[ai][bj][m][0], v1 = acc[ai][bj][m][1];
                        u32x4 w; w.x = pk2(v0[0] * g[0], v0[1] * g[1]); w.y = pk2(v0[2] * g[2], v0[3] * g[3]); w.z = pk2(v1[0] * g[4], v1[1] * g[5]); w.w = pk2(v1[2] * g[6], v1[3] * g[7]);
                        *(u32x4*)(MRG + (size_t)(u.pm * 256 + ai * 128 + wr * 64 + m * 16 + fr) * 1024 + c0 + bj * 128) = w;
                    }
                }
        }
    }
};

struct EpiResid {
    static constexpr bool PERM = true;
    const float* in_l; const float* in_c; float* out_l; float* out_c; const float* gate;
    DI void operator()(const f32x4 (&acc)[2][2][4][2], const Unit& u, int wr, int wc, int fr, int fq) const {
        const int c0 = u.pn * 256 + wc * 32 + 8 * fq;
        const int bt = u.pm / 17, isc = (u.pm - bt * 17) == 0;
        const float* gp = gate + (size_t)(isc ? 8 : bt) * 6144 + c0;
        f32x4 g[2][2];
#pragma unroll
        for (int bj = 0; bj < 2; ++bj) { g[bj][0] = *(const f32x4*)(gp + bj * 128); g[bj][1] = *(const f32x4*)(gp + bj * 128 + 4); }
#pragma unroll
        for (int ai = 0; ai < 2; ++ai) {
            f32x4 xv[4][2][2]; size_t ro[4];
#pragma unroll
            for (int m = 0; m < 4; ++m) {
                const int R = u.pm * 256 + ai * 128 + wr * 64 + m * 16 + fr, s = R - bt * SB;
                ro[m] = isc ? (size_t)(bt * CTXL + s) * D : (size_t)(bt * SEQ + s - CTXL) * D;
                const float* xi = (isc ? in_c : in_l) + ro[m] + c0;
#pragma unroll
                for (int bj = 0; bj < 2; ++bj) { xv[m][bj][0] = *(const f32x4*)(xi + bj * 128); xv[m][bj][1] = *(const f32x4*)(xi + bj * 128 + 4); }
            }
#pragma unroll
            for (int m = 0; m < 4; ++m) {
                float* xo = (isc ? out_c : out_l) + ro[m] + c0;
#pragma unroll
                for (int bj = 0; bj < 2; ++bj) { *(f32x4*)(xo + bj * 128) = xv[m][bj][0] + g[bj][0] * acc[ai][bj][m][0]; *(f32x4*)(xo + bj * 128 + 4) = xv[m][bj][1] + g[bj][1] * acc[ai][bj][m][1]; }
            }
        }
    }
};

template <bool F8> struct EpiSwigluT {
    static constexpr bool PERM = true;
    bf16_t* Hd; int ldc;
    DI void operator()(const f32x4 (&acc)[2][2][4][2], const Unit& u, int wr, int wc, int fr, int fq) const {
#pragma unroll
        for (int ai = 0; ai < 2; ++ai)
#pragma unroll
            for (int m = 0; m < 4; ++m) {
                const size_t eo = (size_t)(u.pm * 256 + ai * 128 + wr * 64 + m * 16 + fr) * ldc + u.pn * 128 + wc * 32 + 8 * fq;
                constexpr float sc = F8 ? 1.f / W8SCALE : 1.f;
                float o[8];
#pragma unroll
                for (int n = 0; n < 2; ++n)
#pragma unroll
                    for (int i = 0; i < 4; ++i) { const float g = acc[ai][0][m][n][i] * sc, up = acc[ai][1][m][n][i] * sc; o[n * 4 + i] = g * sigm(g) * up; }
                if constexpr (F8) { u32x2 w; w.x = pk4_fp8(o[0], o[1], o[2], o[3]); w.y = pk4_fp8(o[4], o[5], o[6], o[7]); *(u32x2*)((unsigned char*)Hd + eo) = w; }
                else { u32x4 w; w.x = pk2(o[0], o[1]); w.y = pk2(o[2], o[3]); w.z = pk2(o[4], o[5]); w.w = pk2(o[6], o[7]); *(u32x4*)(Hd + eo) = w; }
            }
    }
};
typedef EpiSwigluT<false> EpiSwiglu;

struct EpiMoeDown {
    static constexpr bool PERM = true;
    const int* tok; const float* wrow; bf16_t* y0; bf16_t* y1;
    DI void operator()(const f32x4 (&acc)[2][2][4][2], const Unit& u, int wr, int wc, int fr, int fq) const {
        const int c0 = u.pn * 256 + wc * 32 + 8 * fq;
        bf16_t* y = u.aux ? y1 : y0;
        int nn[2][4]; float ww[2][4];
#pragma unroll
        for (int ai = 0; ai < 2; ++ai)
#pragma unroll
            for (int m = 0; m < 4; ++m) { const int row = u.pm * 256 + ai * 128 + wr * 64 + m * 16 + fr; nn[ai][m] = tok[row]; ww[ai][m] = wrow[row] * (1.f / W8SCALE); }
#pragma unroll
        for (int ai = 0; ai < 2; ++ai)
#pragma unroll
            for (int m = 0; m < 4; ++m) if (nn[ai][m] >= 0) {
                const size_t o = (size_t)nn[ai][m] * D + c0; const float w = ww[ai][m];
#pragma unroll
                for (int bj = 0; bj < 2; ++bj) {
                    const f32x4 a0 = acc[ai][bj][m][0] * w, a1 = acc[ai][bj][m][1] * w;
                    u32x4 w4; w4.x = pk2(a0[0], a0[1]); w4.y = pk2(a0[2], a0[3]); w4.z = pk2(a1[0], a1[1]); w4.w = pk2(a1[2], a1[3]); *(u32x4*)(y + o + bj * 128) = w4;
                }
            }
    }
};

struct Ctx {
    LAS unsigned char* lds; int tid, lane, wid, G, c;
    unsigned char* ws;
};

struct ConvItem { const float* W; int N, k0, n0; bf16_t* Dst; int Kd, drow; };
template <bool F8> DI void conv_tile(const ConvItem& c, LAS float* scr, int lane) {
    const float* src = c.W + (size_t)c.k0 * c.N + c.n0 + (lane & 15) * 4;
#pragma unroll 4
    for (int i = 0; i < 16; ++i) { const int kk = 4 * i + (lane >> 4); const f32x4 v = *(const f32x4*)(src + (size_t)kk * c.N);
        LAS float* d = scr + kk * 65 + (lane & 15) * 4; d[0] = v[0]; d[1] = v[1]; d[2] = v[2]; d[3] = v[3]; }
    LDS_WAIT();
    const int kc = lane & 7;
#pragma unroll
    for (int i = 0; i < 8; ++i) { const int n = i * 8 + (lane >> 3); const LAS float* s = scr + (kc * 8) * 65 + n;
        if constexpr (F8) { u32x2 o; o.x = pk4_fp8(s[0] * W8SCALE, s[65] * W8SCALE, s[2 * 65] * W8SCALE, s[3 * 65] * W8SCALE); o.y = pk4_fp8(s[4 * 65] * W8SCALE, s[5 * 65] * W8SCALE, s[6 * 65] * W8SCALE, s[7 * 65] * W8SCALE);
            *(u32x2*)((unsigned char*)c.Dst + (size_t)(c.drow + n) * c.Kd + c.k0 + kc * 8) = o; }
        else { u32x4 o; o.x = pk2(s[0], s[65]); o.y = pk2(s[2 * 65], s[3 * 65]); o.z = pk2(s[4 * 65], s[5 * 65]); o.w = pk2(s[6 * 65], s[7 * 65]);
            *(u32x4*)(c.Dst + (size_t)(c.drow + n) * c.Kd + c.k0 + kc * 8) = o; } }
    LDS_WAIT();
}
constexpr int CV_WIN = 2 * 16 * 128, CV_WBR = 6 * 128, CV_WOUT = 2 * 256, CV_FF = 704, CV_N0 = CV_WIN + CV_WBR + CV_WOUT + 3 * CV_FF;
constexpr int CV_ME = 896, CV_N1 = 3 * 8 * CV_ME;
DI void conv_decode0(const Params& p, int r, ConvItem& c) {
    unsigned char* ws = p.ws;
    if (r < CV_WIN) { const int l = r / 2048, rr = r % 2048; c.W = p.w_in + (size_t)l * 1024 * 8192; c.N = 8192; c.k0 = (rr / 128) * 64; c.n0 = (rr % 128) * 64;
        c.Dst = (bf16_t*)(ws + WS_WIN) + (size_t)l * 8192 * 1024; c.Kd = 1024; c.drow = c.n0; return; } r -= CV_WIN;
    if (r < CV_WBR) { const int m6 = r / 128, rr = r % 128; c.W = p.w_branch + (size_t)m6 * 512 * 1024; c.N = 1024; c.k0 = (rr / 16) * 64; c.n0 = (rr % 16) * 64;
        c.Dst = (bf16_t*)(ws + WS_WBR) + (size_t)m6 * 1024 * 512; c.Kd = 512; c.drow = c.n0; return; } r -= CV_WBR;
    if (r < CV_WOUT) { const int l = r / 256, rr = r % 256; c.W = p.w_out + (size_t)l * 1024 * 1024; c.N = 1024; c.k0 = (rr / 16) * 64; c.n0 = (rr % 16) * 64;
        c.Dst = (bf16_t*)(ws + WS_WOUT) + (size_t)l * 1024 * 1024; c.Kd = 1024; c.drow = c.n0; return; } r -= CV_WOUT;
    if (r < 2 * CV_FF) { const int up = r / CV_FF, rr = r % CV_FF; c.W = up ? p.ffn_wu : p.ffn_wg; c.N = DFF; c.k0 = (rr / 44) * 64; c.n0 = (rr % 44) * 64;
        c.Dst = (bf16_t*)(ws + WS_WGU); c.Kd = 1024; c.drow = (c.n0 / 128) * 256 + (c.n0 % 128) + up * 128; return; } r -= 2 * CV_FF;
    { c.W = p.ffn_wd; c.N = 1024; c.k0 = (r / 16) * 64; c.n0 = (r % 16) * 64; c.Dst = (bf16_t*)(ws + WS_WDN); c.Kd = DFF; c.drow = c.n0; }
}
DI void conv_decode1(const Params& p, int r, ConvItem& c) {
    unsigned char* ws = p.ws;
    if (r < 16 * CV_ME) { const int up = r / (8 * CV_ME), r2 = r % (8 * CV_ME), e = r2 / CV_ME, rr = r2 % CV_ME;
        c.W = (up ? p.moe_wu : p.moe_wg) + (size_t)e * 1024 * DFFE; c.N = DFFE; c.k0 = (rr / 56) * 64; c.n0 = (rr % 56) * 64;
        c.Dst = (bf16_t*)(ws + WS_WMGU + (size_t)e * 7168 * 1024); c.Kd = 1024; c.drow = (c.n0 / 128) * 256 + (c.n0 % 128) + up * 128; return; } r -= 16 * CV_ME;
    { const int e = r / CV_ME, rr = r % CV_ME; c.W = p.moe_wd + (size_t)e * DFFE * 1024; c.N = 1024; c.k0 = (rr / 16) * 64; c.n0 = (rr % 16) * 64;
        c.Dst = (bf16_t*)(ws + WS_WMDN + (size_t)e * 1024 * DFFE); c.Kd = DFFE; c.drow = c.n0; }
}
template <int WHICH> DI void conv_phase(const Params& p, const Ctx& X) {
    LAS float* scr = (LAS float*)(X.lds + X.wid * 16640);
    const int gw = X.c * 8 + X.wid, ngw = X.G * 8, nit = WHICH ? CV_N1 : CV_N0;
    for (int it = gw; it < nit; it += ngw) { ConvItem c; if (WHICH) conv_decode1(p, it, c); else conv_decode0(p, it, c); conv_tile<WHICH != 0>(c, scr, X.lane); }
}

DI void adaln_phase(const Params& p, const Ctx& X) {
    LAS float* sc = (LAS float*)X.lds;
    LAS float* part = sc + 9 * 1024;
    float* mod = (float*)(p.ws + WS_MOD);
    for (int g = X.c; g < 256; g += X.G) {
        const int l = g >> 7, n0 = (g & 127) * 48;
        for (int i = X.tid; i < 9 * 1024; i += 512) { const int r = i >> 10, k = i & 1023; const float cv = r < 8 ? p.c[r * 1024 + k] : p.c_ctx[k]; sc[i] = cv * sigm(cv); }
        __syncthreads();
        const int kq = X.tid >> 4, jq = X.tid & 15;
        float acc[9][3];
#pragma unroll
        for (int r = 0; r < 9; ++r) { acc[r][0] = 0.f; acc[r][1] = 0.f; acc[r][2] = 0.f; }
        const float* w = p.w_ada + (size_t)l * 1024 * 6144 + n0 + jq;
#pragma unroll 4
        for (int i = 0; i < 32; ++i) { const int k = kq + 32 * i; const float w0 = w[(size_t)k * 6144], w1 = w[(size_t)k * 6144 + 16], w2 = w[(size_t)k * 6144 + 32];
#pragma unroll
            for (int r = 0; r < 9; ++r) { const float s = sc[r * 1024 + k]; acc[r][0] += s * w0; acc[r][1] += s * w1; acc[r][2] += s * w2; } }
#pragma unroll
        for (int r = 0; r < 9; ++r)
#pragma unroll
            for (int j = 0; j < 3; ++j) part[kq * 432 + r * 48 + j * 16 + jq] = acc[r][j];
        __syncthreads();
        if (X.tid < 432) { const int r = X.tid / 48, j = X.tid % 48; float s = 0.f;
#pragma unroll 8
            for (int q = 0; q < 32; ++q) s += part[q * 432 + X.tid];
            mod[(size_t)(l * 9 + r) * 6144 + n0 + j] = s + p.b_ada[l * 6144 + n0 + j]; }
        __syncthreads();
    }
}
DI void rope_phase(const Params& p, const Ctx& X) {
    f32x2* tab = (f32x2*)(p.ws + WS_ROPE);
    float* lbt = (float*)(p.ws + WS_LB);
    for (int i = X.c * 512 + X.tid; i < 2048; i += X.G * 512) { const int l = i >> 10, dir = (i >> 9) & 1, ch = i & 511;
        const float p0 = p.hgrn_lb[(dir * 2 + 0) * 512 + ch], p1 = p.hgrn_lb[(dir * 2 + 1) * 512 + ch]; lbt[i] = l == 0 ? 0.f : 1.f / (1.f + expf(p0 - p1)); }
    for (int i = X.c * 512 + X.tid; i < 1024; i += X.G * 512) { const int pos = i >> 4, pp = i & 15;
        const float freq = powf(10000.f, -(float)pp / 16.f), ang = (float)pos * freq; tab[i] = (f32x2){cosf(ang), sinf(ang)}; }
}

template <bool F8> DI void norm_row(const float* xr, const float* g, const float* shift, const float* scale, bf16_t* orow, int lane, f32x4 (&hv)[4]) {
    f32x4 v[4]; float ss = 0.f;
#pragma unroll
    for (int j = 0; j < 4; ++j) { v[j] = *(const f32x4*)(xr + j * 256 + lane * 4); ss += (v[j][0] * v[j][0] + v[j][1] * v[j][1]) + (v[j][2] * v[j][2] + v[j][3] * v[j][3]); }
    const float rstd = rsqrtf(wave_sum(ss) * (1.f / D) + EPS);
#pragma unroll
    for (int j = 0; j < 4; ++j) { const int c = j * 256 + lane * 4;
        const f32x4 gg = *(const f32x4*)(g + c), sh = *(const f32x4*)(shift + c), sc = *(const f32x4*)(scale + c);
        const f32x4 h = (v[j] * rstd * gg) * (sc + 1.0f) + sh; hv[j] = h;
        if constexpr (F8) *(unsigned*)((unsigned char*)orow + c) = pk4_fp8(h[0], h[1], h[2], h[3]);
        else { u32x2 w; w.x = pk2(h[0], h[1]); w.y = pk2(h[2], h[3]); *(u32x2*)(orow + c) = w; } }
}
DI void norm_phase(const Params& p, const Ctx& X, int l, int which, bool first) {
    const float* xl = first ? p.x : p.out; const float* xc = first ? p.ctx : (const float*)(p.ws + WS_CTX);
    const float* g = (which ? p.g_norm2 : p.g_norm1) + l * D;
    const float* mod = (const float*)(p.ws + WS_MOD) + (size_t)l * 9 * 6144 + (which ? 3072 : 0);
    bf16_t* H = (bf16_t*)(p.ws + WS_H);
    const int rpb = (T + X.G - 1) / X.G, r0 = X.c * rpb, r1 = (r0 + rpb < T) ? r0 + rpb : T;
    f32x4 gg[4];
#pragma unroll
    for (int j = 0; j < 4; ++j) gg[j] = *(const f32x4*)(g + j * 256 + X.lane * 4);
    for (int R = r0 + X.wid; R < r1; R += 16) {
        const int Rb = (R + 8 < r1) ? R + 8 : R;
        f32x4 v[2][4], sh[2][4], sc[2][4]; float ss[2] = {0.f, 0.f};
#pragma unroll
        for (int q = 0; q < 2; ++q) { const int Rq = q ? Rb : R; int b, s; row_bs(Rq, b, s); const bool isc = s < CTXL;
            const float* xr = isc ? xc + (size_t)(b * CTXL + s) * D : xl + (size_t)(b * SEQ + s - CTXL) * D;
            const float* mr = mod + (size_t)(isc ? 8 : b) * 6144;
#pragma unroll
            for (int j = 0; j < 4; ++j) { const int c = j * 256 + X.lane * 4; v[q][j] = *(const f32x4*)(xr + c); sh[q][j] = *(const f32x4*)(mr + c); sc[q][j] = *(const f32x4*)(mr + 1024 + c); } }
#pragma unroll
        for (int q = 0; q < 2; ++q)
#pragma unroll
            for (int j = 0; j < 4; ++j) ss[q] += (v[q][j][0] * v[q][j][0] + v[q][j][1] * v[q][j][1]) + (v[q][j][2] * v[q][j][2] + v[q][j][3] * v[q][j][3]);
#pragma unroll
        for (int o = 1; o < 64; o <<= 1) { const float a = __shfl_xor(ss[0], o), b2 = __shfl_xor(ss[1], o); ss[0] += a; ss[1] += b2; }
#pragma unroll
        for (int q = 0; q < 2; ++q) { const int Rq = q ? Rb : R; const float rstd = rsqrtf(ss[q] * (1.f / D) + EPS); bf16_t* orow = H + (size_t)Rq * D;
#pragma unroll
            for (int j = 0; j < 4; ++j) { const int c = j * 256 + X.lane * 4; const f32x4 h = (v[q][j] * rstd * gg[j]) * (sc[q][j] + 1.0f) + sh[q][j];
                u32x2 w; w.x = pk2(h[0], h[1]); w.y = pk2(h[2], h[3]); *(u32x2*)(orow + c) = w; } }
    }
}
DI void norm2_router_phase(const Params& p, const Ctx& X) {
    const int l = 1;
    const float* g = p.g_norm2 + l * D;
    const float* mod = (const float*)(p.ws + WS_MOD) + (size_t)l * 9 * 6144 + 3072;
    bf16_t* H = (bf16_t*)(p.ws + WS_H);
    LAS float* wr = (LAS float*)X.lds;
    LAS int* hist = (LAS int*)(X.lds + 32768);
    for (int i = X.tid; i < 8192; i += 512) wr[i] = p.moe_router[i];
    if (X.tid < 16) hist[X.tid] = 0;
    int* tokt = (int*)(p.ws + WS_TOK);
    for (int i = X.c * 512 + X.tid; i < MAXROWS_MOE; i += X.G * 512) tokt[i] = -1;
    __syncthreads();
    const int tpb = (NLAT + X.G - 1) / X.G, n0 = X.c * tpb, n1 = (n0 + tpb < NLAT) ? n0 + tpb : NLAT;
    f32x4* route = (f32x4*)(p.ws + WS_ROUTE);
    f32x4 gg[4];
#pragma unroll
    for (int j = 0; j < 4; ++j) gg[j] = *(const f32x4*)(g + j * 256 + X.lane * 4);
    for (int n = n0 + X.wid; n < n1; n += 16) {
        const int nb = (n + 8 < n1) ? n + 8 : n, nq = (nb == n) ? 1 : 2;
        f32x4 v[2][4], sh[2][4], sc[2][4]; float ss[2] = {0.f, 0.f};
#pragma unroll
        for (int q = 0; q < 2; ++q) { const int nn = q ? nb : n; const float* xr = p.out + (size_t)nn * D; const float* mr = mod + (size_t)(nn >> 12) * 6144;
#pragma unroll
            for (int j = 0; j < 4; ++j) { const int c = j * 256 + X.lane * 4; v[q][j] = *(const f32x4*)(xr + c); sh[q][j] = *(const f32x4*)(mr + c); sc[q][j] = *(const f32x4*)(mr + 1024 + c); } }
#pragma unroll
        for (int q = 0; q < 2; ++q)
#pragma unroll
            for (int j = 0; j < 4; ++j) ss[q] += (v[q][j][0] * v[q][j][0] + v[q][j][1] * v[q][j][1]) + (v[q][j][2] * v[q][j][2] + v[q][j][3] * v[q][j][3]);
#pragma unroll
        for (int o = 1; o < 64; o <<= 1) { const float a = __shfl_xor(ss[0], o), b2 = __shfl_xor(ss[1], o); ss[0] += a; ss[1] += b2; }
        float lg[2][8];
#pragma unroll
        for (int q = 0; q < 2; ++q) {
            const int nn = q ? nb : n; const float rstd = rsqrtf(ss[q] * (1.f / D) + EPS);
            unsigned char* orow = (unsigned char*)H + (size_t)((nn >> 12) * SB + CTXL + (nn & 4095)) * D;
#pragma unroll
            for (int j = 0; j < 4; ++j) { const f32x4 h = (v[q][j] * rstd * gg[j]) * (sc[q][j] + 1.0f) + sh[q][j]; v[q][j] = h;
                if (q < nq) *(unsigned*)(orow + j * 256 + X.lane * 4) = pk4_fp8(h[0], h[1], h[2], h[3]); }
#pragma unroll
            for (int e = 0; e < 8; ++e) lg[q][e] = 0.f;
        }
#pragma unroll
        for (int j = 0; j < 4; ++j)
#pragma unroll
            for (int i = 0; i < 4; ++i) { const LAS f32x4* wp = (const LAS f32x4*)(wr + (j * 256 + X.lane * 4 + i) * 8); const f32x4 w0 = wp[0], w1 = wp[1];
#pragma unroll
                for (int q = 0; q < 2; ++q) { const float h = v[q][j][i];
                    lg[q][0] += h * w0[0]; lg[q][1] += h * w0[1]; lg[q][2] += h * w0[2]; lg[q][3] += h * w0[3]; lg[q][4] += h * w1[0]; lg[q][5] += h * w1[1]; lg[q][6] += h * w1[2]; lg[q][7] += h * w1[3]; } }
#pragma unroll
        for (int o = 1; o < 64; o <<= 1)
#pragma unroll
            for (int q = 0; q < 2; ++q)
#pragma unroll
                for (int e = 0; e < 8; ++e) lg[q][e] += __shfl_xor(lg[q][e], o);
        for (int q = 0; q < nq; ++q) {
            int e1 = 0; float v1 = lg[q][0];
#pragma unroll
            for (int e = 1; e < 8; ++e) if (lg[q][e] > v1) { v1 = lg[q][e]; e1 = e; }
            int e2 = -1; float v2 = -3.0e38f;
#pragma unroll
            for (int e = 0; e < 8; ++e) if (e != e1 && lg[q][e] > v2) { v2 = lg[q][e]; e2 = e; }
            const float w2 = 1.f / (1.f + expf(v1 - v2)), w1 = 1.f - w2;
            if (X.lane == 0) { route[q ? nb : n] = (f32x4){__int_as_float(e1), __int_as_float(e2), w1, w2}; atomicAdd((int*)&hist[e1], 1); atomicAdd((int*)&hist[8 + e2], 1); }
        }
    }
    __syncthreads();
    if (X.tid < 16) ((int*)(p.ws + WS_HIST))[X.c * 16 + X.tid] = hist[X.tid];
}

DI void readout_phase(const Params& p, const Ctx& X, int l) {
    const bf16_t* OF = (const bf16_t*)(p.ws + WS_OF); bf16_t* OB = (bf16_t*)(p.ws + WS_OB); const bf16_t* OG = (const bf16_t*)(p.ws + WS_OG);
    const float* gn = p.hgrn_gnorm + l * 512 + X.lane * 8;
    const f32x4 g0 = *(const f32x4*)gn, g1 = *(const f32x4*)(gn + 4);
    const int rpb = (T + X.G - 1) / X.G, r0 = X.c * rpb, r1 = (r0 + rpb < T) ? r0 + rpb : T;
    for (int R = r0 + X.wid; R < r1; R += 16) {
        const int Rb = (R + 8 < r1) ? R + 8 : R;
        u32x4 a[2], bb[2], gg[2];
#pragma unroll
        for (int q = 0; q < 2; ++q) { const size_t o = (size_t)(q ? Rb : R) * 512 + X.lane * 8; a[q] = *(const u32x4*)(OF + o); bb[q] = *(const u32x4*)(OB + o); gg[q] = *(const u32x4*)(OG + o); }
        const int nq = (Rb == R) ? 1 : 2;
        for (int q = 0; q < nq; ++q) {
            const int Rq = q ? Rb : R;
            if (l == 1) { int b, s; row_bs(Rq, b, s); if (s < CTXL) continue; }
            float v[8], qv[8];
            v[0] = bflo(a[q].x) + bflo(bb[q].x); v[1] = bfhi(a[q].x) + bfhi(bb[q].x); v[2] = bflo(a[q].y) + bflo(bb[q].y); v[3] = bfhi(a[q].y) + bfhi(bb[q].y);
            v[4] = bflo(a[q].z) + bflo(bb[q].z); v[5] = bfhi(a[q].z) + bfhi(bb[q].z); v[6] = bflo(a[q].w) + bflo(bb[q].w); v[7] = bfhi(a[q].w) + bfhi(bb[q].w);
            qv[0] = bflo(gg[q].x); qv[1] = bfhi(gg[q].x); qv[2] = bflo(gg[q].y); qv[3] = bfhi(gg[q].y); qv[4] = bflo(gg[q].z); qv[5] = bfhi(gg[q].z); qv[6] = bflo(gg[q].w); qv[7] = bfhi(gg[q].w);
            float ss = 0.f;
#pragma unroll
            for (int i = 0; i < 8; ++i) ss += v[i] * v[i];
            ss += __shfl_xor(ss, 1); ss += __shfl_xor(ss, 2); ss += __shfl_xor(ss, 4); ss += __shfl_xor(ss, 8);
            const float rstd = rsqrtf(ss * (1.f / 128.f) + EPS);
            float y[8];
#pragma unroll
            for (int i = 0; i < 8; ++i) y[i] = v[i] * rstd * (i < 4 ? g0[i] : g1[i - 4]) * (qv[i] * sigm(qv[i]));
            u32x4 w; w.x = pk2(y[0], y[1]); w.y = pk2(y[2], y[3]); w.z = pk2(y[4], y[5]); w.w = pk2(y[6], y[7]);
            *(u32x4*)(OB + (size_t)Rq * 512 + X.lane * 8) = w;
        }
    }
}

DI void final_phase(const Params& p, const Ctx& X) {
    const bf16_t* y0 = (const bf16_t*)(p.ws + WS_Y0); const bf16_t* y1 = (const bf16_t*)(p.ws + WS_Y1);
    const float* gate = (const float*)(p.ws + WS_MOD) + (size_t)9 * 6144 + 5120;
    const int rpb = (NLAT + X.G - 1) / X.G, r0 = X.c * rpb, r1 = (r0 + rpb < NLAT) ? r0 + rpb : NLAT;
    f32x4 gf[4];
#pragma unroll
    for (int j = 0; j < 4; ++j) gf[j] = *(const f32x4*)(p.g_final + j * 256 + X.lane * 4);
    for (int n = r0 + X.wid; n < r1; n += 16) {
        const int nb = (n + 8 < r1) ? n + 8 : n;
        f32x4 v[2][4], gt[2][4]; u32x2 ya[2][4], yb[2][4]; float ss[2] = {0.f, 0.f};
#pragma unroll
        for (int q = 0; q < 2; ++q) { const int nq_ = q ? nb : n; const size_t o = (size_t)nq_ * D; const float* gr = gate + (size_t)(nq_ >> 12) * 6144;
#pragma unroll
            for (int j = 0; j < 4; ++j) { const int c = j * 256 + X.lane * 4; v[q][j] = *(const f32x4*)(p.out + o + c); ya[q][j] = *(const u32x2*)(y0 + o + c); yb[q][j] = *(const u32x2*)(y1 + o + c); gt[q][j] = *(const f32x4*)(gr + c); } }
#pragma unroll
        for (int q = 0; q < 2; ++q)
#pragma unroll
            for (int j = 0; j < 4; ++j) {
                const f32x4 ys = (f32x4){bflo(ya[q][j].x), bfhi(ya[q][j].x), bflo(ya[q][j].y), bfhi(ya[q][j].y)} + (f32x4){bflo(yb[q][j].x), bfhi(yb[q][j].x), bflo(yb[q][j].y), bfhi(yb[q][j].y)};
                v[q][j] = v[q][j] + gt[q][j] * ys;
                ss[q] += (v[q][j][0] * v[q][j][0] + v[q][j][1] * v[q][j][1]) + (v[q][j][2] * v[q][j][2] + v[q][j][3] * v[q][j][3]); }
#pragma unroll
        for (int o = 1; o < 64; o <<= 1) { const float a = __shfl_xor(ss[0], o), b2 = __shfl_xor(ss[1], o); ss[0] += a; ss[1] += b2; }
        const int nq = (nb == n) ? 1 : 2;
        for (int q = 0; q < nq; ++q) { const float rstd = rsqrtf(ss[q] * (1.f / D) + EPS); float* xr = p.out + (size_t)(q ? nb : n) * D;
#pragma unroll
            for (int j = 0; j < 4; ++j) *(f32x4*)(xr + j * 256 + X.lane * 4) = v[q][j] * rstd * gf[j]; }
    }
}

DI int crow(int r, int hi) { return (r & 3) + 8 * (r >> 2) + 4 * hi; }
DI void hgrn_phase(const Params& p, const Ctx& X, int l) {
    const bf16_t* P1 = (const bf16_t*)(p.ws + WS_P1);
    constexpr int BUFB = 54272;
    LAS unsigned char* SFb = X.lds + 2 * BUFB;
    const int tid = X.tid, lane = X.lane, wid = X.wid, l31 = lane & 31, hi = lane >> 5;
    const int pw = wid - 4;
    for (int un = X.c; un < 256; un += X.G) {
        const int unit = (X.G == 256) ? ((((un & 7) * 4 + (un >> 6)) << 3) | ((un >> 3) & 7)) : un;
        const int b = unit >> 5, h = (unit >> 3) & 3, dir = (unit >> 2) & 1, vs = unit & 3;
        bf16_t* O = (bf16_t*)(p.ws + (dir ? WS_OB : WS_OF));
        const size_t rowbase = (size_t)b * SB;
        auto srcrow = [&](int jp) -> int { return dir == 0 ? jp : (jp < CTXL ? (CTXL - 1 - jp) : (SB + CTXL - 1 - jp)); };
        struct Pref { u32x4 rl[4], rqv[4]; };
        Pref PA, PB;
        const int half = pw >> 1, khalf = pw & 1, sgn = dir ? -1 : 1;
        auto gload = [&](int c, Pref& P) {
            int ln = lane; asm volatile("" : "+v"(ln)); const int kch = ln & 7, tseg = ln >> 3;
            const size_t R0 = rowbase + srcrow(c * 64 + 32 * half + 4 * tseg); const bf16_t* rp = P1 + R0 * P1LD + h * 128 + 64 * khalf + 8 * kch;
#pragma unroll
            for (int i = 0; i < 4; ++i) { P.rl[i] = *(const u32x4*)(rp + (ptrdiff_t)(i * sgn) * P1LD + 512 + dir * 512); P.rqv[i] = *(const u32x4*)(rp + (ptrdiff_t)(i * sgn) * P1LD); }
        };
        constexpr int NCH = SB / 64;
        if (wid >= 4) {
            auto produce = [&](int c, Pref& P) {
                if (c < NCH) {
                    LAS unsigned char* B = X.lds + (c & 1) * BUFB;
#pragma unroll
                    for (int i = 0; i < 4; ++i) asm volatile("" : "+v"(P.rl[i]), "+v"(P.rqv[i]) :: "memory");
                    int ln = lane; asm volatile("" : "+v"(ln)); const int kch = ln & 7, tseg = ln >> 3;
                    const bool first = half == 0; const int sig = first ? 7 - tseg : tseg, sdir = first ? 8 : -8;
                    float f[4][8];
#pragma unroll
                    for (int i = 0; i < 4; ++i) { const unsigned w[4] = {P.rl[i].x, P.rl[i].y, P.rl[i].z, P.rl[i].w};
#pragma unroll
                        for (int e = 0; e < 8; ++e) f[i][e] = __builtin_amdgcn_exp2f((e & 1) ? bfhi(w[e >> 1]) : bflo(w[e >> 1])); }
                    u32x4 qraw[4];
#pragma unroll
                    for (int i = 0; i < 4; ++i) qraw[i] = P.rqv[i];
                    if (c + 2 < NCH) gload(c + 2, P);
                    float Xp[8], Tt[8], yy[8];
                    const int a1 = (ln + sdir) << 2, a2 = (ln + 2 * sdir) << 2, a4 = (ln + 4 * sdir) << 2;
#pragma unroll
                    for (int e = 0; e < 8; ++e) Tt[e] = (f[0][e] * f[1][e]) * (f[2][e] * f[3][e]);
#pragma unroll
                    for (int e = 0; e < 8; ++e) yy[e] = __int_as_float(__builtin_amdgcn_ds_bpermute(a1, __float_as_int(Tt[e])));
#pragma unroll
                    for (int e = 0; e < 8; ++e) Xp[e] = (sig >= 1) ? yy[e] : 1.f;
#pragma unroll
                    for (int e = 0; e < 8; ++e) yy[e] = __int_as_float(__builtin_amdgcn_ds_bpermute(a1, __float_as_int(Xp[e])));
#pragma unroll
                    for (int e = 0; e < 8; ++e) Xp[e] = (sig >= 1) ? Xp[e] * yy[e] : Xp[e];
#pragma unroll
                    for (int e = 0; e < 8; ++e) yy[e] = __int_as_float(__builtin_amdgcn_ds_bpermute(a2, __float_as_int(Xp[e])));
#pragma unroll
                    for (int e = 0; e < 8; ++e) Xp[e] = (sig >= 2) ? Xp[e] * yy[e] : Xp[e];
#pragma unroll
                    for (int e = 0; e < 8; ++e) yy[e] = __int_as_float(__builtin_amdgcn_ds_bpermute(a4, __float_as_int(Xp[e])));
#pragma unroll
                    for (int e = 0; e < 8; ++e) Xp[e] = (sig >= 4) ? Xp[e] * yy[e] : Xp[e];
                    if (sig == 7) {
                        LAS f32x4* ep = (LAS f32x4*)(B + 53248) + (128 * half + 64 * khalf + 8 * kch) / 4;
                        ep[0] = (f32x4){Xp[0] * Tt[0], Xp[1] * Tt[1], Xp[2] * Tt[2], Xp[3] * Tt[3]}; ep[1] = (f32x4){Xp[4] * Tt[4], Xp[5] * Tt[5], Xp[6] * Tt[6], Xp[7] * Tt[7]};
                    }
                    const int g16 = 4 * khalf + (kch >> 1), ka = kch & 1, sg = 2 * half + (tseg >> 2), sa = (tseg >> 1) & 1, sh = tseg & 1;
                    auto emit = [&](auto firstc) {
                        constexpr bool FIRST = decltype(firstc)::value;
#pragma unroll
                        for (int eh = 0; eh < 2; ++eh) {
                            float kt[4][4];
#pragma unroll
                            for (int i = 0; i < 4; ++i) {
                                const unsigned qw0 = eh ? qraw[i].z : qraw[i].x, qw1 = eh ? qraw[i].w : qraw[i].y;
                                float qt[4];
#pragma unroll
                                for (int e4 = 0; e4 < 4; ++e4) { const int e = 4 * eh + e4;
                                    const float pre = (i == 0) ? f[0][e] : (i == 1) ? f[0][e] * f[1][e] : (i == 2) ? (f[0][e] * f[1][e]) * f[2][e] : (f[0][e] * f[1][e]) * (f[2][e] * f[3][e]);
                                    const float suf = (i == 3) ? 1.f : (i == 2) ? f[3][e] : (i == 1) ? f[3][e] * f[2][e] : (f[3][e] * f[2][e]) * f[1][e];
                                    const float esm = (FIRST ? suf : pre) * Xp[e], ebig = __builtin_amdgcn_rcpf(fmaxf(esm, 1e-30f));
                                    const float qq = (e4 == 0) ? bflo(qw0) : (e4 == 1) ? bfhi(qw0) : (e4 == 2) ? bflo(qw1) : bfhi(qw1);
                                    qt[e4] = qq * (FIRST ? ebig : esm); kt[i][e4] = (1.f - f[i][e]) * (FIRST ? esm : ebig); }
                                const int t = 32 * half + 4 * tseg + i, o = t * 256 + (((2 * g16 + eh) ^ (t & 15)) << 4) + ka * 8;
                                u32x2 qv, kv; qv.x = pk2(qt[0], qt[1]); qv.y = pk2(qt[2], qt[3]); kv.x = pk2(kt[i][0], kt[i][1]); kv.y = pk2(kt[i][2], kt[i][3]);
                                *(LAS u32x2*)(B + o) = qv; *(LAS u32x2*)(B + 16384 + o) = kv;
                            }
#pragma unroll
                            for (int e4 = 0; e4 < 4; ++e4) { const int k = 64 * khalf + 8 * kch + 4 * eh + e4; u32x2 w2; w2.x = pk2(kt[0][e4], kt[1][e4]); w2.y = pk2(kt[2][e4], kt[3][e4]);
                                *(LAS u32x2*)(B + 32768 + k * 128 + (((2 * sg + sh) ^ ((k >> 1) & 7)) << 4) + sa * 8) = w2; }
                        }
                    };
                    if (first) emit(std::true_type{}); else emit(std::false_type{});
                }
            };
            static_assert(NCH % 2 == 0, "producer loop is unrolled by two");
            gload(0, PA); gload(1, PB);
            for (int c = 0; c < NCH; c += 2) { produce(c, PA); __syncthreads(); produce(c + 1, PB); __syncthreads(); }
            __syncthreads();
        } else if (wid < 2) {
            f32x16 S[2];
#pragma unroll
            for (int r = 0; r < 16; ++r) { S[0][r] = 0.f; S[1][r] = 0.f; }
            u32x4 rvv[2];
            auto vload = [&](int c) {
                int tq = tid; asm volatile("" : "+v"(tq));
#pragma unroll
                for (int j = 0; j < 2; ++j) { const int pc = tq + 128 * j; const size_t Rv = rowbase + srcrow(c * 64 + (pc >> 2));
                    rvv[j] = *(const u32x4*)(P1 + Rv * P1LD + 1536 + h * 128 + vs * 32 + (pc & 3) * 8); }
            };
            vload(0);
            for (int c = 0; c <= NCH; ++c) {
                if (c < NCH) {
                    asm volatile("" : "+v"(rvv[0]), "+v"(rvv[1]) :: "memory");
                    LAS unsigned char* Bw = X.lds + (c & 1) * BUFB;
                    int tq = tid; asm volatile("" : "+v"(tq));
#pragma unroll
                    for (int j = 0; j < 2; ++j) { const int pc = tq + 128 * j, s = pc >> 2, sl = s & 15, sa = sl >> 3, sh = (sl >> 2) & 1, si = sl & 3, sc = (s >> 4) * 2 + sh;
                        const unsigned w[4] = {rvv[j].x, rvv[j].y, rvv[j].z, rvv[j].w};
#pragma unroll
                        for (int e = 0; e < 8; ++e) { const int v = (pc & 3) * 8 + e; const bf16_t val = (bf16_t)((e & 1) ? (w[e >> 1] >> 16) : (w[e >> 1] & 0xffffu));
                            *(LAS bf16_t*)(Bw + 49152 + v * 128 + ((sc ^ ((v >> 1) & 7)) << 4) + (4 * sa + si) * 2) = val; } }
                    if (c + 1 < NCH) vload(c + 1);
                }
                if (c >= 1) {
                    const LAS unsigned char* B = X.lds + ((c - 1) & 1) * BUFB;
                    const LAS float* ERC = (const LAS float*)(B + 53248);
#pragma unroll
                    for (int j = 0; j < 2; ++j) {
                        const int kr = 32 * (2 * wid + j), k = kr + l31;
                        f32x16 W;
#pragma unroll
                        for (int g = 0; g < 4; ++g) { const f32x4 er = *(const LAS f32x4*)(ERC + kr + 8 * g + 4 * hi);
#pragma unroll
                            for (int i = 0; i < 4; ++i) W[4 * g + i] = S[j][4 * g + i] * er[i]; }
#pragma unroll
                        for (int ks = 0; ks < 4; ++ks) {
                            const bf16x8 ak = *(const LAS bf16x8*)(B + 32768 + k * 128 + (((2 * ks + hi) ^ ((k >> 1) & 7)) << 4));
                            const bf16x8 bv = *(const LAS bf16x8*)(B + 49152 + l31 * 128 + (((2 * ks + hi) ^ ((l31 >> 1) & 7)) << 4));
                            W = __builtin_amdgcn_mfma_f32_32x32x16_bf16(ak, bv, W, 0, 0, 0);
                        }
#pragma unroll
                        for (int g = 0; g < 4; ++g) { const f32x4 ec = *(const LAS f32x4*)(ERC + 128 + kr + 8 * g + 4 * hi);
#pragma unroll
                            for (int i = 0; i < 4; ++i) S[j][4 * g + i] = W[4 * g + i] * ec[i]; }
                    }
                }
                if (c < NCH) {
                    LAS unsigned char* SF = SFb + (c & 1) * 8192;
#pragma unroll
                    for (int j = 0; j < 2; ++j)
#pragma unroll
                        for (int s = 0; s < 2; ++s) { u32x4 aw; aw.x = pk2(S[j][8 * s], S[j][8 * s + 1]); aw.y = pk2(S[j][8 * s + 2], S[j][8 * s + 3]);
                            aw.z = pk2(S[j][8 * s + 4], S[j][8 * s + 5]); aw.w = pk2(S[j][8 * s + 6], S[j][8 * s + 7]);
                            *(LAS u32x4*)(SF + (((2 * wid + j) * 2 + s) * 64 + lane) * 16) = aw; }
                }
                __syncthreads();
            }
        } else {
            for (int c = 0; c <= NCH; ++c) {
                if (c >= 1) {
                    const LAS unsigned char* B = X.lds + ((c - 1) & 1) * BUFB;
                    const LAS float* ERC = (const LAS float*)(B + 53248);
                    const LAS unsigned char* SF = SFb + ((c - 1) & 1) * 8192;
                    const int tb = wid - 2, t = 32 * tb + l31;
                    f32x16 oacc;
#pragma unroll
                    for (int r = 0; r < 16; ++r) oacc[r] = 0.f;
                    for (int sb = 0; sb <= tb; ++sb) {
                        f32x16 at;
#pragma unroll
                        for (int r = 0; r < 16; ++r) at[r] = 0.f;
                        const int s = 32 * sb + l31;
#pragma unroll
                        for (int ks = 0; ks < 8; ++ks) {
                            const bf16x8 ak = *(const LAS bf16x8*)(B + 16384 + s * 256 + (((2 * ks + hi) ^ (s & 15)) << 4));
                            const bf16x8 bq = *(const LAS bf16x8*)(B + t * 256 + (((2 * ks + hi) ^ (t & 15)) << 4));
                            at = __builtin_amdgcn_mfma_f32_32x32x16_bf16(ak, bq, at, 0, 0, 0);
                        }
                        if (sb == tb) {
#pragma unroll
                            for (int r = 0; r < 16; ++r) at[r] = (crow(r, hi) <= l31) ? at[r] : 0.f;
                        }
#pragma unroll
                        for (int s2 = 0; s2 < 2; ++s2) {
                            u32x4 pw4; pw4.x = pk2(at[8 * s2], at[8 * s2 + 1]); pw4.y = pk2(at[8 * s2 + 2], at[8 * s2 + 3]); pw4.z = pk2(at[8 * s2 + 4], at[8 * s2 + 5]); pw4.w = pk2(at[8 * s2 + 6], at[8 * s2 + 7]);
                            const bf16x8 av = *(const LAS bf16x8*)(B + 49152 + l31 * 128 + ((((2 * sb + s2) * 2 + hi) ^ ((l31 >> 1) & 7)) << 4));
                            oacc = __builtin_amdgcn_mfma_f32_32x32x16_bf16(av, __builtin_bit_cast(bf16x8, pw4), oacc, 0, 0, 0);
                        }
                    }
#pragma unroll
                    for (int kb = 0; kb < 4; ++kb)
#pragma unroll
                        for (int s = 0; s < 2; ++s) {
                            const bf16x8 as = *(const LAS bf16x8*)(SF + ((kb * 2 + s) * 64 + lane) * 16);
                            const u32x4 bw = *(const LAS u32x4*)(B + t * 256 + ((((2 * kb + s) * 2 + hi) ^ (t & 15)) << 4));
                            const f32x4 e0 = *(const LAS f32x4*)(ERC + 32 * kb + 16 * s + 4 * hi), e1 = *(const LAS f32x4*)(ERC + 32 * kb + 16 * s + 8 + 4 * hi);
                            u32x4 bs; bs.x = pk2(bflo(bw.x) * e0[0], bfhi(bw.x) * e0[1]); bs.y = pk2(bflo(bw.y) * e0[2], bfhi(bw.y) * e0[3]);
                            bs.z = pk2(bflo(bw.z) * e1[0], bfhi(bw.z) * e1[1]); bs.w = pk2(bflo(bw.w) * e1[2], bfhi(bw.w) * e1[3]);
                            oacc = __builtin_amdgcn_mfma_f32_32x32x16_bf16(as, __builtin_bit_cast(bf16x8, bs), oacc, 0, 0, 0);
                        }
                    const size_t R = rowbase + srcrow((c - 1) * 64 + t);
                    bf16_t* orow = O + R * 512 + h * 128 + vs * 32 + 4 * hi;
#pragma unroll
                    for (int g = 0; g < 4; ++g) { u32x2 w2; w2.x = pk2(oacc[4 * g], oacc[4 * g + 1]); w2.y = pk2(oacc[4 * g + 2], oacc[4 * g + 3]); *(u32x2*)(orow + 8 * g) = w2; }
                }
                __syncthreads();
            }
        }
    }
}

DI void mlp_phase(const Params& p, const Ctx& X, int l) {
    const bf16_t* P1 = (const bf16_t*)(p.ws + WS_P1); bf16_t* YB = (bf16_t*)(p.ws + WS_YB);
    LAS unsigned char* vT = X.lds;
    const int tid = X.tid, lane = X.lane, wid = X.wid, hi = lane >> 5, l31 = lane & 31;
    const int nch = l ? 32 : 34, nunits = NBATCH * nch;
    for (int u = X.c; u < nunits; u += X.G) {
        const int b = u / nch, ch = u % nch + (l ? 2 : 0);
        const size_t R0 = (size_t)b * SB + ch * 128;
        const int tok = tid >> 2, part = tid & 3;
        const bf16_t* vrow = P1 + (R0 + tok) * P1LD + 2560;
        u32x4 raw[4][4]; float ss = 0.f;
#pragma unroll
        for (int g = 0; g < 4; ++g)
#pragma unroll
            for (int q = 0; q < 4; ++q) raw[g][q] = *(const u32x4*)(vrow + g * 128 + part * 32 + q * 8);
#pragma unroll
        for (int g = 0; g < 4; ++g)
#pragma unroll
            for (int q = 0; q < 4; ++q) { const u32x4 r4 = raw[g][q];
                const float a0 = bflo(r4.x), a1 = bfhi(r4.x), a2 = bflo(r4.y), a3 = bfhi(r4.y), a4 = bflo(r4.z), a5 = bfhi(r4.z), a6 = bflo(r4.w), a7 = bfhi(r4.w);
                ss += (a0 * a0 + a1 * a1) + (a2 * a2 + a3 * a3) + (a4 * a4 + a5 * a5) + (a6 * a6 + a7 * a7); }
        ss += __shfl_xor(ss, 1); ss += __shfl_xor(ss, 2);
        const float rstd = rsqrtf(ss * (1.f / 512.f) + EPS);
        const int tblk = wid & 3, dp = wid >> 2;
#pragma unroll 1
        for (int g = 0; g < 4; ++g) {
#pragma unroll
            for (int q = 0; q < 4; ++q) {
                const int d0 = part * 32 + q * 8;
                const u32x4 r4 = raw[0][q];
                const float* vn = p.mlp_vnorm + l * 512 + g * 128 + d0;
                float a[8]; a[0] = bflo(r4.x); a[1] = bfhi(r4.x); a[2] = bflo(r4.y); a[3] = bfhi(r4.y); a[4] = bflo(r4.z); a[5] = bfhi(r4.z); a[6] = bflo(r4.w); a[7] = bfhi(r4.w);
#pragma unroll
                for (int e = 0; e < 8; ++e) { const int d = d0 + e; const unsigned w = pk2(a[e] * rstd * vn[e], 0.f);
                    *(LAS bf16_t*)(vT + g * 32768 + d * 256 + (((tok >> 3) ^ (d & 15)) << 4) + (tok & 7) * 2) = (bf16_t)(w & 0xffffu); }
            }
#pragma unroll
            for (int q = 0; q < 4; ++q) { raw[0][q] = raw[1][q]; raw[1][q] = raw[2][q]; raw[2][q] = raw[3][q]; }
        }
        __syncthreads();
#pragma unroll 1
        for (int g = 0; g < 4; ++g) {
            const float* wsr = p.mlp_ws + ((size_t)(l * 4 + g) * 128 + tblk * 32 + l31) * 128 + 8 * hi;
            f32x4 w0[8], w1[8];
#pragma unroll
            for (int ks = 0; ks < 8; ++ks) { w0[ks] = *(const f32x4*)(wsr + ks * 16); w1[ks] = *(const f32x4*)(wsr + ks * 16 + 4); }
            f32x16 acc[2];
#pragma unroll
            for (int r = 0; r < 16; ++r) { acc[0][r] = 0.f; acc[1][r] = 0.f; }
            const LAS unsigned char* vTg = vT + g * 32768;
#pragma unroll
            for (int ks = 0; ks < 8; ++ks) {
                u32x4 aw; aw.x = pk2(w0[ks][0], w0[ks][1]); aw.y = pk2(w0[ks][2], w0[ks][3]); aw.z = pk2(w1[ks][0], w1[ks][1]); aw.w = pk2(w1[ks][2], w1[ks][3]);
                const bf16x8 A = __builtin_bit_cast(bf16x8, aw);
#pragma unroll
                for (int j2 = 0; j2 < 2; ++j2) { const int d = (dp * 2 + j2) * 32 + l31;
                    const bf16x8 Bf = *(const LAS bf16x8*)(vTg + d * 256 + (((2 * ks + hi) ^ (d & 15)) << 4));
                    acc[j2] = __builtin_amdgcn_mfma_f32_32x32x16_bf16(A, Bf, acc[j2], 0, 0, 0); }
            }
#pragma unroll
            for (int j2 = 0; j2 < 2; ++j2) { const int d = (dp * 2 + j2) * 32 + l31;
#pragma unroll
                for (int r = 0; r < 16; ++r) { const int t = tblk * 32 + crow(r, hi);
                    const float mixed = acc[j2][r] + p.mlp_bs[(l * 4 + g) * 128 + t];
                    const float uu = bf1(P1[(R0 + t) * P1LD + 2048 + g * 128 + d]);
                    YB[(R0 + t) * 512 + g * 128 + d] = (bf16_t)(pk2(uu * mixed, 0.f) & 0xffffu); } }
        }
        __syncthreads();
    }
}

typedef short v4i16_t __attribute__((ext_vector_type(4)));
DI s16x4 vtr(const LAS unsigned char* pp) { return __builtin_bit_cast(s16x4, __builtin_amdgcn_ds_read_tr16_b64_v4i16((LAS v4i16_t*)pp)); }
DI void glds16(const void* gsrc, unsigned lds_dst) { unsigned keep;
    asm volatile("s_mov_b32 %0, m0\n\ts_mov_b32 m0, %2\n\ts_nop 0\n\tglobal_load_lds_dwordx4 %1, off\n\ts_mov_b32 m0, %0" : "=&s"(keep) : "v"(gsrc), "s"(lds_dst) : "memory"); }
DI void attn_unit(const Params& p, const Ctx& X, int l, int b, int h, int s0, int kbeg, int nk, float lam, float lam_init) {
    const bf16_t* P1 = (const bf16_t*)(p.ws + WS_P1); bf16_t* YC = (bf16_t*)(p.ws + WS_YC);
    int ln_ = X.lane; asm volatile("" : "+v"(ln_));
    const int lane = ln_, wid = X.wid, hi = lane >> 5, l31 = lane & 31;
    const int cc = wid >> 2, qs = s0 + (wid & 3) * 32;
    const size_t rowbase = (size_t)b * SB;
    LAS unsigned char* Kbuf = X.lds;
    LAS unsigned char* Vbuf = X.lds + 49152;
    LAS float* Xb = (LAS float*)X.lds + (wid & 3) * 4096;
    bf16x8 bq[4];
    { const bf16_t* qp = P1 + (rowbase + qs + l31) * P1LD + 3072 + h * 128 + cc * 64 + 8 * hi;
#pragma unroll
      for (int s = 0; s < 4; ++s) bq[s] = *(const bf16x8*)(qp + 16 * s); }
    const bf16_t* kbase = P1 + (rowbase + kbeg) * P1LD + 3584 + h * 128;
    const int krow = 8 * wid + (lane >> 3), kch = (lane & 7) ^ ((krow >> 1) & 7);
    const unsigned koff = (unsigned)(krow * P1LD + kch * 8) * 2u;
    const unsigned voff0 = (unsigned)((((wid & 3) * 16 + (lane >> 2)) * P1LD) + 512 + (wid >> 2) * 32 + (lane & 3) * 8) * 2u;
    const unsigned kl0 = (unsigned)(size_t)Kbuf + wid * 1024, vl0 = (unsigned)(size_t)Vbuf + wid * 1024;
    auto dma_k = [&](int kt, int slot) {
        const char* g = (const char*)(kbase + (size_t)kt * 64 * P1LD);
#pragma unroll
        for (int c2 = 0; c2 < 2; ++c2) glds16(g + koff + c2 * 128, (unsigned)__builtin_amdgcn_readfirstlane((int)(kl0 + slot * 16384 + c2 * 8192)));
    };
    auto dma_v = [&](int kt, int slot) {
        const char* g = (const char*)(kbase + (size_t)kt * 64 * P1LD);
#pragma unroll
        for (int j = 0; j < 2; ++j) glds16(g + voff0 + j * 128, (unsigned)__builtin_amdgcn_readfirstlane((int)(vl0 + slot * 16384 + j * 8192)));
    };
    auto qk = [&](f32x16 (&st)[2], int slot) {
        const LAS unsigned char* Kb = Kbuf + slot * 16384 + cc * 8192;
#pragma unroll
        for (int kb = 0; kb < 2; ++kb) {
#pragma unroll
            for (int r = 0; r < 16; ++r) st[kb][r] = 0.f;
            const int row = 32 * kb + l31;
#pragma unroll
            for (int s = 0; s < 4; ++s) { const bf16x8 a = *(const LAS bf16x8*)(Kb + row * 128 + (((2 * s + hi) ^ ((row >> 1) & 7)) << 4));
                st[kb] = __builtin_amdgcn_mfma_f32_32x32x16_bf16(a, bq[s], st[kb], 0, 0, 0); }
        }
    };
    float m = -1.0e30f, lsum = 0.f;
    f32x16 ot[4];
#pragma unroll
    for (int k = 0; k < 4; ++k)
#pragma unroll
        for (int r = 0; r < 16; ++r) ot[k][r] = 0.f;
    const int vbase = (4 * hi + ((lane & 15) >> 2)) * 64 + ((lane >> 4) & 1) * 32 + (lane & 3) * 8;
    f32x16 sc[2], sn[2];
    dma_k(0, 0); dma_v(0, 0); dma_k(1, 1);
    dma_k(2, 2); dma_v(1, 1);
    asm volatile("s_waitcnt vmcnt(4)" ::: "memory"); __builtin_amdgcn_s_barrier();
    qk(sc, 0);
    asm volatile("s_waitcnt lgkmcnt(0)" ::: "memory"); __builtin_amdgcn_s_barrier();
    int s0k = 0, s1k = 1;
    for (int kt = 0; kt < nk; ++kt) {
        const int s2k = 3 - s0k - s1k;
        const bool full = kt + 3 < nk;
        if (full) { dma_k(kt + 3, s0k); dma_v(kt + 2, s2k); }
        else if (kt + 2 < nk) dma_v(kt + 2, s2k);
        if (kt + 1 < nk) qk(sn, s1k);
        const LAS unsigned char* Vb = Vbuf + s0k * 16384 + vbase;
        bf16x8 vf[4][4];
#pragma unroll
        for (int ks = 0; ks < 4; ++ks)
#pragma unroll
            for (int blk = 0; blk < 4; ++blk) { const s16x4 lo = vtr(Vb + (blk * 4 + ks) * 1024), hh = vtr(Vb + (blk * 4 + ks) * 1024 + 512);
                vf[ks][blk] = (bf16x8){lo[0], lo[1], lo[2], lo[3], hh[0], hh[1], hh[2], hh[3]}; }
        float mx = sc[0][0];
#pragma unroll
        for (int r = 0; r < 16; ++r) { mx = fmaxf(mx, sc[0][r]); mx = fmaxf(mx, sc[1][r]); }
        mx = fmaxf(mx, __shfl_xor(mx, 32));
        if (__any(mx > m)) {
            const float mnew = fmaxf(m, mx), alpha = __builtin_amdgcn_exp2f(m - mnew); m = mnew; lsum *= alpha;
#pragma unroll
            for (int k = 0; k < 4; ++k)
#pragma unroll
                for (int r = 0; r < 16; ++r) ot[k][r] *= alpha;
        }
        float ps = 0.f;
#pragma unroll
        for (int kb = 0; kb < 2; ++kb)
#pragma unroll
            for (int r = 0; r < 16; ++r) { const float e = __builtin_amdgcn_exp2f(sc[kb][r] - m); sc[kb][r] = e; ps += e; }
        lsum += ps;
#pragma unroll
        for (int ks = 0; ks < 4; ++ks)
#pragma unroll
            for (int blk = 0; blk < 4; ++blk) asm volatile("" : "+v"(vf[ks][blk]));
#pragma unroll
        for (int ks = 0; ks < 4; ++ks) {
            const int kb = ks >> 1, s2 = ks & 1;
            u32x4 pw; pw.x = pk2(sc[kb][8 * s2 + 0], sc[kb][8 * s2 + 1]); pw.y = pk2(sc[kb][8 * s2 + 2], sc[kb][8 * s2 + 3]);
            pw.z = pk2(sc[kb][8 * s2 + 4], sc[kb][8 * s2 + 5]); pw.w = pk2(sc[kb][8 * s2 + 6], sc[kb][8 * s2 + 7]);
            const bf16x8 pf = __builtin_bit_cast(bf16x8, pw);
#pragma unroll
            for (int blk = 0; blk < 4; ++blk) ot[blk] = __builtin_amdgcn_mfma_f32_32x32x16_bf16(vf[ks][blk], pf, ot[blk], 0, 0, 0);
        }
#pragma unroll
        for (int kb = 0; kb < 2; ++kb) sc[kb] = sn[kb];
        if (full) asm volatile("s_waitcnt vmcnt(4) lgkmcnt(0)" ::: "memory"); else asm volatile("s_waitcnt vmcnt(0) lgkmcnt(0)" ::: "memory");
        __builtin_amdgcn_s_barrier();
        s0k = s1k; s1k = s2k;
    }
    const float ltot = lsum + __shfl_xor(lsum, 32), inv = 1.f / ltot;
    if (cc == 1) {
#pragma unroll
        for (int k = 0; k < 4; ++k)
#pragma unroll
            for (int r = 0; r < 16; ++r) Xb[(k * 16 + r) * 64 + lane] = ot[k][r] * inv;
    }
    __syncthreads();
    if (cc == 0) {
        float ss = 0.f;
#pragma unroll
        for (int k = 0; k < 4; ++k)
#pragma unroll
            for (int r = 0; r < 16; ++r) { const float o = ot[k][r] * inv - lam * Xb[(k * 16 + r) * 64 + lane]; ot[k][r] = o; ss += o * o; }
        ss += __shfl_xor(ss, 32);
        const float scl = rsqrtf(ss * (1.f / 128.f) + EPS) * (1.f - lam_init);
        bf16_t* yrow = YC + (rowbase + qs + l31) * 512 + h * 128;
        const float* gsub = p.diff_subln + l * 512 + h * 128;
#pragma unroll
        for (int k = 0; k < 4; ++k)
#pragma unroll
            for (int r4 = 0; r4 < 4; ++r4) { const int dv = 32 * k + 8 * r4 + 4 * hi; const f32x4 gg = *(const f32x4*)(gsub + dv);
                u32x2 w; w.x = pk2(ot[k][4 * r4] * scl * gg[0], ot[k][4 * r4 + 1] * scl * gg[1]); w.y = pk2(ot[k][4 * r4 + 2] * scl * gg[2], ot[k][4 * r4 + 3] * scl * gg[3]);
                *(u32x2*)(yrow + dv) = w; }
    }
    __syncthreads();
}
DI void attn_phase(const Params& p, const Ctx& X, int l) {
    const float lam_init = 0.8f - 0.6f * expf(-0.3f * (float)l);
    LAS float* misc = (LAS float*)(X.lds + LDS_MISC);
    if (X.wid == 0) { const float* lp = p.diff_lambda + l * 256; float a = lp[X.lane] * lp[64 + X.lane], b2 = lp[128 + X.lane] * lp[192 + X.lane];
        a = wave_sum(a); b2 = wave_sum(b2); if (X.lane == 0) misc[0] = expf(a) - expf(b2) + lam_init; }
    __syncthreads();
    const float lam = misc[0];
    const int nlat = (1024 - X.c + X.G - 1) / X.G, nctx = (l == 0 && X.c < 64) ? (64 - X.c + X.G - 1) / X.G : 0;
    for (int it = 0; it < nlat + nctx; ++it) {
        int b, h, s0, nk;
        if (it < nlat) {
            int bh, qb;
            if (X.G == 256) { bh = 4 * (X.c & 7) + it; qb = X.c >> 3; } else { const int U = it * X.G + X.c; bh = U >> 5; qb = U & 31; }
            b = bh >> 2; h = bh & 3; s0 = CTXL + qb * 128; nk = SB / 64;
        } else { const int U = (it - nlat) * X.G + X.c; b = U >> 3; h = (U >> 1) & 3; s0 = (U & 1) * 128; nk = CTXL / 64; }
        attn_unit(p, X, l, b, h, s0, 0, nk, lam, lam_init);
    }
}

DI void moe_scatter_phase(const Params& p, const Ctx& X) {
    LAS int* tot = (LAS int*)X.lds;
    LAS int* e1s = tot + 64;
    LAS int* e2s = e1s + 128;
    LAS int* pos0 = e2s + 128;
    LAS int* pos1 = pos0 + 128;
    const int* hist = (const int*)(p.ws + WS_HIST);
    const int tid = X.tid;
    LAS int* hl = tot + 1024;
    LAS int* ps = hl + 4096;
    for (int i = tid; i < X.G * 4; i += 512) ((LAS u32x4*)hl)[i] = ((const u32x4*)hist)[i];
    __syncthreads();
    { const int g = tid & 15, part = tid >> 4; int t = 0, mb = 0;
#pragma unroll
        for (int k = 0; k < 8; ++k) { const int cb = part * 8 + k; if (cb < X.G) { const int v = hl[cb * 16 + g]; t += v; mb += (cb < X.c) ? v : 0; } }
        ps[part * 32 + g] = t; ps[part * 32 + 16 + g] = mb; }
    __syncthreads();
    if (tid < 16) { int t = 0, mb = 0;
        for (int part = 0; part < 32; ++part) { t += ps[part * 32 + tid]; mb += ps[part * 32 + 16 + tid]; }
        tot[tid] = t; tot[16 + tid] = mb; }
    __syncthreads();
    if (tid == 0) { int tb = 0; for (int g = 0; g < 16; ++g) { tot[32 + g] = tb; tot[48 + g] = tb * 256; tb += (tot[g] + 255) >> 8; }
        if (X.c == 0) { int* grp = (int*)(p.ws + WS_GRP); for (int g = 0; g < 16; ++g) { grp[g] = tot[32 + g]; grp[16 + g] = (tot[g] + 255) >> 8; } } }
    const int tpb = (NLAT + X.G - 1) / X.G, n0 = X.c * tpb, n1 = (n0 + tpb < NLAT) ? n0 + tpb : NLAT, cnt = n1 - n0;
    const f32x4* route = (const f32x4*)(p.ws + WS_ROUTE);
    f32x4 rt = (f32x4){0.f, 0.f, 0.f, 0.f};
    if (tid < cnt) { rt = route[n0 + tid]; e1s[tid] = __float_as_int(rt[0]); e2s[tid] = __float_as_int(rt[1]); }
    __syncthreads();
    if (tid < cnt) {
        const int e1 = __float_as_int(rt[0]), e2 = __float_as_int(rt[1]); int r0 = 0, r1 = 0;
        for (int j = 0; j < tid; ++j) { r0 += (e1s[j] == e1) ? 1 : 0; r1 += (e2s[j] == e2) ? 1 : 0; }
        const int q0 = tot[48 + e1] + tot[16 + e1] + r0, q1 = tot[48 + 8 + e2] + tot[16 + 8 + e2] + r1;
        pos0[tid] = q0; pos1[tid] = q1;
        int* tokt = (int*)(p.ws + WS_TOK); float* wrow = (float*)(p.ws + WS_WROW);
        tokt[q0] = n0 + tid; wrow[q0] = rt[2]; tokt[q1] = n0 + tid; wrow[q1] = rt[3];
    }
    __syncthreads();
    const unsigned char* H = p.ws + WS_H; unsigned char* Xs = p.ws + WS_XS;
    for (int j = X.wid; j < cnt; j += 32) {
        u32x4 v0[4];
#pragma unroll
        for (int q = 0; q < 4; ++q) { const int jq = j + 8 * q; if (jq < cnt) { const int n = n0 + jq, b = n >> 12, t = n & 4095; const size_t R = (size_t)b * SB + CTXL + t; v0[q] = *(const u32x4*)(H + R * D + X.lane * 16); } }
#pragma unroll
        for (int q = 0; q < 4; ++q) { const int jq = j + 8 * q; if (jq < cnt) { *(u32x4*)(Xs + (size_t)pos0[jq] * D + X.lane * 16) = v0[q]; *(u32x4*)(Xs + (size_t)pos1[jq] * D + X.lane * 16) = v0[q]; } }
    }
}
DI void moe_order_setup(const Params& p, const Ctx& X, int g0, int ng, int npn, LAS int* tab) {
    const int* grp = (const int*)(p.ws + WS_GRP);
    if (X.tid == 0) { int cu = 0; for (int j = 0; j < ng; ++j) { tab[j] = cu; cu += grp[16 + g0 + j] * npn; tab[32 + j] = grp[g0 + j]; } tab[ng] = cu; }
    __syncthreads();
}

#define XB_TMO      128
#define XB_XCNT(j)  (256  + 64 * (j))
#define XB_XSUB(j)  (1280 + 64 * (j))
#define XB_XGEN(j)  (2304 + 64 * (j))
#define XB_TOP      3328
#define XB_TOPGEN   3392
#define XCD_BAR_WORDS 3456
#define XB_SPIN_CAP (1u << 18)
__device__ __forceinline__ unsigned xb_ld(unsigned* p)              { return __hip_atomic_load(p, __ATOMIC_RELAXED, __HIP_MEMORY_SCOPE_AGENT); }
__device__ __forceinline__ unsigned xb_add(unsigned* p, unsigned v) { return __hip_atomic_fetch_add(p, v, __ATOMIC_RELAXED, __HIP_MEMORY_SCOPE_AGENT); }
__device__ __forceinline__ unsigned xb_xcc_id() { return (unsigned)__builtin_amdgcn_s_getreg((3 << 11) | 20) & 0xFu; }
#define XB_SPIN(cond, bar) do { unsigned _sp = 0; while (cond) { __builtin_amdgcn_s_sleep(1); \
    if ((++_sp & 255u) == 0u) { if (xb_ld(&(bar)[XB_TMO])) break; if (_sp > XB_SPIN_CAP) { atomicAdd(&(bar)[XB_TMO], 1u); break; } } } } while (0)
struct XcdBarrier { unsigned* bar; unsigned x; volatile LAS unsigned* st; };
__device__ __forceinline__ XcdBarrier xcd_barrier_post(unsigned* bar, volatile LAS unsigned* st) {
    XcdBarrier b; b.bar = bar; b.x = xb_xcc_id(); b.st = st;
    if (threadIdx.x == 0) (void)xb_add(&bar[XB_XCNT(b.x)], 1u);
    return b;
}
__device__ __forceinline__ void xcd_barrier_complete(unsigned* bar, unsigned x, unsigned& nloc, unsigned& nx) {
    const unsigned G = gridDim.x * gridDim.y * gridDim.z;
    unsigned sum, cnt, mine, sp = 0u;
    for (;;) {
        sum = 0u; cnt = 0u; mine = 0u;
#pragma unroll 1
        for (unsigned j = 0; j < 16; ++j) { const unsigned c = xb_ld(&bar[XB_XCNT(j)]); sum += c; cnt += (c > 0u) ? 1u : 0u; mine = (j == x) ? c : mine; }
        if (sum == G) break;
        __builtin_amdgcn_s_sleep(1);
        if ((++sp & 255u) == 0u) { if (xb_ld(&bar[XB_TMO])) break; if (sp > XB_SPIN_CAP) { atomicAdd(&bar[XB_TMO], 1u); break; } }
    }
    nloc = mine > 0u ? mine : 1u; nx = cnt > 0u ? cnt : 1u;
}
__device__ __forceinline__ void xcd_barrier(const XcdBarrier& b) {
    asm volatile("s_waitcnt vmcnt(0)" ::: "memory");
    __syncthreads();
    if (threadIdx.x == 0) {
        unsigned* bar = b.bar;
        __builtin_amdgcn_s_waitcnt(0);
        unsigned nloc = b.st[0], nx = b.st[1];
        if (nloc == 0u) { xcd_barrier_complete(bar, b.x, nloc, nx); b.st[0] = nloc; b.st[1] = nx; }
        const unsigned old = xb_add(&bar[XB_XSUB(b.x)], 1u);
        const unsigned gen = old / nloc;
        if (old + 1u == (gen + 1u) * nloc) {
            __builtin_amdgcn_fence(__ATOMIC_RELEASE, "agent");
            asm volatile("s_waitcnt vmcnt(0)" ::: "memory");
            const unsigned og = xb_add(&bar[XB_TOP], 1u);
            const unsigned tg = og / nx;
            if (og + 1u == (tg + 1u) * nx) xb_add(&bar[XB_TOPGEN], 1u);
            else XB_SPIN(xb_ld(&bar[XB_TOPGEN]) == tg, bar);
            __builtin_amdgcn_fence(__ATOMIC_ACQUIRE, "agent");
            xb_add(&bar[XB_XGEN(b.x)], 1u);
            asm volatile("s_waitcnt vmcnt(0)" ::: "memory");
        } else {
            XB_SPIN(xb_ld(&bar[XB_XGEN(b.x)]) == gen, bar);
            __builtin_amdgcn_fence(__ATOMIC_ACQUIRE, "agent");
            asm volatile("s_waitcnt vmcnt(0)" ::: "memory");
        }
    }
    __syncthreads();
}

constexpr int NPHASE = 21;
__global__ void __launch_bounds__(512, 2) mega(Params p) {
    extern __shared__ __attribute__((aligned(16))) unsigned char smem[];
    Ctx X; X.lds = (LAS unsigned char*)smem; X.tid = threadIdx.x; X.lane = X.tid & 63; X.wid = __builtin_amdgcn_readfirstlane(X.tid >> 6); X.G = gridDim.x; X.c = blockIdx.x; X.ws = p.ws;
    volatile LAS unsigned* barw = (volatile LAS unsigned*)(X.lds + LDS_BARW);
    if (X.tid < 4) barw[X.tid] = 0u;
    __syncthreads();
    XcdBarrier bar; bar.bar = (unsigned*)(p.ws + WS_CTL); bar.x = 0; bar.st = barw;
    const int lo = p.lo, hi = p.hi;
    if (hi - lo > 1) bar = xcd_barrier_post((unsigned*)(p.ws + WS_CTL), barw);
#define IN(k) (lo <= (k) && (k) < hi)
#define FRESH() do { int t_ = threadIdx.x; asm volatile("" : "+v"(t_)); X.tid = t_; X.lane = t_ & 63; X.wid = __builtin_amdgcn_readfirstlane(t_ >> 6); } while (0)
#define EN(s) (((EN_MASK) >> (s)) & 1)
#define NREP(s) ((((REP_MASK) >> (s)) & 1) ? 2 : 1)
#define SEAM(k) do { if (IN(k) && IN((k) + 1)) xcd_barrier(bar); } while (0)
#define SITE_PTRS() unsigned char* ws = p.ws; asm volatile("" : "+s"(ws)); float* mod = (float*)(ws + WS_MOD); bf16_t* Hb = (bf16_t*)(ws + WS_H); (void)mod; (void)Hb

    if (EN(0) && IN(0)) { FRESH(); conv_phase<0>(p, X); __syncthreads(); if (NREP(0) == 2) { conv_phase<0>(p, X); __syncthreads(); } adaln_phase(p, X); rope_phase(p, X); __syncthreads(); }
    SEAM(0);
    auto layer = [&](auto lc) {
        constexpr int l = decltype(lc)::value;
        const int pb = 1 + 9 * l;
        if (EN(1) && IN(pb + 0)) for (int rep = 0; rep < NREP(1); ++rep) { FRESH(); norm_phase(p, X, l, 0, l == 0); }
        SEAM(pb + 0);
        if (EN(2) && IN(pb + 1)) {
            SITE_PTRS(); const bf16_t* Win = (const bf16_t*)(ws + WS_WIN) + (size_t)l * 8192 * 1024;
            pg8::Gemm g{Hb, Win, 1024}; TileOrder S; S.init(NMT, 20, X.G, X.c, 0, 0); S.reps = NREP(2);
            LAS float* ropeL = (LAS float*)(X.lds + 131072); LAS float* lbL = (LAS float*)(X.lds + LDS_MISC + 2048);
            __syncthreads();
            for (int i = threadIdx.x; i < 2048; i += 512) ropeL[i] = ((const float*)(ws + WS_ROPE))[i];
            for (int i = threadIdx.x; i < 1024; i += 512) lbL[i] = ((const float*)(ws + WS_LB))[l * 1024 + i];
            __syncthreads();
            EpiInproj E{(bf16_t*)(ws + WS_P1), (bf16_t*)(ws + WS_OG), (const LAS f32x2*)ropeL, (const LAS float*)lbL};
            pg8::gemm_phase<EpiInproj, TileOrder>(X.lds, g, S, E);
        }
        SEAM(pb + 1);
        if (IN(pb + 2)) { if (EN(3)) for (int rep = 0; rep < NREP(3); ++rep) { FRESH(); hgrn_phase(p, X, l); } __syncthreads(); if (EN(4)) for (int rep = 0; rep < NREP(4); ++rep) { FRESH(); mlp_phase(p, X, l); } __syncthreads(); if (EN(5)) for (int rep = 0; rep < NREP(5); ++rep) { FRESH(); attn_phase(p, X, l); } }
        SEAM(pb + 2);
        if (EN(6) && IN(pb + 3)) {
            SITE_PTRS(); const bf16_t* Win = (const bf16_t*)(ws + WS_WIN) + (size_t)l * 8192 * 1024;
            FRESH(); readout_phase(p, X, l);
            pg8::Gemm g{Hb, Win, 1024}; TileOrder S; S.init(l ? 128 : NMT, 12, X.G, X.c, l, 20);
            EpiStore<1> E{(bf16_t*)(ws + WS_G), 3072};
            S.reps = NREP(6); pg8::gemm_phase<EpiStore<1>, TileOrder>(X.lds, g, S, E);
        }
        SEAM(pb + 3);
        if (EN(7) && IN(pb + 4)) for (int rep = 0; rep < NREP(7); ++rep) {
            SITE_PTRS();
            pg8::Gemm g{(const bf16_t*)(ws + WS_OB), (const bf16_t*)(ws + WS_WBR) + (size_t)l * 3 * 1024 * 512, 512};
            MergeOrder S; S.t.init(l ? 128 : NMT, 4, X.G, X.c, l, 0);
            EpiMerge E{(bf16_t*)(ws + WS_MRG), (const bf16_t*)(ws + WS_G)};
            pg8::gemm_phase<EpiMerge, MergeOrder, true, false, true>(X.lds, g, S, E);
        }
        SEAM(pb + 4);
        if (EN(8) && IN(pb + 5)) {
            SITE_PTRS();
            pg8::Gemm g{(const bf16_t*)(ws + WS_MRG), (const bf16_t*)(ws + WS_WOUT) + (size_t)l * 1024 * 1024, 1024};
            TileOrder S; S.init(l ? 128 : NMT, 4, X.G, X.c, l, 0);
            EpiResid E{l == 0 ? p.x : p.out, l == 0 ? p.ctx : (const float*)(ws + WS_CTX), p.out, (float*)(ws + WS_CTX), mod + (size_t)l * 9 * 6144 + 2048};
            pg8::gemm_phase<EpiResid, TileOrder>(X.lds, g, S, E);
        }
        SEAM(pb + 5);
        if (EN(9) && IN(pb + 6)) { __syncthreads(); FRESH(); if (l == 0) norm_phase(p, X, 0, 1, false); else { norm2_router_phase(p, X); __syncthreads(); conv_phase<1>(p, X); if (NREP(9) == 2) { __syncthreads(); conv_phase<1>(p, X); } } }
        SEAM(pb + 6);
        if constexpr (l == 0) {
            if (EN(10) && IN(8)) {
                SITE_PTRS();
                pg8::Gemm g{Hb, (const bf16_t*)(ws + WS_WGU), 1024}; TileOrder S; S.init(NMT, 22, X.G, X.c, 0, 0); S.reps = NREP(10);
                EpiSwiglu E{(bf16_t*)(ws + WS_HID), DFF};
                pg8::gemm_phase<EpiSwiglu, TileOrder>(X.lds, g, S, E);
            }
            SEAM(8);
            if (EN(11) && IN(9)) {
                SITE_PTRS();
                pg8::Gemm g{(const bf16_t*)(ws + WS_HID), (const bf16_t*)(ws + WS_WDN), DFF}; TileOrder S; S.init(NMT, 4, X.G, X.c, 0, 0);
                EpiResid E{p.out, (const float*)(ws + WS_CTX), p.out, (float*)(ws + WS_CTX), mod + 5120};
                pg8::gemm_phase<EpiResid, TileOrder>(X.lds, g, S, E);
            }
            SEAM(9);
        }
    };
    layer(std::integral_constant<int, 0>{}); layer(std::integral_constant<int, 1>{});
    if (EN(12) && IN(17)) for (int rep = 0; rep < NREP(12); ++rep) { __syncthreads(); FRESH(); moe_scatter_phase(p, X); }
    SEAM(17);
    {
        LAS int* tab = (LAS int*)(X.lds + LDS_MISC + 1024);
        if (EN(13) && IN(18)) for (int rep = 0; rep < NREP(13); ++rep) {
            SITE_PTRS();
            __syncthreads(); moe_order_setup(p, X, 0, 16, 28, tab);
            pg8::Gemm g{(const bf16_t*)(ws + WS_XS), (const bf16_t*)(ws + WS_WMGU), 512};
            MoeOrder S{tab, 16, 28, X.G, X.c, 0};
            EpiSwigluT<true> E{(bf16_t*)(ws + WS_HS), DFFE};
            pg8::gemm_phase<EpiSwigluT<true>, MoeOrder, true, true>(X.lds, g, S, E);
        }
        SEAM(18);
        if (EN(14) && IN(19)) {
            SITE_PTRS();
            __syncthreads(); moe_order_setup(p, X, 0, 16, 4, tab);
            pg8::Gemm g{(const bf16_t*)(ws + WS_HS), (const bf16_t*)(ws + WS_WMDN), DFFE / 2};
            MoeOrder S{tab, 16, 4, X.G, X.c, 0};
            EpiMoeDown E{(const int*)(ws + WS_TOK), (const float*)(ws + WS_WROW), (bf16_t*)(ws + WS_Y0), (bf16_t*)(ws + WS_Y1)};
            pg8::gemm_phase<EpiMoeDown, MoeOrder, true, true>(X.lds, g, S, E);
        }
        SEAM(19);
    }
    if (EN(15) && IN(20)) { FRESH(); final_phase(p, X); }
#undef IN
#undef SEAM
}

extern "C" void kernel_launch(void* const* d_in, const int* in_sizes, int n_in, void* d_out, int out_size, void* d_ws, size_t ws_size, hipStream_t stream) {
    static int grid = 0;
    if (grid == 0) {
        if (n_in != 26 || ws_size < WS_END) { fprintf(stderr, "kernel_launch: unexpected n_in %d / ws_size %zu (need %zu)\n", n_in, ws_size, (size_t)WS_END); grid = -1; return; }
        int dev = 0, cus = 0;
        if (hipGetDevice(&dev) != hipSuccess || hipDeviceGetAttribute(&cus, hipDeviceAttributeMultiprocessorCount, dev) != hipSuccess) { grid = -1; return; }
        if (hipFuncSetAttribute((const void*)mega, hipFuncAttributeMaxDynamicSharedMemorySize, LDS_BYTES) != hipSuccess) { fprintf(stderr, "kernel_launch: hipFuncSetAttribute failed\n"); grid = -1; return; }
        int per_cu = 0;
        if (hipOccupancyMaxActiveBlocksPerMultiprocessor(&per_cu, (const void*)mega, 512, LDS_BYTES) != hipSuccess || per_cu < 1) fprintf(stderr, "kernel_launch: occupancy query reports %d\n", per_cu);
        (void)hipGetLastError();
        grid = cus < 256 ? cus : 256;
    }
    if (grid < 0) return;
    (void)hipMemsetAsync((char*)d_ws + WS_CTL, 0, CTL_ZERO_BYTES, stream);
    Params p{};
    const float** pp = (const float**)&p;
    for (int i = 0; i < 26; ++i) pp[i] = (const float*)d_in[i];
    p.out = (float*)d_out; p.ws = (unsigned char*)d_ws;
#if MK_SPLIT
    for (int k = 0; k < NPHASE; ++k) { if (k == 16) {} p.lo = k; p.hi = k + 1; hipLaunchKernelGGL(mega, dim3(grid), dim3(512), LDS_BYTES, stream, p); }
#else
    p.lo = 0; p.hi = NPHASE;
    hipLaunchKernelGGL(mega, dim3(grid), dim3(512), LDS_BYTES, stream, p);
#endif
}
```

```cpp
#include <hip/hip_runtime.h>
#include <stdint.h>
#include <stdio.h>
#include <type_traits>

#ifndef EN_MASK
#define EN_MASK 0xFFFF
#endif
#ifndef REP_MASK
#define REP_MASK 0
#endif
#ifndef MK_SPLIT
#define MK_SPLIT 0
#define TP_PHASE (-1)
#define TP_SUB 0
#define TP_SUBL 0
#define TP_MULT 8
#define TP_MASK 0
#define TP_HIT(k) (TP_PHASE == (k) || ((TP_MASK >> (k)) & 1))
#endif

#define DI __device__ __forceinline__
#define LAS __attribute__((address_space(3)))
typedef unsigned short bf16_t;
typedef short bf16x8 __attribute__((ext_vector_type(8)));
typedef short s16x4 __attribute__((ext_vector_type(4)));
typedef float f32x2 __attribute__((ext_vector_type(2)));
typedef float f32x4 __attribute__((ext_vector_type(4)));
typedef float f32x16 __attribute__((ext_vector_type(16)));
typedef unsigned u32x2 __attribute__((ext_vector_type(2)));
typedef unsigned u32x4 __attribute__((ext_vector_type(4)));
typedef __bf16 bf16x2_t __attribute__((ext_vector_type(2)));
typedef int v8i32 __attribute__((ext_vector_type(8)));

constexpr int D = 1024, NBATCH = 8, SEQ = 4096, CTXL = 256;
constexpr int SB = SEQ + CTXL;
constexpr int T = NBATCH * SB;
constexpr int NMT = T / 256;
constexpr int NLAT = NBATCH * SEQ;
constexpr int INCOLS = 8192, P1LD = 4608, DFF = 2816, DFFE = 3584, NEXP = 8;
constexpr float EPS = 1e-6f;
constexpr int MAXROWS_MOE = 69632;

constexpr size_t MiB = (size_t)1 << 20;
constexpr size_t WS_CTL = 0;
constexpr size_t CTL_ZERO_BYTES = 65536;
constexpr size_t WS_MOD = 1 * MiB;
constexpr size_t WS_ROPE = 1 * MiB + 512 * 1024;
constexpr size_t WS_ROUTE = 2 * MiB;
constexpr size_t WS_HIST = 3 * MiB;
constexpr size_t WS_TOK = 4 * MiB;
constexpr size_t WS_WROW = 5 * MiB;
constexpr size_t WS_GRP = 6 * MiB;
constexpr size_t WS_LB = 7 * MiB;
constexpr size_t WS_POS = 8 * MiB;
constexpr size_t WS_CTX = 9 * MiB;
constexpr size_t WS_WIN = 17 * MiB;
constexpr size_t WS_WBR = 49 * MiB;
constexpr size_t WS_WOUT = 55 * MiB;
constexpr size_t WS_WGU = 59 * MiB;
constexpr size_t WS_WDN = 70 * MiB;
constexpr size_t WS_H = 77 * MiB;
constexpr size_t WS_P1 = 145 * MiB;
constexpr size_t WS_OG = 451 * MiB;
constexpr size_t WS_OF = 485 * MiB;
constexpr size_t WS_OB = 519 * MiB;
constexpr size_t WS_YB = 553 * MiB;
constexpr size_t WS_YC = 587 * MiB;
constexpr size_t WS_G = 145 * MiB;
constexpr size_t WS_MRG = 383 * MiB;
constexpr size_t WS_HID = 145 * MiB;
constexpr size_t WS_WMGU = 469 * MiB;
constexpr size_t WS_WMDN = 525 * MiB;
constexpr size_t WS_XS = 333 * MiB;
constexpr size_t WS_HS = 17 * MiB;
constexpr size_t WS_Y1 = 333 * MiB;
constexpr size_t WS_SLAB = 383 * MiB;
constexpr size_t WS_DSLAB = 469 * MiB;
constexpr size_t WS_OPSLAB = 469 * MiB;
constexpr size_t WS_Y0 = 397 * MiB;
constexpr size_t WS_END = 637 * MiB;
static_assert(WS_WDN + (size_t)1024 * DFF * 2 <= WS_H, "weights");
static_assert(WS_P1 + (size_t)T * P1LD * 2 <= WS_OG && WS_G + (size_t)T * 3072 * 2 <= WS_MRG && WS_MRG + (size_t)T * 1024 * 2 <= WS_OG, "arena");
static_assert(WS_YC + (size_t)T * 512 * 2 <= WS_END && WS_WMGU + (size_t)8 * 7168 * 1024 <= WS_WMDN && WS_WMDN + (size_t)8 * 1024 * DFFE <= WS_END, "arena end");
static_assert(WS_XS + (size_t)MAXROWS_MOE * 1024 <= WS_WMGU && WS_HS + (size_t)MAXROWS_MOE * DFFE <= WS_XS && WS_HID + (size_t)T * DFF * 2 <= WS_END, "moe");

constexpr int LDS_BYTES = 147456;
constexpr int LDS_MISC = 139264;
constexpr int LDS_BARW = LDS_BYTES - 16;

struct Params {
    const float *x, *c, *ctx, *c_ctx, *w_ada, *b_ada, *g_norm1, *g_norm2, *w_in, *hgrn_lb, *hgrn_gnorm, *mlp_vnorm, *mlp_ws, *mlp_bs,
        *diff_lambda, *diff_subln, *w_branch, *w_out, *ffn_wg, *ffn_wu, *ffn_wd, *moe_router, *moe_wg, *moe_wu, *moe_wd, *g_final;
    float* out; unsigned char* ws; int lo, hi;
};

DI unsigned pk2(float lo, float hi) { f32x2 v = {lo, hi}; bf16x2_t b = __builtin_convertvector(v, bf16x2_t); return __builtin_bit_cast(unsigned, b); }
DI float bflo(unsigned u) { return __uint_as_float(u << 16); }
DI float bfhi(unsigned u) { return __uint_as_float(u & 0xffff0000u); }
DI float bf1(bf16_t u) { return __uint_as_float((unsigned)u << 16); }
DI float wave_sum(float v) {
#pragma unroll
    for (int o = 1; o < 64; o <<= 1) v += __shfl_xor(v, o);
    return v;
}
DI float sigm(float x) { return __builtin_amdgcn_rcpf(1.f + __builtin_amdgcn_exp2f(-1.4426950408889634f * x)); }
DI float gelu_tanh(float x) { const float u = 0.7978845608028654f * (x + 0.044715f * x * x * x); return x * __builtin_amdgcn_rcpf(1.f + __builtin_amdgcn_exp2f(-2.885390081777927f * u)); }
DI f32x4 exp2_4(f32x4 a) { return (f32x4){__builtin_amdgcn_exp2f(a[0]), __builtin_amdgcn_exp2f(a[1]), __builtin_amdgcn_exp2f(a[2]), __builtin_amdgcn_exp2f(a[3])}; }
DI f32x4 rcp_4(f32x4 a) { return (f32x4){__builtin_amdgcn_rcpf(a[0]), __builtin_amdgcn_rcpf(a[1]), __builtin_amdgcn_rcpf(a[2]), __builtin_amdgcn_rcpf(a[3])}; }
DI f32x4 sigm4(f32x4 x) { return rcp_4(exp2_4(x * (-1.4426950408889634f)) + 1.0f); }
DI f32x4 gelu_tanh4(f32x4 x) { const f32x4 q = (x * x) * (-0.10294324f) + (-2.3022082f); return x * rcp_4(exp2_4(x * q) + 1.0f); }
#define LDS_WAIT() asm volatile("s_waitcnt lgkmcnt(0)" ::: "memory")
DI unsigned pk4_fp8(float a, float b, float c, float d) {
    a = __builtin_amdgcn_fmed3f(a, -448.f, 448.f); b = __builtin_amdgcn_fmed3f(b, -448.f, 448.f); c = __builtin_amdgcn_fmed3f(c, -448.f, 448.f); d = __builtin_amdgcn_fmed3f(d, -448.f, 448.f);
    int w = __builtin_amdgcn_cvt_pk_fp8_f32(a, b, 0, false); w = __builtin_amdgcn_cvt_pk_fp8_f32(c, d, w, true); return (unsigned)w; }
constexpr float W8SCALE = 64.f;

namespace pg8 {
constexpr int BM = 256, BK = 64, HALF = 128, HTB = HALF * BK * 2, STAGE_BYTES = 8 * HTB;
__host__ __device__ __forceinline__ int lds_byte(int r, int c) { const int st = (r >> 4) * 2 + (c >> 5), rr = r & 15, cc = c & 31, ob = rr * 64 + cc * 2; return st * 1024 + (ob ^ (((ob >> 9) & 1) << 5)); }
__host__ __device__ __forceinline__ void stage_rc(int b, int& R, int& C) { const int st = b / 1024, sb = b % 1024, swz = sb ^ (((sb >> 9) & 1) << 5); R = (st >> 1) * 16 + swz / 64; C = (st & 1) * 32 + (swz % 64) / 2; }
__host__ __device__ __forceinline__ int perm32(int rho) { const int n = rho >> 4, i = rho & 15; return 8 * (i >> 2) + 4 * n + (i & 3); }

struct Unit { int pm, pn, pa, pb, aux, kt0, nkt; };
struct Gemm { const bf16_t* A; const bf16_t* Bt; int K; };

template <class Epi, class Sched, bool ALIGN_EPI = true, bool FP8 = false, bool CHAIN = false, bool KSPLIT = false>
DI void gemm_phase(LAS unsigned char* lds, const Gemm g, const Sched& S, const Epi& E) {
    int tid_ = threadIdx.x; asm volatile("" : "+v"(tid_));
    const int tid = tid_, wid = __builtin_amdgcn_readfirstlane(tid >> 6), lane = tid & 63, wr = wid >> 2, wc = wid & 3, fr = lane & 15, fq = lane >> 4;
    const int K = g.K, nt = K / BK;
    unsigned voffA[2], voffB[2];
#pragma unroll
    for (int i = 0; i < 2; ++i) { int R, C; stage_rc(tid * 16 + i * 8192, R, C); const int Rb = Epi::PERM ? ((R & ~31) + perm32(R & 31)) : R;
        voffA[i] = (unsigned)(R * K + C) * 2u; voffB[i] = (unsigned)(Rb * K + C) * 2u; }
    const size_t kstep = (size_t)(BK * 2);
    const size_t hstep = (size_t)HALF * K * 2;
    const size_t tstep = 2 * hstep;
    const unsigned ldsw = (unsigned)wid * 1024u;
    const int aoff = lds_byte(wr * 64 + fr, fq * 8), boff = lds_byte(wc * 32 + fr, fq * 8);
#define PG8_SA(b, h) (((b) * 2 + (h)) * HTB)
#define PG8_SB(b, h) ((4 + (b) * 2 + (h)) * HTB)
#define PG8_STAGE(bufoff, gbase, voff) do { _Pragma("unroll") for (int _i = 0; _i < 2; ++_i) { unsigned vo_ = (voff)[_i]; asm volatile("" : "+v"(vo_));     \
        __builtin_amdgcn_global_load_lds((const unsigned*)((const char*)(gbase) + vo_), (LAS unsigned*)(lds + (bufoff) + ldsw + _i * 8192), 16, 0, 0); } } while (0)
typedef int v4i32_ __attribute__((ext_vector_type(4)));
#define PG8_LDA(dst, b, h) do { _Pragma("unroll") for (int m = 0; m < 4; ++m) { if constexpr (FP8) { const v4i32_ lo_ = *(const LAS v4i32_*)(lds + PG8_SA(b, h) + aoff + m * 2048), hi_ = *(const LAS v4i32_*)(lds + PG8_SA(b, h) + aoff + m * 2048 + 1024); \
            dst##8[m] = __builtin_shufflevector(lo_, hi_, 0, 1, 2, 3, 4, 5, 6, 7); } else { _Pragma("unroll") for (int k = 0; k < 2; ++k) dst[m][k] = *(const LAS bf16x8*)(lds + PG8_SA(b, h) + aoff + m * 2048 + k * 1024); } } } while (0)
#define PG8_LDB(dst, b, h) do { _Pragma("unroll") for (int n = 0; n < 2; ++n) { if constexpr (FP8) { const v4i32_ lo_ = *(const LAS v4i32_*)(lds + PG8_SB(b, h) + boff + n * 2048), hi_ = *(const LAS v4i32_*)(lds + PG8_SB(b, h) + boff + n * 2048 + 1024); \
            dst##8[n] = __builtin_shufflevector(lo_, hi_, 0, 1, 2, 3, 4, 5, 6, 7); } else { _Pragma("unroll") for (int k = 0; k < 2; ++k) dst[n][k] = *(const LAS bf16x8*)(lds + PG8_SB(b, h) + boff + n * 2048 + k * 1024); } } } while (0)
#define PG8_MMA(ai, bj, At, Bt) do { __builtin_amdgcn_s_setprio(1); _Pragma("unroll") for (int m = 0; m < 4; ++m) _Pragma("unroll") for (int n = 0; n < 2; ++n) { \
        if constexpr (FP8) asm volatile("v_mfma_scale_f32_16x16x128_f8f6f4 %0, %1, %2, %0, %3, %3 op_sel_hi:[0,0,0]" : "+v"(acc[ai][bj][m][n]) : "v"(Bt##8[n]), "v"(At##8[m]), "v"(sc7f));   \
        else { _Pragma("unroll") for (int k = 0; k < 2; ++k) acc[ai][bj][m][n] = __builtin_amdgcn_mfma_f32_16x16x32_bf16(Bt[n][k], At[m][k], acc[ai][bj][m][n], 0, 0, 0); } } \
        __builtin_amdgcn_s_setprio(0); } while (0)
#define PG8_WAIT_V(n) asm volatile("s_waitcnt vmcnt(" #n ")" ::: "memory")
#define PG8_WAIT_L(n) asm volatile("s_waitcnt lgkmcnt(" #n ")" ::: "memory")
#define PG8_BAR __builtin_amdgcn_s_barrier()
#define PG8_SCHED __builtin_amdgcn_sched_barrier(0)
    Unit cur, nxt; int ui = 0;
    if (!S.next(0, cur)) return;
    f32x4 acc[2][2][4][2];
#pragma unroll
    for (int a = 0; a < 2; ++a)
#pragma unroll
        for (int b = 0; b < 2; ++b)
#pragma unroll
            for (int m = 0; m < 4; ++m)
#pragma unroll
                for (int n = 0; n < 2; ++n) acc[a][b][m][n] = (f32x4){0.f, 0.f, 0.f, 0.f};
    bf16x8 At[4][2], B0[2][2], B1[2][2]; v8i32 At8[4], B08[2], B18[2];
    const int sc7f = 0x7F7F7F7F;
    const char* cA = (const char*)g.A + (size_t)cur.pa * tstep; const char* cB = (const char*)g.Bt + (size_t)cur.pb * tstep;
    if constexpr (KSPLIT) { cA += (size_t)cur.kt0 * kstep; cB += (size_t)cur.kt0 * kstep; }
    PG8_STAGE(PG8_SB(0, 0), cB, voffB); PG8_STAGE(PG8_SB(0, 1), cB + hstep, voffB); PG8_STAGE(PG8_SA(0, 0), cA, voffA); PG8_STAGE(PG8_SA(0, 1), cA + hstep, voffA);
    if (wr == 1) PG8_BAR;
    PG8_WAIT_V(2); PG8_BAR;
    PG8_STAGE(PG8_SB(1, 0), cB + kstep, voffB); PG8_STAGE(PG8_SA(1, 0), cA + kstep, voffA); PG8_STAGE(PG8_SB(1, 1), cB + hstep + kstep, voffB);
    PG8_WAIT_V(6); PG8_BAR;
    for (;;) {
        const bool has_next = S.next(ui + 1, nxt);
        const char* nA = has_next ? (const char*)g.A + (size_t)nxt.pa * tstep : cA; const char* nB = has_next ? (const char*)g.Bt + (size_t)nxt.pb * tstep : cB;
        if constexpr (KSPLIT) { if (has_next) { nA += (size_t)nxt.kt0 * kstep; nB += (size_t)nxt.kt0 * kstep; } }
        const int ntu = KSPLIT ? cur.nkt : nt;
#pragma clang loop unroll(disable)
        for (int t = 0; t < ntu; t += 2) {
            const bool last = (t == ntu - 2);
            const char* a1 = cA + (size_t)(t + 1) * kstep;
            const char* a2 = last ? nA : cA + (size_t)(t + 2) * kstep; const char* b2 = last ? nB : cB + (size_t)(t + 2) * kstep;
            const char* a3 = a2 + kstep; const char* b3 = b2 + kstep;
            PG8_LDB(B0, 0, 0); PG8_LDB(B1, 0, 1); PG8_SCHED; PG8_LDA(At, 0, 0); PG8_STAGE(PG8_SA(1, 1), a1 + hstep, voffA);
            PG8_WAIT_V(8); PG8_WAIT_L(0); PG8_BAR; PG8_MMA(0, 0, At, B0); PG8_MMA(0, 1, At, B1); PG8_BAR; PG8_SCHED;
            PG8_LDA(At, 0, 1); PG8_STAGE(PG8_SB(0, 0), b2, voffB); PG8_STAGE(PG8_SB(0, 1), b2 + hstep, voffB); PG8_STAGE(PG8_SA(0, 0), a2, voffA);
            PG8_WAIT_V(8); PG8_WAIT_L(0); PG8_BAR; PG8_MMA(1, 0, At, B0); PG8_MMA(1, 1, At, B1); PG8_BAR; PG8_SCHED;
            PG8_LDB(B0, 1, 0); PG8_LDB(B1, 1, 1); PG8_SCHED; PG8_LDA(At, 1, 0); PG8_STAGE(PG8_SA(0, 1), a2 + hstep, voffA);
            PG8_WAIT_V(8); PG8_WAIT_L(0); PG8_BAR; PG8_MMA(0, 0, At, B0); PG8_MMA(0, 1, At, B1); PG8_BAR; PG8_SCHED;
            PG8_LDA(At, 1, 1); PG8_STAGE(PG8_SB(1, 0), b3, voffB); PG8_STAGE(PG8_SB(1, 1), b3 + hstep, voffB); PG8_STAGE(PG8_SA(1, 0), a3, voffA);
            PG8_WAIT_V(8); PG8_WAIT_L(0); PG8_BAR; PG8_MMA(1, 0, At, B0); PG8_MMA(1, 1, At, B1); PG8_BAR; PG8_SCHED;
        }
        if constexpr (ALIGN_EPI) { if (wr == 0) PG8_BAR; }
        if constexpr (FP8) asm volatile("s_nop 15\n\ts_nop 7" : "+v"(acc[1][1][0][0]), "+v"(acc[1][1][0][1]), "+v"(acc[1][1][1][0]), "+v"(acc[1][1][1][1]), "+v"(acc[1][1][2][0]), "+v"(acc[1][1][2][1]), "+v"(acc[1][1][3][0]), "+v"(acc[1][1][3][1]) :: "memory");
        E(acc, cur, wr, wc, fr, fq);
        if (!has_next) break;
        if (!(CHAIN && cur.aux < 2)) {
#pragma unroll
        for (int a = 0; a < 2; ++a)
#pragma unroll
            for (int b = 0; b < 2; ++b)
#pragma unroll
                for (int m = 0; m < 4; ++m)
#pragma unroll
                    for (int n = 0; n < 2; ++n) acc[a][b][m][n] = (f32x4){0.f, 0.f, 0.f, 0.f};
        }
        cur = nxt; cA = nA; cB = nB; ++ui;
        if constexpr (ALIGN_EPI) { if (wr == 1) PG8_BAR; }
    }
    PG8_WAIT_V(0);
    if constexpr (!ALIGN_EPI) { if (wr == 0) PG8_BAR; }
    PG8_BAR;
#undef PG8_SA
#undef PG8_SB
#undef PG8_STAGE
#undef PG8_LDA
#undef PG8_LDB
#undef PG8_MMA
#undef PG8_WAIT_V
#undef PG8_WAIT_L
#undef PG8_BAR
#undef PG8_SCHED
}
}
using pg8::Unit;

struct TileOrder {
    int nM, nN, nwg, G, c, skipctx, pboff, reps = 1;
    DI void init(int nM_, int nN_, int G_, int c_, int skipctx_, int pboff_) { nM = nM_; nN = nN_; nwg = nM * nN; G = G_; c = c_; skipctx = skipctx_; pboff = pboff_; }
    DI bool tile(long L, int& pm, int& pn) const {
        if (L >= (long)nwg * reps) return false;
        if (reps > 1) L %= nwg;
        int wgid = (int)L; { const int q = nwg / 8, r = nwg % 8, xcd = wgid % 8, off = wgid / 8; wgid = (xcd < r ? xcd * (q + 1) : r * (q + 1) + (xcd - r) * q) + off; }
        const int nig = 8 * nN, gid = wgid / nig, fm = gid * 8, gsz = (nM - fm) < 8 ? (nM - fm) : 8;
        int m = fm + ((wgid % nig) % gsz); pn = (wgid % nig) / gsz;
        pm = skipctx ? (m + (m >> 4) + 1) : m; return true;
    }
    DI bool next(int i, Unit& u) const { int pm, pn; if (!tile((long)i * G + c, pm, pn)) return false; u.pm = pm; u.pn = pn; u.pa = pm; u.pb = pboff + pn; u.aux = 0; return true; }
};
struct MergeOrder {
    TileOrder t;
    int nctx = 0;
    DI bool next(int i, Unit& u) const {
        if (nctx) { const int nk = (t.nwg - t.c + t.G - 1) / t.G;
            if (i >= 3 * nk) { const int q = (i - 3 * nk) * t.G + t.c; if (q >= 3 * nctx) return false; const int cu = q / 3, br = q - 3 * cu;
                u.pm = (cu >> 2) * 17; u.pn = cu & 3; u.pa = br * NMT + u.pm; u.pb = br * 4 + u.pn; u.aux = 4 + br; return true; } }
        const int br = i % 3; int pm, pn; if (!t.tile((long)(i / 3) * t.G + t.c, pm, pn)) return false;
        u.pm = pm; u.pn = pn; u.pa = br * NMT + pm; u.pb = br * 4 + pn; u.aux = br; return true; }
};
struct OpOrder {
    TileOrder t; int G, c;
    DI bool next(int i, Unit& u) const {
        const int L = i * G + c;
        if (L < 512) { int pm, pn; if (!t.tile(L, pm, pn)) return false; u.pm = pm; u.pn = pn; u.pa = pm; u.pb = pn; u.aux = 0; u.kt0 = 0; u.nkt = 16; return true; }
        const int q = L - 512; if (q >= 192) return false;
        const int cu = q / 6, r = q - 6 * cu;
        u.pm = (cu >> 2) * 17; u.pn = cu & 3; u.pa = NMT + (r >> 1) * 8 + (cu >> 2); u.pb = u.pn; u.aux = 1 + r; u.kt0 = (r & 1) * 8; u.nkt = 8; return true;
    }
};
struct FdOrder {
    TileOrder t; int G, c;
    DI bool next(int i, Unit& u) const {
        const int L = i * G + c;
        if (L < 512) { int pm, pn; if (!t.tile(L, pm, pn)) return false; u.pm = pm; u.pn = pn; u.pa = pm; u.pb = pn; u.aux = 0; u.kt0 = 0; u.nkt = DFF / 64; return true; }
        const int q = L - 512; if (q >= 256) return false;
        const int cu = q >> 3, s = q & 7;
        u.pm = (cu >> 2) * 17; u.pn = cu & 3; u.pa = u.pm; u.pb = u.pn; u.aux = 1 + s;
        u.kt0 = 2 * (s < 6 ? 3 * s : 18 + 2 * (s - 6)); u.nkt = s < 6 ? 6 : 4; return true;
    }
};
struct MoeOrder {
    const LAS int* tab;
    int ng, npn, G, c, g0;
    int ksplit = 0;
    DI bool next(int i, Unit& u) const {
        int L = i * G + c; const int total = __builtin_amdgcn_readfirstlane(tab[ng]); int sl = -1;
        if (ksplit && L >= 1024) { const int q = L - 1024; L = 1024 + (q >> 2); sl = q & 3; }
        if (L >= total) return false;
        int ln = (int)(threadIdx.x & 63); asm volatile("" : "+v"(ln)); const int tv = tab[ln & 15];
        const int j = __builtin_amdgcn_readfirstlane((int)__popcll(__ballot(ln >= 1 && ln < ng && L >= tv)));
        const int tj = __builtin_amdgcn_readfirstlane(tab[j]), tbj = __builtin_amdgcn_readfirstlane(tab[32 + j]), e = (g0 + j) & 7;
        const int r = L - tj, mt = r / npn, pn = r % npn, gt = tbj + mt;
        u.pm = gt; u.pa = gt; u.pn = pn; u.pb = e * npn + pn; u.aux = (g0 + j) >> 3;
        u.kt0 = 0; u.nkt = DFFE / 128;
        if (sl >= 0) { u.aux += 2 * (1 + sl); u.kt0 = sl < 2 ? 8 * sl : 16 + 6 * (sl - 2); u.nkt = sl < 2 ? 8 : 6; }
        return true;
    }
};

DI void row_bs(int R, int& b, int& s) { b = R / SB; s = R - b * SB; }

struct EpiInproj {
    static constexpr bool PERM = true;
    bf16_t* P1; bf16_t* OG; const LAS f32x2* rope; const LAS float* lbt;
    template <int OP> DI void run(const f32x4 (&acc)[2][2][4][2], const Unit& u, int wr, int wc, int fr, int fq, bf16_t* base, int ldc, int colt, float qs) const {
        f32x4 lb0[2], lb1[2];
        if (OP == 3) {
#pragma unroll
            for (int bj = 0; bj < 2; ++bj) { const LAS float* lp = lbt + (u.pn - 2) * 256 + bj * 128 + wc * 32 + 8 * fq; lb0[bj] = *(const LAS f32x4*)lp; lb1[bj] = *(const LAS f32x4*)(lp + 4); }
        }
#pragma unroll
        for (int ai = 0; ai < 2; ++ai)
#pragma unroll
            for (int m = 0; m < 4; ++m) {
                const int R = u.pm * 256 + ai * 128 + wr * 64 + m * 16 + fr;
                bf16_t* rowp = base + (size_t)R * ldc + colt + wc * 32 + 8 * fq;
                f32x4 c0 = {1.f, 1.f, 1.f, 1.f}, s0 = {0.f, 0.f, 0.f, 0.f}, c1 = c0, s1 = s0;
                if (OP == 2) {
                    int b, s; row_bs(R, b, s);
                    const int t = s - CTXL; const int pos = (wc & 1) ? (t & 63) : (t >> 6);
                    if (s >= CTXL) { const LAS f32x4* rp = (const LAS f32x4*)(rope + pos * 16 + 8 * (fq & 1)); const f32x4 a = rp[0], bq = rp[1], cq = rp[2], dq = rp[3];
                        c0 = (f32x4){a[0], a[2], bq[0], bq[2]}; s0 = (f32x4){a[1], a[3], bq[1], bq[3]}; c1 = (f32x4){cq[0], cq[2], dq[0], dq[2]}; s1 = (f32x4){cq[1], cq[3], dq[1], dq[3]}; }
                }
#pragma unroll
                for (int bj = 0; bj < 2; ++bj) {
                    f32x4 v0 = acc[ai][bj][m][0], v1 = acc[ai][bj][m][1];
                    if (OP == 1) { v0 = gelu_tanh4(v0); v1 = gelu_tanh4(v1); }
                    else if (OP == 3) {
                        const f32x4 f0 = sigm4(v0) * (1.0f - lb0[bj]) + lb0[bj], f1 = sigm4(v1) * (1.0f - lb1[bj]) + lb1[bj];
#pragma unroll
                        for (int i = 0; i < 4; ++i) { v0[i] = __builtin_amdgcn_logf(f0[i]); v1[i] = __builtin_amdgcn_logf(f1[i]); }
                    } else if (OP == 2) {
                        f32x4 x1a, x2a, x1b, x2b;
#pragma unroll
                        for (int i = 0; i < 4; ++i) {
                            auto ra = __builtin_amdgcn_permlane32_swap(__float_as_uint(v0[i]), __float_as_uint(v0[i]), false, false); x1a[i] = __uint_as_float(ra[0]); x2a[i] = __uint_as_float(ra[1]);
                            auto rb = __builtin_amdgcn_permlane32_swap(__float_as_uint(v1[i]), __float_as_uint(v1[i]), false, false); x1b[i] = __uint_as_float(rb[0]); x2b[i] = __uint_as_float(rb[1]); }
                        if (fq < 2) { v0 = (x1a * c0 - x2a * s0) * qs; v1 = (x1b * c1 - x2b * s1) * qs; }
                        else { v0 = (x1a * s0 + x2a * c0) * qs; v1 = (x1b * s1 + x2b * c1) * qs; }
                    }
                    u32x4 w; w.x = pk2(v0[0], v0[1]); w.y = pk2(v0[2], v0[3]); w.z = pk2(v1[0], v1[1]); w.w = pk2(v1[2], v1[3]);
                    *(u32x4*)(rowp + bj * 128) = w;
                }
            }
    }
    DI void operator()(const f32x4 (&acc)[2][2][4][2], const Unit& u, int wr, int wc, int fr, int fq) const {
        const int pn = u.pn;
        bf16_t* base; int ldc, colt;
        if (pn == 8 || pn == 9) { base = OG; ldc = 512; colt = (pn - 8) * 256; }
        else { base = P1; ldc = P1LD; colt = pn * 256 - (pn >= 10 ? 512 : 0); }
        const float qs = (pn == 14 || pn == 15) ? 0.18033688011112042f : 1.0f;
        if (pn >= 10 && pn <= 13) run<1>(acc, u, wr, wc, fr, fq, base, ldc, colt, qs);
        else if (pn >= 14 && pn <= 17) run<2>(acc, u, wr, wc, fr, fq, base, ldc, colt, qs);
        else if (pn >= 2 && pn <= 5) run<3>(acc, u, wr, wc, fr, fq, base, ldc, colt, qs);
        else run<0>(acc, u, wr, wc, fr, fq, base, ldc, colt, qs);
    }
};

template <int ACT> struct EpiStore {
    static constexpr bool PERM = true;
    bf16_t* O; int ldc;
    DI void operator()(const f32x4 (&acc)[2][2][4][2], const Unit& u, int wr, int wc, int fr, int fq) const {
#pragma unroll
        for (int ai = 0; ai < 2; ++ai)
#pragma unroll
            for (int m = 0; m < 4; ++m) {
                bf16_t* rowp = O + (size_t)(u.pm * 256 + ai * 128 + wr * 64 + m * 16 + fr) * ldc + u.pn * 256 + wc * 32 + 8 * fq;
#pragma unroll
                for (int bj = 0; bj < 2; ++bj) {
                    f32x4 v0 = acc[ai][bj][m][0], v1 = acc[ai][bj][m][1];
                    if (ACT == 1) { v0 = sigm4(v0); v1 = sigm4(v1);
#pragma unroll
                        for (int i = 0; i < 4; ++i) { v0[i] = fmaxf(v0[i], 1e-6f); v1[i] = fmaxf(v1[i], 1e-6f); }
                    }
                    u32x4 w; w.x = pk2(v0[0], v0[1]); w.y = pk2(v0[2], v0[3]); w.z = pk2(v1[0], v1[1]); w.w = pk2(v1[2], v1[3]);
                    *(u32x4*)(rowp + bj * 128) = w;
                }
            }
    }
};

struct EpiMerge {
    static constexpr bool PERM = true;
    bf16_t* MRG; const bf16_t* G;
    DI void operator()(f32x4 (&acc)[2][2][4][2], const Unit& u, int wr, int wc, int fr, int fq) const {
        const int br = u.aux & 3; const bool chain = u.aux < 2;
        const int pmo = u.aux >= 4 ? NMT + br * 8 + u.pm / 17 : u.pm;
        const int c0 = u.pn * 256 + wc * 32 + 8 * fq;
#pragma unroll
        for (int ai = 0; ai < 2; ++ai) {
            u32x4 gv[4][2], hv[4][2];
#pragma unroll
            for (int m = 0; m < 4; ++m)
#pragma unroll
                for (int bj = 0; bj < 2; ++bj) { const bf16_t* gp = G + (size_t)(u.pm * 256 + ai * 128 + wr * 64 + m * 16 + fr) * 3072 + br * 1024 + c0 + bj * 128;
                    gv[m][bj] = *(const u32x4*)gp; if (chain) hv[m][bj] = *(const u32x4*)(gp + 1024); }
#pragma unroll
            for (int m = 0; m < 4; ++m)
#pragma unroll
                for (int bj = 0; bj < 2; ++bj) {
                    const u32x4 g4 = gv[m][bj];
                    const f32x4 ga = (f32x4){bflo(g4.x), bfhi(g4.x), bflo(g4.y), bfhi(g4.y)}, gb = (f32x4){bflo(g4.z), bfhi(g4.z), bflo(g4.w), bfhi(g4.w)};
                    if (chain) {
                        const u32x4 h4 = hv[m][bj];
                        const f32x4 ha = (f32x4){bflo(h4.x), bfhi(h4.x), bflo(h4.y), bfhi(h4.y)}, hb = (f32x4){bflo(h4.z), bfhi(h4.z), bflo(h4.w), bfhi(h4.w)};
                        acc[ai][bj][m][0] = acc[ai][bj][m][0] * (ga * rcp_4(ha)); acc[ai][bj][m][1] = acc[ai][bj][m][1] * (gb * rcp_4(hb));
                    } else {
                        const f32x4 v0 = acc[ai][bj][m][0] * ga, v1 = acc[ai][bj][m][1] * gb;
                        u32x4 w; w.x = pk2(v0[0], v0[1]); w.y = pk2(v0[2], v0[3]); w.z = pk2(v1[0], v1[1]); w.w = pk2(v1[2], v1[3]);
                        *(u32x4*)(MRG + (size_t)(pmo * 256 + ai * 128 + wr * 64 + m * 16 + fr) * 1024 + c0 + bj * 128) = w;
                    }
                }
        }
    }
};

struct EpiResid {
    static constexpr bool PERM = true;
    const float* in_l; const float* in_c; float* out_l; float* out_c; const float* gate;
    bf16_t* slab = nullptr;
    DI void operator()(const f32x4 (&acc)[2][2][4][2], const Unit& u, int wr, int wc, int fr, int fq) const {
        const int c0 = u.pn * 256 + wc * 32 + 8 * fq;
        if (u.aux) {
            bf16_t* sl = slab + ((size_t)(u.aux - 1) * (NBATCH * CTXL) + (size_t)(u.pm / 17) * CTXL + wr * 64 + fr) * D + c0;
#pragma unroll
            for (int ai = 0; ai < 2; ++ai)
#pragma unroll
                for (int m = 0; m < 4; ++m)
#pragma unroll
                    for (int bj = 0; bj < 2; ++bj) { const f32x4 a0 = acc[ai][bj][m][0], a1 = acc[ai][bj][m][1];
                        u32x4 w4; w4.x = pk2(a0[0], a0[1]); w4.y = pk2(a0[2], a0[3]); w4.z = pk2(a1[0], a1[1]); w4.w = pk2(a1[2], a1[3]); *(u32x4*)(sl + (size_t)(ai * 128 + m * 16) * D + bj * 128) = w4; }
            return;
        }
        const int bt = u.pm / 17, isc = (u.pm - bt * 17) == 0;
        const float* gp = gate + (size_t)(isc ? 8 : bt) * 6144 + c0;
        f32x4 g[2][2];
#pragma unroll
        for (int bj = 0; bj < 2; ++bj) { g[bj][0] = *(const f32x4*)(gp + bj * 128); g[bj][1] = *(const f32x4*)(gp + bj * 128 + 4); }
#pragma unroll
        for (int ai = 0; ai < 2; ++ai) {
            f32x4 xv[4][2][2]; size_t ro[4];
#pragma unroll
            for (int m = 0; m < 4; ++m) {
                const int R = u.pm * 256 + ai * 128 + wr * 64 + m * 16 + fr, s = R - bt * SB;
                ro[m] = isc ? (size_t)(bt * CTXL + s) * D : (size_t)(bt * SEQ + s - CTXL) * D;
                const float* xi = (isc ? in_c : in_l) + ro[m] + c0;
#pragma unroll
                for (int bj = 0; bj < 2; ++bj) { xv[m][bj][0] = *(const f32x4*)(xi + bj * 128); xv[m][bj][1] = *(const f32x4*)(xi + bj * 128 + 4); }
            }
#pragma unroll
            for (int m = 0; m < 4; ++m) {
                float* xo = (isc ? out_c : out_l) + ro[m] + c0;
#pragma unroll
                for (int bj = 0; bj < 2; ++bj) { *(f32x4*)(xo + bj * 128) = xv[m][bj][0] + g[bj][0] * acc[ai][bj][m][0]; *(f32x4*)(xo + bj * 128 + 4) = xv[m][bj][1] + g[bj][1] * acc[ai][bj][m][1]; }
            }
        }
    }
};

template <bool F8> struct EpiSwigluT {
    static constexpr bool PERM = true;
    bf16_t* Hd; int ldc;
    DI void operator()(const f32x4 (&acc)[2][2][4][2], const Unit& u, int wr, int wc, int fr, int fq) const {
#pragma unroll
        for (int ai = 0; ai < 2; ++ai)
#pragma unroll
            for (int m = 0; m < 4; ++m) {
                const size_t eo = (size_t)(u.pm * 256 + ai * 128 + wr * 64 + m * 16 + fr) * ldc + u.pn * 128 + wc * 32 + 8 * fq;
                constexpr float sc = F8 ? 1.f / W8SCALE : 1.f;
                float o[8];
#pragma unroll
                for (int n = 0; n < 2; ++n)
#pragma unroll
                    for (int ih = 0; ih < 2; ++ih) {
                        const f32x2 g2 = (f32x2){acc[ai][0][m][n][2 * ih], acc[ai][0][m][n][2 * ih + 1]}, u2 = (f32x2){acc[ai][1][m][n][2 * ih], acc[ai][1][m][n][2 * ih + 1]};
                        const f32x2 a2 = g2 * (-1.4426950408889634f * sc);
                        const f32x2 e2 = (f32x2){__builtin_amdgcn_exp2f(a2[0]), __builtin_amdgcn_exp2f(a2[1])};
                        const f32x2 d2 = e2 * (1.f / (sc * sc)) + (1.f / (sc * sc));
                        const f32x2 r2 = (f32x2){__builtin_amdgcn_rcpf(d2[0]), __builtin_amdgcn_rcpf(d2[1])};
                        const f32x2 o2 = (g2 * u2) * r2;
                        o[n * 4 + 2 * ih] = o2[0]; o[n * 4 + 2 * ih + 1] = o2[1]; }
                if constexpr (F8) { u32x2 w; w.x = pk4_fp8(o[0], o[1], o[2], o[3]); w.y = pk4_fp8(o[4], o[5], o[6], o[7]); *(u32x2*)((unsigned char*)Hd + eo) = w; }
                else { u32x4 w; w.x = pk2(o[0], o[1]); w.y = pk2(o[2], o[3]); w.z = pk2(o[4], o[5]); w.w = pk2(o[6], o[7]); *(u32x4*)(Hd + eo) = w; }
            }
    }
};
typedef EpiSwigluT<false> EpiSwiglu;

struct EpiMoeDown {
    static constexpr bool PERM = true;
    const int* tok; const float* wrow; bf16_t* y0; bf16_t* y1; bf16_t* dslab;
    DI void operator()(const f32x4 (&acc)[2][2][4][2], const Unit& u, int wr, int wc, int fr, int fq) const {
        const int c0 = u.pn * 256 + wc * 32 + 8 * fq;
        if (u.aux >= 2) {
            const int rb = u.pm * 256 + wr * 64 + fr;
            bf16_t* sl = dslab + ((size_t)((u.aux >> 1) - 1) * 4096 + (size_t)(rb - 65536)) * D + c0;
            float wv[2][4];
#pragma unroll
            for (int ai = 0; ai < 2; ++ai)
#pragma unroll
                for (int m = 0; m < 4; ++m) wv[ai][m] = wrow[rb + ai * 128 + m * 16] * (1.f / W8SCALE);
#pragma unroll
            for (int ai = 0; ai < 2; ++ai)
#pragma unroll
                for (int m = 0; m < 4; ++m)
#pragma unroll
                    for (int bj = 0; bj < 2; ++bj) { const f32x4 a0 = acc[ai][bj][m][0] * wv[ai][m], a1 = acc[ai][bj][m][1] * wv[ai][m];
                        u32x4 w4; w4.x = pk2(a0[0], a0[1]); w4.y = pk2(a0[2], a0[3]); w4.z = pk2(a1[0], a1[1]); w4.w = pk2(a1[2], a1[3]); *(u32x4*)(sl + (size_t)(ai * 128 + m * 16) * D + bj * 128) = w4; }
            return;
        }
        bf16_t* y = u.aux ? y1 : y0;
        int nn[2][4]; float ww[2][4];
#pragma unroll
        for (int ai = 0; ai < 2; ++ai)
#pragma unroll
            for (int m = 0; m < 4; ++m) { const int row = u.pm * 256 + ai * 128 + wr * 64 + m * 16 + fr; nn[ai][m] = tok[row]; ww[ai][m] = wrow[row] * (1.f / W8SCALE); }
#pragma unroll
        for (int ai = 0; ai < 2; ++ai)
#pragma unroll
            for (int m = 0; m < 4; ++m) if (nn[ai][m] >= 0) {
                const size_t o = (size_t)nn[ai][m] * D + c0; const float w = ww[ai][m];
#pragma unroll
                for (int bj = 0; bj < 2; ++bj) {
                    const f32x4 a0 = acc[ai][bj][m][0] * w, a1 = acc[ai][bj][m][1] * w;
                    u32x4 w4; w4.x = pk2(a0[0], a0[1]); w4.y = pk2(a0[2], a0[3]); w4.z = pk2(a1[0], a1[1]); w4.w = pk2(a1[2], a1[3]); *(u32x4*)(y + o + bj * 128) = w4;
                }
            }
    }
};

struct Ctx {
    LAS unsigned char* lds; int tid, lane, wid, G, c;
    unsigned char* ws;
};

struct ConvItem { const float* W; int N, k0, n0; bf16_t* Dst; int Kd, drow; };
template <bool F8> DI void conv_tile(const ConvItem& c, LAS float* scr, int lane) {
    const float* src = c.W + (size_t)c.k0 * c.N + c.n0 + (lane & 15) * 4;
#pragma unroll 4
    for (int i = 0; i < 16; ++i) { const int kk = 4 * i + (lane >> 4); const f32x4 v = *(const f32x4*)(src + (size_t)kk * c.N);
        LAS float* d = scr + kk * 65 + (lane & 15) * 4; d[0] = v[0]; d[1] = v[1]; d[2] = v[2]; d[3] = v[3]; }
    LDS_WAIT();
    const int kc = lane & 7;
#pragma unroll
    for (int i = 0; i < 8; ++i) { const int n = i * 8 + (lane >> 3); const LAS float* s = scr + (kc * 8) * 65 + n;
        if constexpr (F8) { u32x2 o; o.x = pk4_fp8(s[0] * W8SCALE, s[65] * W8SCALE, s[2 * 65] * W8SCALE, s[3 * 65] * W8SCALE); o.y = pk4_fp8(s[4 * 65] * W8SCALE, s[5 * 65] * W8SCALE, s[6 * 65] * W8SCALE, s[7 * 65] * W8SCALE);
            *(u32x2*)((unsigned char*)c.Dst + (size_t)(c.drow + n) * c.Kd + c.k0 + kc * 8) = o; }
        else { u32x4 o; o.x = pk2(s[0], s[65]); o.y = pk2(s[2 * 65], s[3 * 65]); o.z = pk2(s[4 * 65], s[5 * 65]); o.w = pk2(s[6 * 65], s[7 * 65]);
            *(u32x4*)(c.Dst + (size_t)(c.drow + n) * c.Kd + c.k0 + kc * 8) = o; } }
    LDS_WAIT();
}
constexpr int CV_WIN = 2 * 16 * 128, CV_WBR = 6 * 128, CV_WOUT = 2 * 256, CV_FF = 704, CV_N0 = CV_WIN + CV_WBR + CV_WOUT + 3 * CV_FF;
constexpr int CV_ME = 896, CV_N1 = 3 * 8 * CV_ME;
DI void conv_decode0(const Params& p, int r, ConvItem& c) {
    unsigned char* ws = p.ws;
    if (r < CV_WIN) { const int l = r / 2048, rr = r % 2048; c.W = p.w_in + (size_t)l * 1024 * 8192; c.N = 8192; c.k0 = (rr / 128) * 64; c.n0 = (rr % 128) * 64;
        c.Dst = (bf16_t*)(ws + WS_WIN) + (size_t)l * 8192 * 1024; c.Kd = 1024; c.drow = c.n0; return; } r -= CV_WIN;
    if (r < CV_WBR) { const int m6 = r / 128, rr = r % 128; c.W = p.w_branch + (size_t)m6 * 512 * 1024; c.N = 1024; c.k0 = (rr / 16) * 64; c.n0 = (rr % 16) * 64;
        c.Dst = (bf16_t*)(ws + WS_WBR) + (size_t)m6 * 1024 * 512; c.Kd = 512; c.drow = c.n0; return; } r -= CV_WBR;
    if (r < CV_WOUT) { const int l = r / 256, rr = r % 256; c.W = p.w_out + (size_t)l * 1024 * 1024; c.N = 1024; c.k0 = (rr / 16) * 64; c.n0 = (rr % 16) * 64;
        c.Dst = (bf16_t*)(ws + WS_WOUT) + (size_t)l * 1024 * 1024; c.Kd = 1024; c.drow = c.n0; return; } r -= CV_WOUT;
    if (r < 2 * CV_FF) { const int up = r / CV_FF, rr = r % CV_FF; c.W = up ? p.ffn_wu : p.ffn_wg; c.N = DFF; c.k0 = (rr / 44) * 64; c.n0 = (rr % 44) * 64;
        c.Dst = (bf16_t*)(ws + WS_WGU); c.Kd = 1024; c.drow = (c.n0 / 128) * 256 + (c.n0 % 128) + up * 128; return; } r -= 2 * CV_FF;
    { c.W = p.ffn_wd; c.N = 1024; c.k0 = (r / 16) * 64; c.n0 = (r % 16) * 64; c.Dst = (bf16_t*)(ws + WS_WDN); c.Kd = DFF; c.drow = c.n0; }
}
DI void conv_decode1(const Params& p, int r, ConvItem& c) {
    unsigned char* ws = p.ws;
    if (r < 16 * CV_ME) { const int up = r / (8 * CV_ME), r2 = r % (8 * CV_ME), e = r2 / CV_ME, rr = r2 % CV_ME;
        c.W = (up ? p.moe_wu : p.moe_wg) + (size_t)e * 1024 * DFFE; c.N = DFFE; c.k0 = (rr / 56) * 64; c.n0 = (rr % 56) * 64;
        c.Dst = (bf16_t*)(ws + WS_WMGU + (size_t)e * 7168 * 1024); c.Kd = 1024; c.drow = (c.n0 / 128) * 256 + (c.n0 % 128) + up * 128; return; } r -= 16 * CV_ME;
    { const int e = r / CV_ME, rr = r % CV_ME; c.W = p.moe_wd + (size_t)e * DFFE * 1024; c.N = 1024; c.k0 = (rr / 16) * 64; c.n0 = (rr % 16) * 64;
        c.Dst = (bf16_t*)(ws + WS_WMDN + (size_t)e * 1024 * DFFE); c.Kd = DFFE; c.drow = c.n0; }
}
template <int WHICH> DI void conv_range(const Params& p, const Ctx& X, int first, int last, int hidx, int nh) {
    LAS float* scr = (LAS float*)(X.lds + X.wid * 16640);
    const int gw = hidx * 8 + X.wid, ngw = nh * 8;
    for (int it = first + gw; it < last; it += ngw) { ConvItem c; if (WHICH) conv_decode1(p, it, c); else conv_decode0(p, it, c); conv_tile<WHICH != 0>(c, scr, X.lane); }
}
template <int WHICH> DI void conv_phase(const Params& p, const Ctx& X) { conv_range<WHICH>(p, X, 0, WHICH ? CV_N1 : CV_N0, X.c, X.G); }
DI bool conv_split(const Ctx& X) { return X.G == 256; }

DI void adaln_phase(const Params& p, const Ctx& X) {
    LAS float* sc = (LAS float*)X.lds;
    LAS float* part = sc + 9 * 1024;
    float* mod = (float*)(p.ws + WS_MOD);
    for (int g = X.c; g < 256; g += X.G) {
        const int l = g >> 7, n0 = (g & 127) * 48;
        for (int i = X.tid; i < 9 * 1024; i += 512) { const int r = i >> 10, k = i & 1023; const float cv = r < 8 ? p.c[r * 1024 + k] : p.c_ctx[k]; sc[i] = cv * sigm(cv); }
        __syncthreads();
        const int kq = X.tid >> 4, jq = X.tid & 15;
        float acc[9][3];
#pragma unroll
        for (int r = 0; r < 9; ++r) { acc[r][0] = 0.f; acc[r][1] = 0.f; acc[r][2] = 0.f; }
        const float* w = p.w_ada + (size_t)l * 1024 * 6144 + n0 + jq;
        float wv[32][3];
#pragma unroll
        for (int i = 0; i < 32; ++i) { const int k = kq + 32 * i; wv[i][0] = w[(size_t)k * 6144]; wv[i][1] = w[(size_t)k * 6144 + 16]; wv[i][2] = w[(size_t)k * 6144 + 32]; }
#pragma unroll
        for (int i = 0; i < 32; ++i) { const int k = kq + 32 * i;
#pragma unroll
            for (int r = 0; r < 9; ++r) { const float s = sc[r * 1024 + k]; acc[r][0] += s * wv[i][0]; acc[r][1] += s * wv[i][1]; acc[r][2] += s * wv[i][2]; } }
#pragma unroll
        for (int r = 0; r < 9; ++r)
#pragma unroll
            for (int j = 0; j < 3; ++j) part[kq * 432 + r * 48 + j * 16 + jq] = acc[r][j];
        __syncthreads();
        if (X.tid < 432) { const int r = X.tid / 48, j = X.tid % 48; float s = 0.f;
#pragma unroll 8
            for (int q = 0; q < 32; ++q) s += part[q * 432 + X.tid];
            mod[(size_t)(l * 9 + r) * 6144 + n0 + j] = s + p.b_ada[l * 6144 + n0 + j]; }
        __syncthreads();
    }
}
DI void rope_phase(const Params& p, const Ctx& X) {
    f32x2* tab = (f32x2*)(p.ws + WS_ROPE);
    float* lbt = (float*)(p.ws + WS_LB);
    for (int i = X.c * 512 + X.tid; i < 2048; i += X.G * 512) { const int l = i >> 10, dir = (i >> 9) & 1, ch = i & 511;
        const float p0 = p.hgrn_lb[(dir * 2 + 0) * 512 + ch], p1 = p.hgrn_lb[(dir * 2 + 1) * 512 + ch]; lbt[i] = l == 0 ? 0.f : 1.f / (1.f + expf(p0 - p1)); }
    for (int i = X.c * 512 + X.tid; i < 1024; i += X.G * 512) { const int pos = i >> 4, pp = i & 15;
        const float freq = powf(10000.f, -(float)pp / 16.f), ang = (float)pos * freq; tab[i] = (f32x2){cosf(ang), sinf(ang)}; }
}

template <bool F8> DI void norm_row(const float* xr, const float* g, const float* shift, const float* scale, bf16_t* orow, int lane, f32x4 (&hv)[4]) {
    f32x4 v[4]; float ss = 0.f;
#pragma unroll
    for (int j = 0; j < 4; ++j) { v[j] = *(const f32x4*)(xr + j * 256 + lane * 4); ss += (v[j][0] * v[j][0] + v[j][1] * v[j][1]) + (v[j][2] * v[j][2] + v[j][3] * v[j][3]); }
    const float rstd = rsqrtf(wave_sum(ss) * (1.f / D) + EPS);
#pragma unroll
    for (int j = 0; j < 4; ++j) { const int c = j * 256 + lane * 4;
        const f32x4 gg = *(const f32x4*)(g + c), sh = *(const f32x4*)(shift + c), sc = *(const f32x4*)(scale + c);
        const f32x4 h = (v[j] * rstd * gg) * (sc + 1.0f) + sh; hv[j] = h;
        if constexpr (F8) *(unsigned*)((unsigned char*)orow + c) = pk4_fp8(h[0], h[1], h[2], h[3]);
        else { u32x2 w; w.x = pk2(h[0], h[1]); w.y = pk2(h[2], h[3]); *(u32x2*)(orow + c) = w; } }
}
DI void norm_phase(const Params& p, const Ctx& X, int l, int which, bool first, int nslab = 0) {
    const bool addslab = nslab > 0;
    const float* xl = first ? p.x : p.out; const float* xc = (first || (addslab && which == 1)) ? p.ctx : (const float*)(p.ws + WS_CTX);
    const float* g = (which ? p.g_norm2 : p.g_norm1) + l * D;
    const float* mod = (const float*)(p.ws + WS_MOD) + (size_t)l * 9 * 6144 + (which ? 3072 : 0);
    bf16_t* H = (bf16_t*)(p.ws + WS_H);
    const int rpb = (T + X.G - 1) / X.G, r0 = X.c * rpb, r1 = (r0 + rpb < T) ? r0 + rpb : T;
    f32x4 gg[4];
#pragma unroll
    for (int j = 0; j < 4; ++j) gg[j] = *(const f32x4*)(g + j * 256 + X.lane * 4);
    const bool remap = addslab && X.G == 256;
    auto rowmap = [&](int vr) { if (!remap) return vr; const int blk = vr / 136, o = vr - blk * 136;
        if (o < 128) { const int n = blk * 128 + o; return (n >> 12) * SB + CTXL + (n & 4095); } const int jc = blk * 8 + (o - 128); return (jc >> 8) * SB + (jc & 255); };
    for (int Rv = r0 + X.wid; Rv < r1; Rv += 16) {
        const int Rvb = (Rv + 8 < r1) ? Rv + 8 : Rv;
        const int R = rowmap(Rv), Rb = rowmap(Rvb);
        f32x4 v[2][4], sh[2][4], sc[2][4]; float ss[2] = {0.f, 0.f};
#pragma unroll
        for (int q = 0; q < 2; ++q) { const int Rq = q ? Rb : R; int b, s; row_bs(Rq, b, s); const bool isc = s < CTXL;
            const float* xr = isc ? xc + (size_t)(b * CTXL + s) * D : xl + (size_t)(b * SEQ + s - CTXL) * D;
            const float* mr = mod + (size_t)(isc ? 8 : b) * 6144;
#pragma unroll
            for (int j = 0; j < 4; ++j) { const int c = j * 256 + X.lane * 4; v[q][j] = *(const f32x4*)(xr + c); sh[q][j] = *(const f32x4*)(mr + c); sc[q][j] = *(const f32x4*)(mr + 1024 + c); } }
        if (addslab) {
#pragma unroll
            for (int q = 0; q < 2; ++q) { const int Rq = q ? Rb : R; int b, s; row_bs(Rq, b, s);
                if (s < CTXL) {
                    const bf16_t* sl = (const bf16_t*)(p.ws + (which ? WS_OPSLAB : WS_SLAB)) + (size_t)(b * CTXL + s) * D + X.lane * 4;
                    const float* gr = (const float*)(p.ws + WS_MOD) + (size_t)8 * 6144 + (which ? 2048 : 5120) + X.lane * 4;
                    u32x2 pw[8][4]; f32x4 gt[4];
#pragma unroll
                    for (int k = 0; k < 8; ++k)
#pragma unroll
                        for (int j = 0; j < 4; ++j) pw[k][j] = (k < nslab) ? *(const u32x2*)(sl + (size_t)k * (NBATCH * CTXL) * D + j * 256) : (u32x2){0u, 0u};
#pragma unroll
                    for (int j = 0; j < 4; ++j) gt[j] = *(const f32x4*)(gr + j * 256);
#pragma unroll
                    for (int j = 0; j < 4; ++j) { f32x4 sum = (f32x4){0.f, 0.f, 0.f, 0.f};
#pragma unroll
                        for (int k = 0; k < 8; ++k) sum = sum + (f32x4){bflo(pw[k][j].x), bfhi(pw[k][j].x), bflo(pw[k][j].y), bfhi(pw[k][j].y)};
                        v[q][j] = v[q][j] + gt[j] * sum;
                        if (which) *(f32x4*)((float*)(p.ws + WS_CTX) + (size_t)(b * CTXL + s) * D + j * 256 + X.lane * 4) = v[q][j]; }
                } }
        }
#pragma unroll
        for (int q = 0; q < 2; ++q)
#pragma unroll
            for (int j = 0; j < 4; ++j) ss[q] += (v[q][j][0] * v[q][j][0] + v[q][j][1] * v[q][j][1]) + (v[q][j][2] * v[q][j][2] + v[q][j][3] * v[q][j][3]);
#pragma unroll
        for (int o = 1; o < 64; o <<= 1) { const float a = __shfl_xor(ss[0], o), b2 = __shfl_xor(ss[1], o); ss[0] += a; ss[1] += b2; }
#pragma unroll
        for (int q = 0; q < 2; ++q) { const int Rq = q ? Rb : R; const float rstd = rsqrtf(ss[q] * (1.f / D) + EPS); bf16_t* orow = H + (size_t)Rq * D;
#pragma unroll
            for (int j = 0; j < 4; ++j) { const int c = j * 256 + X.lane * 4; const f32x4 h = (v[q][j] * rstd * gg[j]) * (sc[q][j] + 1.0f) + sh[q][j];
                u32x2 w; w.x = pk2(h[0], h[1]); w.y = pk2(h[2], h[3]); *(u32x2*)(orow + c) = w; } }
    }
}
DI void norm2_router_phase(const Params& p, const Ctx& X) {
    const int l = 1;
    const float* g = p.g_norm2 + l * D;
    const float* mod = (const float*)(p.ws + WS_MOD) + (size_t)l * 9 * 6144 + 3072;
    bf16_t* H = (bf16_t*)(p.ws + WS_H);
    LAS float* wr = (LAS float*)X.lds;
    LAS int* hist = (LAS int*)(X.lds + 32768);
    for (int i = X.tid; i < 8192; i += 512) wr[i] = p.moe_router[i];
    if (X.tid < 16) hist[X.tid] = 0;
    int* tokt = (int*)(p.ws + WS_TOK);
    for (int i = X.c * 512 + X.tid; i < MAXROWS_MOE; i += X.G * 512) tokt[i] = -1;
    __syncthreads();
    const int tpb = (NLAT + X.G - 1) / X.G, n0 = X.c * tpb, n1 = (n0 + tpb < NLAT) ? n0 + tpb : NLAT;
    f32x4* route = (f32x4*)(p.ws + WS_ROUTE);
    f32x4 gg[4];
#pragma unroll
    for (int j = 0; j < 4; ++j) gg[j] = *(const f32x4*)(g + j * 256 + X.lane * 4);
    for (int n = n0 + X.wid; n < n1; n += 16) {
        const int nb = (n + 8 < n1) ? n + 8 : n, nq = (nb == n) ? 1 : 2;
        f32x4 v[2][4], sh[2][4], sc[2][4]; float ss[2] = {0.f, 0.f};
#pragma unroll
        for (int q = 0; q < 2; ++q) { const int nn = q ? nb : n; const float* xr = p.out + (size_t)nn * D; const float* mr = mod + (size_t)(nn >> 12) * 6144;
#pragma unroll
            for (int j = 0; j < 4; ++j) { const int c = j * 256 + X.lane * 4; v[q][j] = *(const f32x4*)(xr + c); sh[q][j] = *(const f32x4*)(mr + c); sc[q][j] = *(const f32x4*)(mr + 1024 + c); } }
#pragma unroll
        for (int q = 0; q < 2; ++q)
#pragma unroll
            for (int j = 0; j < 4; ++j) ss[q] += (v[q][j][0] * v[q][j][0] + v[q][j][1] * v[q][j][1]) + (v[q][j][2] * v[q][j][2] + v[q][j][3] * v[q][j][3]);
#pragma unroll
        for (int o = 1; o < 64; o <<= 1) { const float a = __shfl_xor(ss[0], o), b2 = __shfl_xor(ss[1], o); ss[0] += a; ss[1] += b2; }
        float lg[2][8];
#pragma unroll
        for (int q = 0; q < 2; ++q) {
            const int nn = q ? nb : n; const float rstd = rsqrtf(ss[q] * (1.f / D) + EPS);
            unsigned char* orow = (unsigned char*)H + (size_t)((nn >> 12) * SB + CTXL + (nn & 4095)) * D;
#pragma unroll
            for (int j = 0; j < 4; ++j) { const f32x4 h = (v[q][j] * rstd * gg[j]) * (sc[q][j] + 1.0f) + sh[q][j]; v[q][j] = h;
                if (q < nq) *(unsigned*)(orow + j * 256 + X.lane * 4) = pk4_fp8(h[0], h[1], h[2], h[3]); }
#pragma unroll
            for (int e = 0; e < 8; ++e) lg[q][e] = 0.f;
        }
#pragma unroll
        for (int j = 0; j < 4; ++j)
#pragma unroll
            for (int i = 0; i < 4; ++i) { const LAS f32x4* wp = (const LAS f32x4*)(wr + (j * 256 + X.lane * 4 + i) * 8); const f32x4 w0 = wp[0], w1 = wp[1];
#pragma unroll
                for (int q = 0; q < 2; ++q) { const float h = v[q][j][i];
                    lg[q][0] += h * w0[0]; lg[q][1] += h * w0[1]; lg[q][2] += h * w0[2]; lg[q][3] += h * w0[3]; lg[q][4] += h * w1[0]; lg[q][5] += h * w1[1]; lg[q][6] += h * w1[2]; lg[q][7] += h * w1[3]; } }
#pragma unroll
        for (int o = 1; o < 64; o <<= 1)
#pragma unroll
            for (int q = 0; q < 2; ++q)
#pragma unroll
                for (int e = 0; e < 8; ++e) lg[q][e] += __shfl_xor(lg[q][e], o);
        for (int q = 0; q < nq; ++q) {
            int e1 = 0; float v1 = lg[q][0];
#pragma unroll
            for (int e = 1; e < 8; ++e) if (lg[q][e] > v1) { v1 = lg[q][e]; e1 = e; }
            int e2 = -1; float v2 = -3.0e38f;
#pragma unroll
            for (int e = 0; e < 8; ++e) if (e != e1 && lg[q][e] > v2) { v2 = lg[q][e]; e2 = e; }
            const float w2 = 1.f / (1.f + expf(v1 - v2)), w1 = 1.f - w2;
            if (X.lane == 0) { route[q ? nb : n] = (f32x4){__int_as_float(e1), __int_as_float(e2), w1, w2}; atomicAdd((int*)&hist[e1], 1); atomicAdd((int*)&hist[8 + e2], 1); }
        }
    }
    __syncthreads();
    if (X.tid < 16) ((int*)(p.ws + WS_HIST))[X.c * 16 + X.tid] = hist[X.tid];
}

DI void readout_phase(const Params& p, const Ctx& X, int l) {
    const bf16_t* OF = (const bf16_t*)(p.ws + WS_OF); bf16_t* OB = (bf16_t*)(p.ws + WS_OB); const bf16_t* OG = (const bf16_t*)(p.ws + WS_OG);
    const float* gn = p.hgrn_gnorm + l * 512 + X.lane * 8;
    const f32x4 g0 = *(const f32x4*)gn, g1 = *(const f32x4*)(gn + 4);
    const int rpb = (T + X.G - 1) / X.G, r0 = X.c * rpb, r1 = (r0 + rpb < T) ? r0 + rpb : T;
    for (int R = r0 + X.wid; R < r1; R += 16) {
        const int Rb = (R + 8 < r1) ? R + 8 : R;
        u32x4 a[2], bb[2], gg[2];
#pragma unroll
        for (int q = 0; q < 2; ++q) { const size_t o = (size_t)(q ? Rb : R) * 512 + X.lane * 8; a[q] = *(const u32x4*)(OF + o); bb[q] = *(const u32x4*)(OB + o); gg[q] = *(const u32x4*)(OG + o); }
        const int nq = (Rb == R) ? 1 : 2;
        for (int q = 0; q < nq; ++q) {
            const int Rq = q ? Rb : R;
            if (l == 1) { int b, s; row_bs(Rq, b, s); if (s < CTXL) continue; }
            float v[8], qv[8];
            v[0] = bflo(a[q].x) + bflo(bb[q].x); v[1] = bfhi(a[q].x) + bfhi(bb[q].x); v[2] = bflo(a[q].y) + bflo(bb[q].y); v[3] = bfhi(a[q].y) + bfhi(bb[q].y);
            v[4] = bflo(a[q].z) + bflo(bb[q].z); v[5] = bfhi(a[q].z) + bfhi(bb[q].z); v[6] = bflo(a[q].w) + bflo(bb[q].w); v[7] = bfhi(a[q].w) + bfhi(bb[q].w);
            qv[0] = bflo(gg[q].x); qv[1] = bfhi(gg[q].x); qv[2] = bflo(gg[q].y); qv[3] = bfhi(gg[q].y); qv[4] = bflo(gg[q].z); qv[5] = bfhi(gg[q].z); qv[6] = bflo(gg[q].w); qv[7] = bfhi(gg[q].w);
            float ss = 0.f;
#pragma unroll
            for (int i = 0; i < 8; ++i) ss += v[i] * v[i];
            ss += __shfl_xor(ss, 1); ss += __shfl_xor(ss, 2); ss += __shfl_xor(ss, 4); ss += __shfl_xor(ss, 8);
            const float rstd = rsqrtf(ss * (1.f / 128.f) + EPS);
            float y[8];
#pragma unroll
            for (int i = 0; i < 8; ++i) y[i] = v[i] * rstd * (i < 4 ? g0[i] : g1[i - 4]) * (qv[i] * sigm(qv[i]));
            u32x4 w; w.x = pk2(y[0], y[1]); w.y = pk2(y[2], y[3]); w.z = pk2(y[4], y[5]); w.w = pk2(y[6], y[7]);
            *(u32x4*)(OB + (size_t)Rq * 512 + X.lane * 8) = w;
        }
    }
}

DI void final_phase(const Params& p, const Ctx& X) {
    const bf16_t* y0 = (const bf16_t*)(p.ws + WS_Y0); const bf16_t* y1 = (const bf16_t*)(p.ws + WS_Y1);
    const float* gate = (const float*)(p.ws + WS_MOD) + (size_t)9 * 6144 + 5120;
    const int* posv = (const int*)(p.ws + WS_POS); const bf16_t* dslab = (const bf16_t*)(p.ws + WS_DSLAB);
    const int rpb = (NLAT + X.G - 1) / X.G, r0 = X.c * rpb, r1 = (r0 + rpb < NLAT) ? r0 + rpb : NLAT;
    f32x4 gf[4];
#pragma unroll
    for (int j = 0; j < 4; ++j) gf[j] = *(const f32x4*)(p.g_final + j * 256 + X.lane * 4);
    for (int n = r0 + X.wid; n < r1; n += 16) {
        const int nb = (n + 8 < r1) ? n + 8 : n;
        f32x4 v[2][4], gt[2][4]; u32x2 ya[2][4], yb[2][4]; float ss[2] = {0.f, 0.f};
#pragma unroll
        for (int q = 0; q < 2; ++q) { const int nq_ = q ? nb : n; const size_t o = (size_t)nq_ * D; const float* gr = gate + (size_t)(nq_ >> 12) * 6144;
#pragma unroll
            for (int j = 0; j < 4; ++j) { const int c = j * 256 + X.lane * 4; v[q][j] = *(const f32x4*)(p.out + o + c); ya[q][j] = *(const u32x2*)(y0 + o + c); yb[q][j] = *(const u32x2*)(y1 + o + c); gt[q][j] = *(const f32x4*)(gr + c); } }
#pragma unroll
        for (int q = 0; q < 2; ++q) { const int nq_ = q ? nb : n; const int p0 = posv[2 * nq_], p1 = posv[2 * nq_ + 1];
#pragma unroll
            for (int e = 0; e < 2; ++e) { const int pe = e ? p1 : p0;
                if (pe >= 65536) {
                    const bf16_t* sl = dslab + (size_t)(pe - 65536) * D + X.lane * 4;
                    u32x2 pw[4][4];
#pragma unroll
                    for (int k = 0; k < 4; ++k)
#pragma unroll
                        for (int j = 0; j < 4; ++j) pw[k][j] = *(const u32x2*)(sl + (size_t)k * 4096 * D + j * 256);
#pragma unroll
                    for (int j = 0; j < 4; ++j) { float s0 = 0.f, s1 = 0.f, s2 = 0.f, s3 = 0.f;
#pragma unroll
                        for (int k = 0; k < 4; ++k) { s0 += bflo(pw[k][j].x); s1 += bfhi(pw[k][j].x); s2 += bflo(pw[k][j].y); s3 += bfhi(pw[k][j].y); }
                        u32x2 o; o.x = pk2(s0, s1); o.y = pk2(s2, s3); if (e) yb[q][j] = o; else ya[q][j] = o; }
                } } }
#pragma unroll
        for (int q = 0; q < 2; ++q)
#pragma unroll
            for (int j = 0; j < 4; ++j) {
                const f32x4 ys = (f32x4){bflo(ya[q][j].x), bfhi(ya[q][j].x), bflo(ya[q][j].y), bfhi(ya[q][j].y)} + (f32x4){bflo(yb[q][j].x), bfhi(yb[q][j].x), bflo(yb[q][j].y), bfhi(yb[q][j].y)};
                v[q][j] = v[q][j] + gt[q][j] * ys;
                ss[q] += (v[q][j][0] * v[q][j][0] + v[q][j][1] * v[q][j][1]) + (v[q][j][2] * v[q][j][2] + v[q][j][3] * v[q][j][3]); }
#pragma unroll
        for (int o = 1; o < 64; o <<= 1) { const float a = __shfl_xor(ss[0], o), b2 = __shfl_xor(ss[1], o); ss[0] += a; ss[1] += b2; }
        const int nq = (nb == n) ? 1 : 2;
        for (int q = 0; q < nq; ++q) { const float rstd = rsqrtf(ss[q] * (1.f / D) + EPS); float* xr = p.out + (size_t)(q ? nb : n) * D;
#pragma unroll
            for (int j = 0; j < 4; ++j) *(f32x4*)(xr + j * 256 + X.lane * 4) = v[q][j] * rstd * gf[j]; }
    }
}

DI int crow(int r, int hi) { return (r & 3) + 8 * (r >> 2) + 4 * hi; }
DI void hgrn_phase(const Params& p, const Ctx& X, int l) {
    const bf16_t* P1 = (const bf16_t*)(p.ws + WS_P1);
    constexpr int BUFB = 54272;
    LAS unsigned char* SFb = X.lds + 2 * BUFB;
    const int tid = X.tid, lane = X.lane, wid = X.wid, l31 = lane & 31, hi = lane >> 5;
    const int pw = wid - 4;
    for (int un = X.c; un < 256; un += X.G) {
        const int unit = (X.G == 256) ? ((((un & 7) * 4 + (un >> 6)) << 3) | ((un >> 3) & 7)) : un;
        const int b = unit >> 5, h = (unit >> 3) & 3, dir = (unit >> 2) & 1, vs = unit & 3;
        bf16_t* O = (bf16_t*)(p.ws + (dir ? WS_OB : WS_OF));
        const size_t rowbase = (size_t)b * SB;
        auto srcrow = [&](int jp) -> int { return dir == 0 ? jp : (jp < CTXL ? (CTXL - 1 - jp) : (SB + CTXL - 1 - jp)); };
        struct Pref { u32x4 rl[4], rqv[4]; };
        Pref PA, PB;
        const int half = pw >> 1, khalf = pw & 1, sgn = dir ? -1 : 1;
        auto gload = [&](int c, Pref& P) {
            int ln = lane; asm volatile("" : "+v"(ln)); const int kch = ln & 7, tseg = ln >> 3;
            const size_t R0 = rowbase + srcrow(c * 64 + 32 * half + 4 * tseg); const bf16_t* rp = P1 + R0 * P1LD + h * 128 + 64 * khalf + 8 * kch;
#pragma unroll
            for (int i = 0; i < 4; ++i) { P.rl[i] = *(const u32x4*)(rp + (ptrdiff_t)(i * sgn) * P1LD + 512 + dir * 512); P.rqv[i] = *(const u32x4*)(rp + (ptrdiff_t)(i * sgn) * P1LD); }
        };
        constexpr int NCH = SB / 64;
        if (wid >= 4) {
            auto produce = [&](int c, Pref& P) {
                if (c < NCH) {
                    LAS unsigned char* B = X.lds + (c & 1) * BUFB;
#pragma unroll
                    for (int i = 0; i < 4; ++i) asm volatile("" : "+v"(P.rl[i]), "+v"(P.rqv[i]) :: "memory");
                    int ln = lane; asm volatile("" : "+v"(ln)); const int kch = ln & 7, tseg = ln >> 3;
                    const bool first = half == 0; const int sig = first ? 7 - tseg : tseg, sdir = first ? 8 : -8;
                    float f[4][8];
#pragma unroll
                    for (int i = 0; i < 4; ++i) { const unsigned w[4] = {P.rl[i].x, P.rl[i].y, P.rl[i].z, P.rl[i].w};
#pragma unroll
                        for (int e = 0; e < 8; ++e) f[i][e] = __builtin_amdgcn_exp2f((e & 1) ? bfhi(w[e >> 1]) : bflo(w[e >> 1])); }
                    u32x4 qraw[4];
#pragma unroll
                    for (int i = 0; i < 4; ++i) qraw[i] = P.rqv[i];
                    if (c + 2 < NCH) gload(c + 2, P);
                    float Xp[8], Tt[8], yy[8];
                    const int a1 = (ln + sdir) << 2, a2 = (ln + 2 * sdir) << 2, a4 = (ln + 4 * sdir) << 2;
#pragma unroll
                    for (int e = 0; e < 8; ++e) Tt[e] = (f[0][e] * f[1][e]) * (f[2][e] * f[3][e]);
#pragma unroll
                    for (int e = 0; e < 8; ++e) yy[e] = __int_as_float(__builtin_amdgcn_ds_bpermute(a1, __float_as_int(Tt[e])));
#pragma unroll
                    for (int e = 0; e < 8; ++e) Xp[e] = (sig >= 1) ? yy[e] : 1.f;
#pragma unroll
                    for (int e = 0; e < 8; ++e) yy[e] = __int_as_float(__builtin_amdgcn_ds_bpermute(a1, __float_as_int(Xp[e])));
#pragma unroll
                    for (int e = 0; e < 8; ++e) Xp[e] = (sig >= 1) ? Xp[e] * yy[e] : Xp[e];
#pragma unroll
                    for (int e = 0; e < 8; ++e) yy[e] = __int_as_float(__builtin_amdgcn_ds_bpermute(a2, __float_as_int(Xp[e])));
#pragma unroll
                    for (int e = 0; e < 8; ++e) Xp[e] = (sig >= 2) ? Xp[e] * yy[e] : Xp[e];
#pragma unroll
                    for (int e = 0; e < 8; ++e) yy[e] = __int_as_float(__builtin_amdgcn_ds_bpermute(a4, __float_as_int(Xp[e])));
#pragma unroll
                    for (int e = 0; e < 8; ++e) Xp[e] = (sig >= 4) ? Xp[e] * yy[e] : Xp[e];
                    if (sig == 7) {
                        LAS f32x4* ep = (LAS f32x4*)(B + 53248) + (128 * half + 64 * khalf + 8 * kch) / 4;
                        ep[0] = (f32x4){Xp[0] * Tt[0], Xp[1] * Tt[1], Xp[2] * Tt[2], Xp[3] * Tt[3]}; ep[1] = (f32x4){Xp[4] * Tt[4], Xp[5] * Tt[5], Xp[6] * Tt[6], Xp[7] * Tt[7]};
                    }
                    const int g16 = 4 * khalf + (kch >> 1), ka = kch & 1, sg = 2 * half + (tseg >> 2), sa = (tseg >> 1) & 1, sh = tseg & 1;
                    auto emit = [&](auto firstc) {
                        constexpr bool FIRST = decltype(firstc)::value;
#pragma unroll
                        for (int eh = 0; eh < 2; ++eh) {
                            float kt[4][4];
                            float esm[4][4], ebig[4][4];
#pragma unroll
                            for (int e4 = 0; e4 < 4; ++e4) { const int e = 4 * eh + e4;
                                if (FIRST) { esm[3][e4] = Xp[e]; esm[2][e4] = f[3][e] * esm[3][e4]; esm[1][e4] = f[2][e] * esm[2][e4]; esm[0][e4] = f[1][e] * esm[1][e4];
                                    ebig[0][e4] = __builtin_amdgcn_rcpf(fmaxf(esm[0][e4], 1e-30f)); ebig[1][e4] = ebig[0][e4] * f[1][e]; ebig[2][e4] = ebig[1][e4] * f[2][e]; ebig[3][e4] = ebig[2][e4] * f[3][e]; }
                                else { esm[0][e4] = f[0][e] * Xp[e]; esm[1][e4] = f[1][e] * esm[0][e4]; esm[2][e4] = f[2][e] * esm[1][e4]; esm[3][e4] = f[3][e] * esm[2][e4];
                                    ebig[3][e4] = __builtin_amdgcn_rcpf(fmaxf(esm[3][e4], 1e-30f)); ebig[2][e4] = ebig[3][e4] * f[3][e]; ebig[1][e4] = ebig[2][e4] * f[2][e]; ebig[0][e4] = ebig[1][e4] * f[1][e]; } }
#pragma unroll
                            for (int i = 0; i < 4; ++i) {
                                const unsigned qw0 = eh ? qraw[i].z : qraw[i].x, qw1 = eh ? qraw[i].w : qraw[i].y;
                                float qt[4];
#pragma unroll
                                for (int e4 = 0; e4 < 4; ++e4) { const int e = 4 * eh + e4;
                                    const float qq = (e4 == 0) ? bflo(qw0) : (e4 == 1) ? bfhi(qw0) : (e4 == 2) ? bflo(qw1) : bfhi(qw1);
                                    qt[e4] = qq * (FIRST ? ebig[i][e4] : esm[i][e4]); kt[i][e4] = (1.f - f[i][e]) * (FIRST ? esm[i][e4] : ebig[i][e4]); }
                                const int t = 32 * half + 4 * tseg + i, o = t * 256 + (((2 * g16 + eh) ^ (t & 15)) << 4) + ka * 8;
                                u32x2 qv, kv; qv.x = pk2(qt[0], qt[1]); qv.y = pk2(qt[2], qt[3]); kv.x = pk2(kt[i][0], kt[i][1]); kv.y = pk2(kt[i][2], kt[i][3]);
                                *(LAS u32x2*)(B + o) = qv; *(LAS u32x2*)(B + 16384 + o) = kv;
                            }
#pragma unroll
                            for (int e4 = 0; e4 < 4; ++e4) { const int k = 64 * khalf + 8 * kch + 4 * eh + e4; u32x2 w2; w2.x = pk2(kt[0][e4], kt[1][e4]); w2.y = pk2(kt[2][e4], kt[3][e4]);
                                *(LAS u32x2*)(B + 32768 + k * 128 + (((2 * sg + sh) ^ ((k >> 1) & 7)) << 4) + sa * 8) = w2; }
                        }
                    };
                    if (first) emit(std::true_type{}); else emit(std::false_type{});
                }
            };
            static_assert(NCH % 2 == 0, "producer loop is unrolled by two");
            gload(0, PA); gload(1, PB);
            for (int c = 0; c < NCH; c += 2) { produce(c, PA); __syncthreads(); produce(c + 1, PB); __syncthreads(); }
            __syncthreads();
        } else if (wid < 2) {
            f32x16 S[2];
#pragma unroll
            for (int r = 0; r < 16; ++r) { S[0][r] = 0.f; S[1][r] = 0.f; }
            u32x4 rvv[2];
            auto vload = [&](int c) {
                int tq = tid; asm volatile("" : "+v"(tq));
#pragma unroll
                for (int j = 0; j < 2; ++j) { const int pc = tq + 128 * j; const size_t Rv = rowbase + srcrow(c * 64 + (pc >> 2));
                    rvv[j] = *(const u32x4*)(P1 + Rv * P1LD + 1536 + h * 128 + vs * 32 + (pc & 3) * 8); }
            };
            vload(0);
            for (int c = 0; c <= NCH; ++c) {
                if (c < NCH) {
                    asm volatile("" : "+v"(rvv[0]), "+v"(rvv[1]) :: "memory");
                    LAS unsigned char* Bw = X.lds + (c & 1) * BUFB;
                    int tq = tid; asm volatile("" : "+v"(tq));
#pragma unroll
                    for (int j = 0; j < 2; ++j) { const int pc = tq + 128 * j, s = pc >> 2, sl = s & 15, sa = sl >> 3, sh = (sl >> 2) & 1, si = sl & 3, sc = (s >> 4) * 2 + sh;
                        const unsigned w[4] = {rvv[j].x, rvv[j].y, rvv[j].z, rvv[j].w};
#pragma unroll
                        for (int e = 0; e < 8; ++e) { const int v = (pc & 3) * 8 + e; const bf16_t val = (bf16_t)((e & 1) ? (w[e >> 1] >> 16) : (w[e >> 1] & 0xffffu));
                            *(LAS bf16_t*)(Bw + 49152 + v * 128 + ((sc ^ ((v >> 1) & 7)) << 4) + (4 * sa + si) * 2) = val; } }
                    if (c + 1 < NCH) vload(c + 1);
                }
                if (c >= 1) {
                    const LAS unsigned char* B = X.lds + ((c - 1) & 1) * BUFB;
                    const LAS float* ERC = (const LAS float*)(B + 53248);
#pragma unroll
                    for (int j = 0; j < 2; ++j) {
                        const int kr = 32 * (2 * wid + j), k = kr + l31;
                        f32x16 W;
#pragma unroll
                        for (int g = 0; g < 4; ++g) { const f32x4 er = *(const LAS f32x4*)(ERC + kr + 8 * g + 4 * hi);
#pragma unroll
                            for (int i = 0; i < 4; ++i) W[4 * g + i] = S[j][4 * g + i] * er[i]; }
#pragma unroll
                        for (int ks = 0; ks < 4; ++ks) {
                            const bf16x8 ak = *(const LAS bf16x8*)(B + 32768 + k * 128 + (((2 * ks + hi) ^ ((k >> 1) & 7)) << 4));
                            const bf16x8 bv = *(const LAS bf16x8*)(B + 49152 + l31 * 128 + (((2 * ks + hi) ^ ((l31 >> 1) & 7)) << 4));
                            W = __builtin_amdgcn_mfma_f32_32x32x16_bf16(ak, bv, W, 0, 0, 0);
                        }
#pragma unroll
                        for (int g = 0; g < 4; ++g) { const f32x4 ec = *(const LAS f32x4*)(ERC + 128 + kr + 8 * g + 4 * hi);
#pragma unroll
                            for (int i = 0; i < 4; ++i) S[j][4 * g + i] = W[4 * g + i] * ec[i]; }
                    }
                }
                if (c < NCH) {
                    LAS unsigned char* SF = SFb + (c & 1) * 8192;
#pragma unroll
                    for (int j = 0; j < 2; ++j)
#pragma unroll
                        for (int s = 0; s < 2; ++s) { u32x4 aw; aw.x = pk2(S[j][8 * s], S[j][8 * s + 1]); aw.y = pk2(S[j][8 * s + 2], S[j][8 * s + 3]);
                            aw.z = pk2(S[j][8 * s + 4], S[j][8 * s + 5]); aw.w = pk2(S[j][8 * s + 6], S[j][8 * s + 7]);
                            *(LAS u32x4*)(SF + (((2 * wid + j) * 2 + s) * 64 + lane) * 16) = aw; }
                }
                __syncthreads();
            }
        } else {
            for (int c = 0; c <= NCH; ++c) {
                if (c >= 1) {
                    const LAS unsigned char* B = X.lds + ((c - 1) & 1) * BUFB;
                    const LAS float* ERC = (const LAS float*)(B + 53248);
                    const LAS unsigned char* SF = SFb + ((c - 1) & 1) * 8192;
                    const int tb = wid - 2, t = 32 * tb + l31;
                    f32x16 oacc;
#pragma unroll
                    for (int r = 0; r < 16; ++r) oacc[r] = 0.f;
                    for (int sb = 0; sb <= tb; ++sb) {
                        f32x16 at;
#pragma unroll
                        for (int r = 0; r < 16; ++r) at[r] = 0.f;
                        const int s = 32 * sb + l31;
#pragma unroll
                        for (int ks = 0; ks < 8; ++ks) {
                            const bf16x8 ak = *(const LAS bf16x8*)(B + 16384 + s * 256 + (((2 * ks + hi) ^ (s & 15)) << 4));
                            const bf16x8 bq = *(const LAS bf16x8*)(B + t * 256 + (((2 * ks + hi) ^ (t & 15)) << 4));
                            at = __builtin_amdgcn_mfma_f32_32x32x16_bf16(ak, bq, at, 0, 0, 0);
                        }
                        if (sb == tb) {
#pragma unroll
                            for (int r = 0; r < 16; ++r) at[r] = (crow(r, hi) <= l31) ? at[r] : 0.f;
                        }
#pragma unroll
                        for (int s2 = 0; s2 < 2; ++s2) {
                            u32x4 pw4; pw4.x = pk2(at[8 * s2], at[8 * s2 + 1]); pw4.y = pk2(at[8 * s2 + 2], at[8 * s2 + 3]); pw4.z = pk2(at[8 * s2 + 4], at[8 * s2 + 5]); pw4.w = pk2(at[8 * s2 + 6], at[8 * s2 + 7]);
                            const bf16x8 av = *(const LAS bf16x8*)(B + 49152 + l31 * 128 + ((((2 * sb + s2) * 2 + hi) ^ ((l31 >> 1) & 7)) << 4));
                            oacc = __builtin_amdgcn_mfma_f32_32x32x16_bf16(av, __builtin_bit_cast(bf16x8, pw4), oacc, 0, 0, 0);
                        }
                    }
#pragma unroll
                    for (int kb = 0; kb < 4; ++kb)
#pragma unroll
                        for (int s = 0; s < 2; ++s) {
                            const bf16x8 as = *(const LAS bf16x8*)(SF + ((kb * 2 + s) * 64 + lane) * 16);
                            const u32x4 bw = *(const LAS u32x4*)(B + t * 256 + ((((2 * kb + s) * 2 + hi) ^ (t & 15)) << 4));
                            const f32x4 e0 = *(const LAS f32x4*)(ERC + 32 * kb + 16 * s + 4 * hi), e1 = *(const LAS f32x4*)(ERC + 32 * kb + 16 * s + 8 + 4 * hi);
                            u32x4 bs; bs.x = pk2(bflo(bw.x) * e0[0], bfhi(bw.x) * e0[1]); bs.y = pk2(bflo(bw.y) * e0[2], bfhi(bw.y) * e0[3]);
                            bs.z = pk2(bflo(bw.z) * e1[0], bfhi(bw.z) * e1[1]); bs.w = pk2(bflo(bw.w) * e1[2], bfhi(bw.w) * e1[3]);
                            oacc = __builtin_amdgcn_mfma_f32_32x32x16_bf16(as, __builtin_bit_cast(bf16x8, bs), oacc, 0, 0, 0);
                        }
                    const size_t R = rowbase + srcrow((c - 1) * 64 + t);
                    bf16_t* orow = O + R * 512 + h * 128 + vs * 32 + 4 * hi;
#pragma unroll
                    for (int g = 0; g < 4; ++g) { u32x2 w2; w2.x = pk2(oacc[4 * g], oacc[4 * g + 1]); w2.y = pk2(oacc[4 * g + 2], oacc[4 * g + 3]); *(u32x2*)(orow + 8 * g) = w2; }
                }
                __syncthreads();
            }
        }
    }
}

DI void mlp_phase(const Params& p, const Ctx& X, int l) {
    const bf16_t* P1 = (const bf16_t*)(p.ws + WS_P1); bf16_t* YB = (bf16_t*)(p.ws + WS_YB);
    LAS unsigned char* vT = X.lds;
    const int tid = X.tid, lane = X.lane, wid = X.wid, hi = lane >> 5, l31 = lane & 31;
    const int nch = l ? 32 : 34, nunits = NBATCH * nch;
    for (int k = 0;; ++k) {
        const int u = k * X.G + (k == 0 ? X.c : X.G - 1 - X.c);
        if (u >= nunits) break;
        const int b = u / nch, ch = u % nch + (l ? 2 : 0);
        const size_t R0 = (size_t)b * SB + ch * 128;
        const int tok = tid >> 2, part = tid & 3;
        const bf16_t* vrow = P1 + (R0 + tok) * P1LD + 2560;
        u32x4 raw[4][4]; float ss = 0.f;
#pragma unroll
        for (int g = 0; g < 4; ++g)
#pragma unroll
            for (int q = 0; q < 4; ++q) raw[g][q] = *(const u32x4*)(vrow + g * 128 + part * 32 + q * 8);
#pragma unroll
        for (int g = 0; g < 4; ++g)
#pragma unroll
            for (int q = 0; q < 4; ++q) { const u32x4 r4 = raw[g][q];
                const float a0 = bflo(r4.x), a1 = bfhi(r4.x), a2 = bflo(r4.y), a3 = bfhi(r4.y), a4 = bflo(r4.z), a5 = bfhi(r4.z), a6 = bflo(r4.w), a7 = bfhi(r4.w);
                ss += (a0 * a0 + a1 * a1) + (a2 * a2 + a3 * a3) + (a4 * a4 + a5 * a5) + (a6 * a6 + a7 * a7); }
        ss += __shfl_xor(ss, 1); ss += __shfl_xor(ss, 2);
        const float rstd = rsqrtf(ss * (1.f / 512.f) + EPS);
        const int tblk = wid & 3, dp = wid >> 2;
#pragma unroll 1
        for (int g = 0; g < 4; ++g) {
#pragma unroll
            for (int q = 0; q < 4; ++q) {
                const int d0 = part * 32 + q * 8;
                const u32x4 r4 = raw[0][q];
                const float* vn = p.mlp_vnorm + l * 512 + g * 128 + d0;
                float a[8]; a[0] = bflo(r4.x); a[1] = bfhi(r4.x); a[2] = bflo(r4.y); a[3] = bfhi(r4.y); a[4] = bflo(r4.z); a[5] = bfhi(r4.z); a[6] = bflo(r4.w); a[7] = bfhi(r4.w);
#pragma unroll
                for (int e = 0; e < 8; ++e) { const int d = d0 + e; const unsigned w = pk2(a[e] * rstd * vn[e], 0.f);
                    *(LAS bf16_t*)(vT + g * 32768 + d * 256 + (((tok >> 3) ^ (d & 15)) << 4) + (tok & 7) * 2) = (bf16_t)(w & 0xffffu); }
            }
#pragma unroll
            for (int q = 0; q < 4; ++q) { raw[0][q] = raw[1][q]; raw[1][q] = raw[2][q]; raw[2][q] = raw[3][q]; }
        }
        __syncthreads();
#pragma unroll 1
        for (int g = 0; g < 4; ++g) {
            const float* wsr = p.mlp_ws + ((size_t)(l * 4 + g) * 128 + tblk * 32 + l31) * 128 + 8 * hi;
            f32x4 w0[8], w1[8];
#pragma unroll
            for (int ks = 0; ks < 8; ++ks) { w0[ks] = *(const f32x4*)(wsr + ks * 16); w1[ks] = *(const f32x4*)(wsr + ks * 16 + 4); }
            const int t = tblk * 32 + l31;
            const float bsv = p.mlp_bs[(l * 4 + g) * 128 + t];
            const bf16_t* urow = P1 + (R0 + t) * P1LD + 2048 + g * 128 + dp * 64 + 4 * hi;
            u32x2 uw[2][4];
#pragma unroll
            for (int j2 = 0; j2 < 2; ++j2)
#pragma unroll
                for (int rq = 0; rq < 4; ++rq) uw[j2][rq] = *(const u32x2*)(urow + j2 * 32 + rq * 8);
            f32x16 acc[2];
#pragma unroll
            for (int r = 0; r < 16; ++r) { acc[0][r] = 0.f; acc[1][r] = 0.f; }
            const LAS unsigned char* vTg = vT + g * 32768;
#pragma unroll
            for (int ks = 0; ks < 8; ++ks) {
                u32x4 aw; aw.x = pk2(w0[ks][0], w0[ks][1]); aw.y = pk2(w0[ks][2], w0[ks][3]); aw.z = pk2(w1[ks][0], w1[ks][1]); aw.w = pk2(w1[ks][2], w1[ks][3]);
                const bf16x8 Wf = __builtin_bit_cast(bf16x8, aw);
#pragma unroll
                for (int j2 = 0; j2 < 2; ++j2) { const int d = (dp * 2 + j2) * 32 + l31;
                    const bf16x8 Vf = *(const LAS bf16x8*)(vTg + d * 256 + (((2 * ks + hi) ^ (d & 15)) << 4));
                    acc[j2] = __builtin_amdgcn_mfma_f32_32x32x16_bf16(Vf, Wf, acc[j2], 0, 0, 0); }
            }
            bf16_t* yrow = YB + (R0 + t) * 512 + g * 128 + dp * 64 + 4 * hi;
#pragma unroll
            for (int j2 = 0; j2 < 2; ++j2)
#pragma unroll
                for (int rq = 0; rq < 4; ++rq) { const u32x2 u2 = uw[j2][rq]; u32x2 o;
                    o.x = pk2(bflo(u2.x) * (acc[j2][4 * rq] + bsv), bfhi(u2.x) * (acc[j2][4 * rq + 1] + bsv)); o.y = pk2(bflo(u2.y) * (acc[j2][4 * rq + 2] + bsv), bfhi(u2.y) * (acc[j2][4 * rq + 3] + bsv));
                    *(u32x2*)(yrow + j2 * 32 + rq * 8) = o; }
        }
        __syncthreads();
    }
}

typedef short v4i16_t __attribute__((ext_vector_type(4)));
DI s16x4 vtr(const LAS unsigned char* pp) { return __builtin_bit_cast(s16x4, __builtin_amdgcn_ds_read_tr16_b64_v4i16((LAS v4i16_t*)pp)); }
DI void glds16(const void* gsrc, unsigned lds_dst) { unsigned keep;
    asm volatile("s_mov_b32 %0, m0\n\ts_mov_b32 m0, %2\n\ts_nop 0\n\tglobal_load_lds_dwordx4 %1, off\n\ts_mov_b32 m0, %0" : "=&s"(keep) : "v"(gsrc), "s"(lds_dst) : "memory"); }
DI void attn_unit(const Params& p, const Ctx& X, int l, int b, int h, int s0, int kbeg, int nk, float lam, float lam_init) {
    const bf16_t* P1 = (const bf16_t*)(p.ws + WS_P1); bf16_t* YC = (bf16_t*)(p.ws + WS_YC);
    int ln_ = X.lane; asm volatile("" : "+v"(ln_));
    const int lane = ln_, wid = X.wid, hi = lane >> 5, l31 = lane & 31;
    const int cc = wid >> 2, qs = s0 + (wid & 3) * 32;
    const size_t rowbase = (size_t)b * SB;
    LAS unsigned char* Kbuf = X.lds;
    LAS unsigned char* Vbuf = X.lds + 65536;
    LAS float* Xb = (LAS float*)X.lds + (wid & 3) * 4096;
    bf16x8 bq[4];
    { const bf16_t* qp = P1 + (rowbase + qs + l31) * P1LD + 3072 + h * 128 + cc * 64 + 8 * hi;
#pragma unroll
      for (int s = 0; s < 4; ++s) bq[s] = *(const bf16x8*)(qp + 16 * s); }
    const bf16_t* kbase = P1 + (rowbase + kbeg) * P1LD + 3584 + h * 128;
    const int krow = 8 * wid + (lane >> 3), kch = (lane & 7) ^ ((krow >> 1) & 7);
    const unsigned koff = (unsigned)(krow * P1LD + kch * 8) * 2u;
    const unsigned voff0 = (unsigned)((((wid & 3) * 16 + (lane >> 2)) * P1LD) + 512 + (wid >> 2) * 32 + (lane & 3) * 8) * 2u;
    const unsigned kl0 = (unsigned)(size_t)Kbuf + wid * 1024, vl0 = (unsigned)(size_t)Vbuf + wid * 1024;
    auto dma_k = [&](int kt, int slot) {
        const char* g = (const char*)(kbase + (size_t)kt * 64 * P1LD);
#pragma unroll
        for (int c2 = 0; c2 < 2; ++c2) glds16(g + koff + c2 * 128, (unsigned)__builtin_amdgcn_readfirstlane((int)(kl0 + slot * 16384 + c2 * 8192)));
    };
    auto dma_v = [&](int kt, int slot) {
        const char* g = (const char*)(kbase + (size_t)kt * 64 * P1LD);
#pragma unroll
        for (int j = 0; j < 2; ++j) glds16(g + voff0 + j * 128, (unsigned)__builtin_amdgcn_readfirstlane((int)(vl0 + slot * 16384 + j * 8192)));
    };
    f32x16 negm;
#pragma unroll
    for (int r = 0; r < 16; ++r) negm[r] = 0.f;
    auto qk = [&](f32x16 (&st)[2], int slot) {
        const LAS unsigned char* Kb = Kbuf + slot * 16384 + cc * 8192;
#pragma unroll
        for (int kb = 0; kb < 2; ++kb) {
            const int row = 32 * kb + l31;
#pragma unroll
            for (int s = 0; s < 4; ++s) { const bf16x8 a = *(const LAS bf16x8*)(Kb + row * 128 + (((2 * s + hi) ^ ((row >> 1) & 7)) << 4));
                if (s == 0) st[kb] = __builtin_amdgcn_mfma_f32_32x32x16_bf16(a, bq[s], negm, 0, 0, 0);
                else st[kb] = __builtin_amdgcn_mfma_f32_32x32x16_bf16(a, bq[s], st[kb], 0, 0, 0); }
        }
    };
    float lsum = 0.f;
    f32x16 ot[4];
#pragma unroll
    for (int k = 0; k < 4; ++k)
#pragma unroll
        for (int r = 0; r < 16; ++r) ot[k][r] = 0.f;
    const int vbase = (4 * hi + ((lane & 15) >> 2)) * 64 + ((lane >> 4) & 1) * 32 + (lane & 3) * 8;
    f32x16 sc[2];
    u32x4 pfw[4];
    bf16x8 vf[4][4];
    auto softmax_seg = [&](const bool first, const int vslot) {
        { const LAS unsigned char* Vb = Vbuf + vslot * 16384 + vbase;
#pragma unroll
          for (int ks = 0; ks < 4; ++ks)
#pragma unroll
            for (int blk = 0; blk < 4; ++blk) { const s16x4 lo = vtr(Vb + (blk * 4 + ks) * 1024), hh = vtr(Vb + (blk * 4 + ks) * 1024 + 512);
                vf[ks][blk] = (bf16x8){lo[0], lo[1], lo[2], lo[3], hh[0], hh[1], hh[2], hh[3]}; } }
        float mx = sc[0][0];
#pragma unroll
        for (int r = 0; r < 16; ++r) { mx = fmaxf(mx, sc[0][r]); mx = fmaxf(mx, sc[1][r]); }
        if (first || __any(mx > 8.0f)) {
            mx = fmaxf(mx, __shfl_xor(mx, 32));
            const float d = first ? mx : fmaxf(mx, 0.f), alpha = __builtin_amdgcn_exp2f(-d);
            lsum *= alpha;
#pragma unroll
            for (int k = 0; k < 4; ++k)
#pragma unroll
                for (int r = 0; r < 16; ++r) ot[k][r] *= alpha;
#pragma unroll
            for (int r = 0; r < 16; ++r) { sc[0][r] -= d; sc[1][r] -= d; negm[r] -= d; }
        }
        float ps = 0.f;
#pragma unroll
        for (int kb = 0; kb < 2; ++kb)
#pragma unroll
            for (int r = 0; r < 16; ++r) { const float e = __builtin_amdgcn_exp2f(sc[kb][r]); sc[kb][r] = e; ps += e; }
        lsum += ps;
#pragma unroll
        for (int ks = 0; ks < 4; ++ks) { const int kb = ks >> 1, s2 = ks & 1;
            pfw[ks].x = pk2(sc[kb][8 * s2 + 0], sc[kb][8 * s2 + 1]); pfw[ks].y = pk2(sc[kb][8 * s2 + 2], sc[kb][8 * s2 + 3]);
            pfw[ks].z = pk2(sc[kb][8 * s2 + 4], sc[kb][8 * s2 + 5]); pfw[ks].w = pk2(sc[kb][8 * s2 + 6], sc[kb][8 * s2 + 7]); }
    };
    auto matrix_seg = [&](int tqk) {
        bf16x8 ak[2][4];
        { const LAS unsigned char* Kb = Kbuf + (tqk & 3) * 16384 + cc * 8192;
#pragma unroll
          for (int kb = 0; kb < 2; ++kb) { const int row = 32 * kb + l31;
#pragma unroll
            for (int s = 0; s < 4; ++s) ak[kb][s] = *(const LAS bf16x8*)(Kb + row * 128 + (((2 * s + hi) ^ ((row >> 1) & 7)) << 4)); } }
#pragma unroll
        for (int ks = 0; ks < 4; ++ks) { const bf16x8 pf = __builtin_bit_cast(bf16x8, pfw[ks]);
#pragma unroll
            for (int blk = 0; blk < 4; ++blk) ot[blk] = __builtin_amdgcn_mfma_f32_32x32x16_bf16(vf[ks][blk], pf, ot[blk], 0, 0, 0); }
#pragma unroll
        for (int kb = 0; kb < 2; ++kb) {
            sc[kb] = __builtin_amdgcn_mfma_f32_32x32x16_bf16(ak[kb][0], bq[0], negm, 0, 0, 0);
#pragma unroll
            for (int s = 1; s < 4; ++s) sc[kb] = __builtin_amdgcn_mfma_f32_32x32x16_bf16(ak[kb][s], bq[s], sc[kb], 0, 0, 0);
        }
    };
#pragma unroll
    for (int ks = 0; ks < 4; ++ks) pfw[ks] = (u32x4){0u, 0u, 0u, 0u};
    dma_k(0, 0); dma_v(0, 0); dma_k(1, 1);
    dma_k(2, 2); dma_v(1, 1);
    dma_k(3, 3); dma_v(2, 2);
    asm volatile("s_waitcnt vmcnt(8)" ::: "memory"); __builtin_amdgcn_s_barrier();
    if (cc == 0) qk(sc, 0);
    int nprev = 4;
    auto odd_issue = [&](int t, int& ncur) { ncur = 0; if (t + 4 < nk) { dma_k(t + 4, t & 3); ncur += 2; } if (t + 3 < nk) { dma_v(t + 3, (t + 3) & 3); ncur += 2; } };
    auto odd_wait = [&](int ncur) {
        const int keep = ncur + nprev; nprev = ncur;
        if (keep == 8) asm volatile("s_waitcnt vmcnt(8) lgkmcnt(0)" ::: "memory"); else if (keep == 6) asm volatile("s_waitcnt vmcnt(6) lgkmcnt(0)" ::: "memory");
        else if (keep == 4) asm volatile("s_waitcnt vmcnt(4) lgkmcnt(0)" ::: "memory"); else if (keep == 2) asm volatile("s_waitcnt vmcnt(2) lgkmcnt(0)" ::: "memory");
        else asm volatile("s_waitcnt vmcnt(0) lgkmcnt(0)" ::: "memory");
        __builtin_amdgcn_s_barrier(); };
    auto even_end = [&]() { asm volatile("s_waitcnt lgkmcnt(0)" ::: "memory"); __builtin_amdgcn_s_barrier(); };
    if (cc == 0) {
#pragma clang loop unroll(disable)
        for (int t = 0; t < nk; ++t) {
            softmax_seg(t == 0, t & 3); even_end();
            int nc; odd_issue(t, nc); matrix_seg(t + 1); odd_wait(nc);
        }
        even_end();
    } else {
        qk(sc, 0); even_end();
#pragma clang loop unroll(disable)
        for (int t = 0; t < nk; ++t) {
            int nc; odd_issue(t, nc); softmax_seg(t == 0, t & 3); odd_wait(nc);
            matrix_seg(t + 1); even_end();
        }
    }
    const float ltot = lsum + __shfl_xor(lsum, 32), inv = 1.f / ltot;
    if (cc == 1) {
#pragma unroll
        for (int k = 0; k < 4; ++k)
#pragma unroll
            for (int r = 0; r < 16; ++r) Xb[(k * 16 + r) * 64 + lane] = ot[k][r] * inv;
    }
    __syncthreads();
    if (cc == 0) {
        float ss = 0.f;
#pragma unroll
        for (int k = 0; k < 4; ++k)
#pragma unroll
            for (int r = 0; r < 16; ++r) { const float o = ot[k][r] * inv - lam * Xb[(k * 16 + r) * 64 + lane]; ot[k][r] = o; ss += o * o; }
        ss += __shfl_xor(ss, 32);
        const float scl = rsqrtf(ss * (1.f / 128.f) + EPS) * (1.f - lam_init);
        bf16_t* yrow = YC + (rowbase + qs + l31) * 512 + h * 128;
        const float* gsub = p.diff_subln + l * 512 + h * 128;
#pragma unroll
        for (int k = 0; k < 4; ++k)
#pragma unroll
            for (int r4 = 0; r4 < 4; ++r4) { const int dv = 32 * k + 8 * r4 + 4 * hi; const f32x4 gg = *(const f32x4*)(gsub + dv);
                u32x2 w; w.x = pk2(ot[k][4 * r4] * scl * gg[0], ot[k][4 * r4 + 1] * scl * gg[1]); w.y = pk2(ot[k][4 * r4 + 2] * scl * gg[2], ot[k][4 * r4 + 3] * scl * gg[3]);
                *(u32x2*)(yrow + dv) = w; }
    }
    __syncthreads();
}
DI void attn_phase(const Params& p, const Ctx& X, int l) {
    const float lam_init = 0.8f - 0.6f * expf(-0.3f * (float)l);
    LAS float* misc = (LAS float*)(X.lds + LDS_MISC);
    if (X.wid == 0) { const float* lp = p.diff_lambda + l * 256; float a = lp[X.lane] * lp[64 + X.lane], b2 = lp[128 + X.lane] * lp[192 + X.lane];
        a = wave_sum(a); b2 = wave_sum(b2); if (X.lane == 0) misc[0] = expf(a) - expf(b2) + lam_init; }
    __syncthreads();
    const float lam = misc[0];
    const int nlat = (1024 - X.c + X.G - 1) / X.G, nctx = (l == 0 && X.c < 64) ? (64 - X.c + X.G - 1) / X.G : 0;
    for (int it = 0; it < nlat + nctx; ++it) {
        int b, h, s0, nk;
        if (it < nlat) {
            int bh, qb;
            if (X.G == 256) { bh = 4 * (X.c & 7) + it; qb = X.c >> 3; } else { const int U = it * X.G + X.c; bh = U >> 5; qb = U & 31; }
            b = bh >> 2; h = bh & 3; s0 = CTXL + qb * 128; nk = SB / 64;
        } else { const int U = (it - nlat) * X.G + X.c; b = U >> 3; h = (U >> 1) & 3; s0 = (U & 1) * 128; nk = CTXL / 64; }
        attn_unit(p, X, l, b, h, s0, 0, nk, lam, lam_init);
    }
}

DI void moe_scatter_phase(const Params& p, const Ctx& X) {
    LAS int* tot = (LAS int*)X.lds;
    LAS int* e1s = tot + 64;
    LAS int* e2s = e1s + 128;
    LAS int* pos0 = e2s + 128;
    LAS int* pos1 = pos0 + 128;
    const int* hist = (const int*)(p.ws + WS_HIST);
    const int tid = X.tid;
    LAS int* hl = tot + 1024;
    LAS int* ps = hl + 4096;
    for (int i = tid; i < X.G * 4; i += 512) ((LAS u32x4*)hl)[i] = ((const u32x4*)hist)[i];
    __syncthreads();
    { const int g = tid & 15, part = tid >> 4; int t = 0, mb = 0;
#pragma unroll
        for (int k = 0; k < 8; ++k) { const int cb = part * 8 + k; if (cb < X.G) { const int v = hl[cb * 16 + g]; t += v; mb += (cb < X.c) ? v : 0; } }
        ps[part * 32 + g] = t; ps[part * 32 + 16 + g] = mb; }
    __syncthreads();
    if (tid < 16) { int t = 0, mb = 0;
        for (int part = 0; part < 32; ++part) { t += ps[part * 32 + tid]; mb += ps[part * 32 + 16 + tid]; }
        tot[tid] = t; tot[16 + tid] = mb; }
    __syncthreads();
    if (tid == 0) { int tb = 0; for (int g = 0; g < 16; ++g) { tot[32 + g] = tb; tot[48 + g] = tb * 256; tb += (tot[g] + 255) >> 8; }
        if (X.c == 0) { int* grp = (int*)(p.ws + WS_GRP); for (int g = 0; g < 16; ++g) { grp[g] = tot[32 + g]; grp[16 + g] = (tot[g] + 255) >> 8; } } }
    const int tpb = (NLAT + X.G - 1) / X.G, n0 = X.c * tpb, n1 = (n0 + tpb < NLAT) ? n0 + tpb : NLAT, cnt = n1 - n0;
    const f32x4* route = (const f32x4*)(p.ws + WS_ROUTE);
    f32x4 rt = (f32x4){0.f, 0.f, 0.f, 0.f};
    if (tid < cnt) { rt = route[n0 + tid]; e1s[tid] = __float_as_int(rt[0]); e2s[tid] = __float_as_int(rt[1]); }
    __syncthreads();
    if (tid < cnt) {
        const int e1 = __float_as_int(rt[0]), e2 = __float_as_int(rt[1]); int r0 = 0, r1 = 0;
        for (int j = 0; j < tid; ++j) { r0 += (e1s[j] == e1) ? 1 : 0; r1 += (e2s[j] == e2) ? 1 : 0; }
        const int q0 = tot[48 + e1] + tot[16 + e1] + r0, q1 = tot[48 + 8 + e2] + tot[16 + 8 + e2] + r1;
        pos0[tid] = q0; pos1[tid] = q1;
        ((int*)(p.ws + WS_POS))[2 * (n0 + tid)] = q0; ((int*)(p.ws + WS_POS))[2 * (n0 + tid) + 1] = q1;
        int* tokt = (int*)(p.ws + WS_TOK); float* wrow = (float*)(p.ws + WS_WROW);
        tokt[q0] = n0 + tid; wrow[q0] = rt[2]; tokt[q1] = n0 + tid; wrow[q1] = rt[3];
    }
    __syncthreads();
    const unsigned char* H = p.ws + WS_H; unsigned char* Xs = p.ws + WS_XS;
    for (int j = X.wid; j < cnt; j += 32) {
        u32x4 v0[4];
#pragma unroll
        for (int q = 0; q < 4; ++q) { const int jq = j + 8 * q; if (jq < cnt) { const int n = n0 + jq, b = n >> 12, t = n & 4095; const size_t R = (size_t)b * SB + CTXL + t; v0[q] = *(const u32x4*)(H + R * D + X.lane * 16); } }
#pragma unroll
        for (int q = 0; q < 4; ++q) { const int jq = j + 8 * q; if (jq < cnt) { *(u32x4*)(Xs + (size_t)pos0[jq] * D + X.lane * 16) = v0[q]; *(u32x4*)(Xs + (size_t)pos1[jq] * D + X.lane * 16) = v0[q]; } }
    }
}
DI void moe_order_setup(const Params& p, const Ctx& X, int g0, int ng, int npn, LAS int* tab) {
    const int* grp = (const int*)(p.ws + WS_GRP);
    if (X.tid == 0) { int cu = 0; for (int j = 0; j < ng; ++j) { tab[j] = cu; cu += grp[16 + g0 + j] * npn; tab[32 + j] = grp[g0 + j]; } tab[ng] = cu; }
    __syncthreads();
}

#define XB_TMO      128
#define XB_XCNT(j)  (256  + 64 * (j))
#define XB_XSUB(j)  (1280 + 64 * (j))
#define XB_XGEN(j)  (2304 + 64 * (j))
#define XB_TOP      3328
#define XB_TOPGEN   3392
#define XCD_BAR_WORDS 3456
#define XB_SPIN_CAP (1u << 18)
__device__ __forceinline__ unsigned xb_ld(unsigned* p)              { return __hip_atomic_load(p, __ATOMIC_RELAXED, __HIP_MEMORY_SCOPE_AGENT); }
__device__ __forceinline__ unsigned xb_add(unsigned* p, unsigned v) { return __hip_atomic_fetch_add(p, v, __ATOMIC_RELAXED, __HIP_MEMORY_SCOPE_AGENT); }
__device__ __forceinline__ unsigned xb_xcc_id() { return (unsigned)__builtin_amdgcn_s_getreg((3 << 11) | 20) & 0xFu; }
#define XB_SPIN(cond, bar) do { unsigned _sp = 0; while (cond) { __builtin_amdgcn_s_sleep(1); \
    if ((++_sp & 255u) == 0u) { if (xb_ld(&(bar)[XB_TMO])) break; if (_sp > XB_SPIN_CAP) { atomicAdd(&(bar)[XB_TMO], 1u); break; } } } } while (0)
struct XcdBarrier { unsigned* bar; unsigned x; volatile LAS unsigned* st; };
__device__ __forceinline__ XcdBarrier xcd_barrier_post(unsigned* bar, volatile LAS unsigned* st) {
    XcdBarrier b; b.bar = bar; b.x = xb_xcc_id(); b.st = st;
    if (threadIdx.x == 0) (void)xb_add(&bar[XB_XCNT(b.x)], 1u);
    return b;
}
__device__ __forceinline__ void xcd_barrier_complete(unsigned* bar, unsigned x, unsigned& nloc, unsigned& nx) {
    const unsigned G = gridDim.x * gridDim.y * gridDim.z;
    unsigned sum, cnt, mine, sp = 0u;
    for (;;) {
        sum = 0u; cnt = 0u; mine = 0u;
#pragma unroll 1
        for (unsigned j = 0; j < 16; ++j) { const unsigned c = xb_ld(&bar[XB_XCNT(j)]); sum += c; cnt += (c > 0u) ? 1u : 0u; mine = (j == x) ? c : mine; }
        if (sum == G) break;
        __builtin_amdgcn_s_sleep(1);
        if ((++sp & 255u) == 0u) { if (xb_ld(&bar[XB_TMO])) break; if (sp > XB_SPIN_CAP) { atomicAdd(&bar[XB_TMO], 1u); break; } }
    }
    nloc = mine > 0u ? mine : 1u; nx = cnt > 0u ? cnt : 1u;
}
__device__ __forceinline__ void xcd_barrier(const XcdBarrier& b) {
    asm volatile("s_waitcnt vmcnt(0)" ::: "memory");
    __syncthreads();
    if (threadIdx.x == 0) {
        unsigned* bar = b.bar;
        __builtin_amdgcn_s_waitcnt(0);
        unsigned nloc = b.st[0], nx = b.st[1];
        if (nloc == 0u) { xcd_barrier_complete(bar, b.x, nloc, nx); b.st[0] = nloc; b.st[1] = nx; }
        const unsigned old = xb_add(&bar[XB_XSUB(b.x)], 1u);
        const unsigned gen = old / nloc;
        if (old + 1u == (gen + 1u) * nloc) {
            __builtin_amdgcn_fence(__ATOMIC_RELEASE, "agent");
            asm volatile("s_waitcnt vmcnt(0)" ::: "memory");
            const unsigned og = xb_add(&bar[XB_TOP], 1u);
            const unsigned tg = og / nx;
            if (og + 1u == (tg + 1u) * nx) xb_add(&bar[XB_TOPGEN], 1u);
            else XB_SPIN(xb_ld(&bar[XB_TOPGEN]) == tg, bar);
            __builtin_amdgcn_fence(__ATOMIC_ACQUIRE, "agent");
            xb_add(&bar[XB_XGEN(b.x)], 1u);
            asm volatile("s_waitcnt vmcnt(0)" ::: "memory");
        } else {
            XB_SPIN(xb_ld(&bar[XB_XGEN(b.x)]) == gen, bar);
            __builtin_amdgcn_fence(__ATOMIC_ACQUIRE, "agent");
            asm volatile("s_waitcnt vmcnt(0)" ::: "memory");
        }
    }
    __syncthreads();
}

constexpr int NPHASE = 21;
__global__ void __launch_bounds__(512, 2) mega(Params p) {
    extern __shared__ __attribute__((aligned(16))) unsigned char smem[];
    Ctx X; X.lds = (LAS unsigned char*)smem; X.tid = threadIdx.x; X.lane = X.tid & 63; X.wid = __builtin_amdgcn_readfirstlane(X.tid >> 6); X.G = gridDim.x; X.c = blockIdx.x; X.ws = p.ws;
    volatile LAS unsigned* barw = (volatile LAS unsigned*)(X.lds + LDS_BARW);
    if (X.tid < 4) barw[X.tid] = 0u;
    __syncthreads();
    XcdBarrier bar; bar.bar = (unsigned*)(p.ws + WS_CTL); bar.x = 0; bar.st = barw;
    const int lo = p.lo, hi = p.hi;
    long long tp0 = 0; if (TP_HIT(0)) tp0 = wall_clock64();
    if (hi - lo > 1) bar = xcd_barrier_post((unsigned*)(p.ws + WS_CTL), barw);
#define IN(k) (lo <= (k) && (k) < hi)
#define FRESH() do { int t_ = threadIdx.x; asm volatile("" : "+v"(t_)); X.tid = t_; X.lane = t_ & 63; X.wid = __builtin_amdgcn_readfirstlane(t_ >> 6); } while (0)
#define EN(s) (((EN_MASK) >> (s)) & 1)
#define NREP(s) ((((REP_MASK) >> (s)) & 1) ? 2 : 1)
#define TP_SPIN(dt) do { const long long t1_ = wall_clock64(); const long long w_ = (long long)(TP_MULT) * (dt); while (wall_clock64() - t1_ < w_) __builtin_amdgcn_s_sleep(16); } while (0)
#define SEAM(k) do { if (IN(k) && IN((k) + 1)) { xcd_barrier(bar); if (TP_HIT(k)) { const long long d_ = wall_clock64() - tp0; TP_SPIN(d_); xcd_barrier(bar); } if (TP_HIT((k) + 1)) tp0 = wall_clock64(); } } while (0)
#define TP_WRAP(sub, ll, call) do { long long s0_ = 0; if (TP_SUB == (sub) && TP_SUBL == (ll)) s0_ = wall_clock64(); call; if (TP_SUB == (sub) && TP_SUBL == (ll)) { const long long d_ = wall_clock64() - s0_; TP_SPIN(d_); } } while (0)
#define SITE_PTRS() unsigned char* ws = p.ws; asm volatile("" : "+s"(ws)); float* mod = (float*)(ws + WS_MOD); bf16_t* Hb = (bf16_t*)(ws + WS_H); (void)mod; (void)Hb

    if (EN(0) && IN(0)) { FRESH(); if (conv_split(X)) conv_range<0>(p, X, 0, 2048, X.c, X.G); else conv_phase<0>(p, X); __syncthreads(); if (NREP(0) == 2) { conv_phase<0>(p, X); __syncthreads(); } adaln_phase(p, X); rope_phase(p, X); __syncthreads(); }
    SEAM(0);
    auto layer = [&](auto lc) {
        constexpr int l = decltype(lc)::value;
        const int pb = 1 + 9 * l;
        if (EN(1) && IN(pb + 0)) for (int rep = 0; rep < NREP(1); ++rep) { FRESH(); norm_phase(p, X, l, 0, l == 0, l == 1 ? 8 : 0); }
        SEAM(pb + 0);
        if (EN(2) && IN(pb + 1)) {
            SITE_PTRS(); const bf16_t* Win = (const bf16_t*)(ws + WS_WIN) + (size_t)l * 8192 * 1024;
            pg8::Gemm g{Hb, Win, 1024}; TileOrder S; S.init(NMT, 20, X.G, X.c, 0, 0); S.reps = NREP(2);
            LAS float* ropeL = (LAS float*)(X.lds + 131072); LAS float* lbL = (LAS float*)(X.lds + LDS_MISC + 2048);
            __syncthreads();
            for (int i = threadIdx.x; i < 2048; i += 512) ropeL[i] = ((const float*)(ws + WS_ROPE))[i];
            for (int i = threadIdx.x; i < 1024; i += 512) lbL[i] = ((const float*)(ws + WS_LB))[l * 1024 + i];
            __syncthreads();
            EpiInproj E{(bf16_t*)(ws + WS_P1), (bf16_t*)(ws + WS_OG), (const LAS f32x2*)ropeL, (const LAS float*)lbL};
            pg8::gemm_phase<EpiInproj, TileOrder>(X.lds, g, S, E);
            if constexpr (l == 0) { if (conv_split(X) && X.c >= 160) { FRESH(); conv_range<0>(p, X, CV_WIN, CV_N0, X.c - 160, 96); } }
        }
        SEAM(pb + 1);
        if (IN(pb + 2)) { if (EN(3)) for (int rep = 0; rep < NREP(3); ++rep) { FRESH(); TP_WRAP(1, l, hgrn_phase(p, X, l)); } __syncthreads(); if (EN(4)) for (int rep = 0; rep < NREP(4); ++rep) { FRESH(); TP_WRAP(2, l, mlp_phase(p, X, l)); } __syncthreads(); if (EN(5)) for (int rep = 0; rep < NREP(5); ++rep) { FRESH(); TP_WRAP(3, l, attn_phase(p, X, l)); } }
        SEAM(pb + 2);
        if (EN(6) && IN(pb + 3)) {
            SITE_PTRS(); const bf16_t* Win = (const bf16_t*)(ws + WS_WIN) + (size_t)l * 8192 * 1024;
            FRESH(); readout_phase(p, X, l);
            pg8::Gemm g{Hb, Win, 1024}; TileOrder S; S.init(l ? 128 : NMT, 12, X.G, X.c, l, 20);
            EpiStore<1> E{(bf16_t*)(ws + WS_G), 3072};
            S.reps = NREP(6); pg8::gemm_phase<EpiStore<1>, TileOrder>(X.lds, g, S, E);
            if constexpr (l == 0) { if (conv_split(X) && X.c >= 96) { FRESH(); conv_range<0>(p, X, 2048, CV_WIN, X.c - 96, 160); } }
        }
        SEAM(pb + 3);
        if (EN(7) && IN(pb + 4)) for (int rep = 0; rep < NREP(7); ++rep) {
            SITE_PTRS();
            pg8::Gemm g{(const bf16_t*)(ws + WS_OB), (const bf16_t*)(ws + WS_WBR) + (size_t)l * 3 * 1024 * 512, 512};
            MergeOrder S; S.t.init(128, 4, X.G, X.c, 1, 0); S.nctx = l ? 0 : 32;
            EpiMerge E{(bf16_t*)(ws + WS_MRG), (const bf16_t*)(ws + WS_G)};
            pg8::gemm_phase<EpiMerge, MergeOrder, true, false, true>(X.lds, g, S, E);
        }
        SEAM(pb + 4);
        if (EN(8) && IN(pb + 5)) {
            SITE_PTRS();
            pg8::Gemm g{(const bf16_t*)(ws + WS_MRG), (const bf16_t*)(ws + WS_WOUT) + (size_t)l * 1024 * 1024, 1024};
            EpiResid E{l == 0 ? p.x : p.out, l == 0 ? p.ctx : (const float*)(ws + WS_CTX), p.out, (float*)(ws + WS_CTX), mod + (size_t)l * 9 * 6144 + 2048, (bf16_t*)(ws + WS_OPSLAB)};
            if constexpr (l == 0) { OpOrder S; S.t.init(128, 4, X.G, X.c, 1, 0); S.G = X.G; S.c = X.c; pg8::gemm_phase<EpiResid, OpOrder, true, false, false, true>(X.lds, g, S, E); }
            else { TileOrder S; S.init(128, 4, X.G, X.c, 1, 0); pg8::gemm_phase<EpiResid, TileOrder>(X.lds, g, S, E); }
        }
        SEAM(pb + 5);
        if (EN(9) && IN(pb + 6)) { __syncthreads(); FRESH(); if (l == 0) norm_phase(p, X, 0, 1, false, 6); else { norm2_router_phase(p, X); __syncthreads(); conv_phase<1>(p, X); if (NREP(9) == 2) { __syncthreads(); conv_phase<1>(p, X); } } }
        SEAM(pb + 6);
        if constexpr (l == 0) {
            if (EN(10) && IN(8)) {
                SITE_PTRS();
                pg8::Gemm g{Hb, (const bf16_t*)(ws + WS_WGU), 1024}; TileOrder S; S.init(NMT, 22, X.G, X.c, 0, 0); S.reps = NREP(10);
                EpiSwiglu E{(bf16_t*)(ws + WS_HID), DFF};
                pg8::gemm_phase<EpiSwiglu, TileOrder>(X.lds, g, S, E);
            }
            SEAM(8);
            if (EN(11) && IN(9)) {
                SITE_PTRS();
                pg8::Gemm g{(const bf16_t*)(ws + WS_HID), (const bf16_t*)(ws + WS_WDN), DFF}; FdOrder S; S.t.init(128, 4, X.G, X.c, 1, 0); S.G = X.G; S.c = X.c;
                EpiResid E{p.out, (const float*)(ws + WS_CTX), p.out, (float*)(ws + WS_CTX), mod + 5120, (bf16_t*)(ws + WS_SLAB)};
                pg8::gemm_phase<EpiResid, FdOrder, true, false, false, true>(X.lds, g, S, E);
            }
            SEAM(9);
        }
    };
    layer(std::integral_constant<int, 0>{}); layer(std::integral_constant<int, 1>{});
    if (EN(12) && IN(17)) for (int rep = 0; rep < NREP(12); ++rep) { __syncthreads(); FRESH(); moe_scatter_phase(p, X); }
    SEAM(17);
    {
        LAS int* tab = (LAS int*)(X.lds + LDS_MISC + 1024);
        if (EN(13) && IN(18)) for (int rep = 0; rep < NREP(13); ++rep) {
            SITE_PTRS();
            __syncthreads(); moe_order_setup(p, X, 0, 16, 28, tab);
            pg8::Gemm g{(const bf16_t*)(ws + WS_XS), (const bf16_t*)(ws + WS_WMGU), 512};
            MoeOrder S{tab, 16, 28, X.G, X.c, 0};
            EpiSwigluT<true> E{(bf16_t*)(ws + WS_HS), DFFE};
            pg8::gemm_phase<EpiSwigluT<true>, MoeOrder, true, true>(X.lds, g, S, E);
        }
        SEAM(18);
        if (EN(14) && IN(19)) {
            SITE_PTRS();
            __syncthreads(); moe_order_setup(p, X, 0, 16, 4, tab);
            pg8::Gemm g{(const bf16_t*)(ws + WS_HS), (const bf16_t*)(ws + WS_WMDN), DFFE / 2};
            MoeOrder S{tab, 16, 4, X.G, X.c, 0, 1};
            EpiMoeDown E{(const int*)(ws + WS_TOK), (const float*)(ws + WS_WROW), (bf16_t*)(ws + WS_Y0), (bf16_t*)(ws + WS_Y1), (bf16_t*)(ws + WS_DSLAB)};
            pg8::gemm_phase<EpiMoeDown, MoeOrder, true, true, false, true>(X.lds, g, S, E);
        }
        SEAM(19);
    }
    if (EN(15) && IN(20)) { FRESH(); final_phase(p, X); if (TP_HIT(20)) { const long long d_ = wall_clock64() - tp0; TP_SPIN(d_); } }
#undef IN
#undef SEAM
#undef TP_WRAP
#undef TP_SPIN
}

extern "C" void kernel_launch(void* const* d_in, const int* in_sizes, int n_in, void* d_out, int out_size, void* d_ws, size_t ws_size, hipStream_t stream) {
    static int grid = 0;
    if (grid == 0) {
        if (n_in != 26 || ws_size < WS_END) { fprintf(stderr, "kernel_launch: unexpected n_in %d / ws_size %zu (need %zu)\n", n_in, ws_size, (size_t)WS_END); grid = -1; return; }
        int dev = 0, cus = 0;
        if (hipGetDevice(&dev) != hipSuccess || hipDeviceGetAttribute(&cus, hipDeviceAttributeMultiprocessorCount, dev) != hipSuccess) { grid = -1; return; }
        if (hipFuncSetAttribute((const void*)mega, hipFuncAttributeMaxDynamicSharedMemorySize, LDS_BYTES) != hipSuccess) { fprintf(stderr, "kernel_launch: hipFuncSetAttribute failed\n"); grid = -1; return; }
        int per_cu = 0;
        if (hipOccupancyMaxActiveBlocksPerMultiprocessor(&per_cu, (const void*)mega, 512, LDS_BYTES) != hipSuccess || per_cu < 1) fprintf(stderr, "kernel_launch: occupancy query reports %d\n", per_cu);
        (void)hipGetLastError();
        grid = cus < 256 ? cus : 256;
    }
    if (grid < 0) return;
    (void)hipMemsetAsync((char*)d_ws + WS_CTL, 0, CTL_ZERO_BYTES, stream);
    Params p{};
    const float** pp = (const float**)&p;
    for (int i = 0; i < 26; ++i) pp[i] = (const float*)d_in[i];
    p.out = (float*)d_out; p.ws = (unsigned char*)d_ws;
#if MK_SPLIT
    for (int k = 0; k < NPHASE; ++k) { if (k == 16) {} p.lo = k; p.hi = k + 1; hipLaunchKernelGGL(mega, dim3(grid), dim3(512), LDS_BYTES, stream, p); }
#else
    p.lo = 0; p.hi = NPHASE;
    hipLaunchKernelGGL(mega, dim3(grid), dim3(512), LDS_BYTES, stream, p);
#endif
}
```

```cpp
#include <hip/hip_runtime.h>
#include <stdint.h>
#include <stdio.h>
#include <type_traits>

#ifndef EN_MASK
#define EN_MASK 0xFFFF
#endif
#ifndef REP_MASK
#define REP_MASK 0
#endif
#ifndef MK_SPLIT
#define MK_SPLIT 0
#define TP_PHASE (-1)
#define TP_SUB 0
#define TP_SUBL 0
#define TP_MULT 8
#define TP_MASK 0
#define TP_HIT(k) (TP_PHASE == (k) || ((TP_MASK >> (k)) & 1))
#endif

#define DI __device__ __forceinline__
#define LAS __attribute__((address_space(3)))
typedef unsigned short bf16_t;
typedef short bf16x8 __attribute__((ext_vector_type(8)));
typedef short s16x4 __attribute__((ext_vector_type(4)));
typedef float f32x2 __attribute__((ext_vector_type(2)));
typedef float f32x4 __attribute__((ext_vector_type(4)));
typedef float f32x16 __attribute__((ext_vector_type(16)));
typedef unsigned u32x2 __attribute__((ext_vector_type(2)));
typedef unsigned u32x4 __attribute__((ext_vector_type(4)));
typedef __bf16 bf16x2_t __attribute__((ext_vector_type(2)));
typedef int v8i32 __attribute__((ext_vector_type(8)));

constexpr int D = 1024, NBATCH = 8, SEQ = 4096, CTXL = 256;
constexpr int SB = SEQ + CTXL;
constexpr int T = NBATCH * SB;
constexpr int NMT = T / 256;
constexpr int NLAT = NBATCH * SEQ;
constexpr int INCOLS = 8192, P1LD = 4608, DFF = 2816, DFFE = 3584, NEXP = 8;
constexpr float EPS = 1e-6f;
constexpr int MAXROWS_MOE = 69632;

constexpr size_t MiB = (size_t)1 << 20;
constexpr size_t WS_CTL = 0;
constexpr size_t CTL_ZERO_BYTES = 65536;
constexpr size_t WS_MOD = 1 * MiB;
constexpr size_t WS_ROPE = 1 * MiB + 512 * 1024;
constexpr size_t WS_ROUTE = 2 * MiB;
constexpr size_t WS_HIST = 3 * MiB;
constexpr size_t WS_TOK = 4 * MiB;
constexpr size_t WS_WROW = 5 * MiB;
constexpr size_t WS_GRP = 6 * MiB;
constexpr size_t WS_LB = 7 * MiB;
constexpr size_t WS_POS = 8 * MiB;
constexpr size_t WS_CTX = 9 * MiB;
constexpr size_t WS_WIN = 17 * MiB;
constexpr size_t WS_WBR = 49 * MiB;
constexpr size_t WS_WOUT = 55 * MiB;
constexpr size_t WS_WGU = 59 * MiB;
constexpr size_t WS_WDN = 70 * MiB;
constexpr size_t WS_H = 77 * MiB;
constexpr size_t WS_P1 = 145 * MiB;
constexpr size_t WS_OG = 451 * MiB;
constexpr size_t WS_OF = 485 * MiB;
constexpr size_t WS_OB = 519 * MiB;
constexpr size_t WS_YB = 553 * MiB;
constexpr size_t WS_YC = 587 * MiB;
constexpr size_t WS_G = 145 * MiB;
constexpr size_t WS_MRG = 383 * MiB;
constexpr size_t WS_HID = 145 * MiB;
constexpr size_t WS_WMGU = 469 * MiB;
constexpr size_t WS_WMDN = 525 * MiB;
constexpr size_t WS_XS = 333 * MiB;
constexpr size_t WS_HS = 17 * MiB;
constexpr size_t WS_Y1 = 333 * MiB;
constexpr size_t WS_SLAB = 383 * MiB;
constexpr size_t WS_DSLAB = 469 * MiB;
constexpr size_t WS_OPSLAB = 469 * MiB;
constexpr size_t WS_Y0 = 397 * MiB;
constexpr size_t WS_END = 637 * MiB;
static_assert(WS_WDN + (size_t)1024 * DFF * 2 <= WS_H, "weights");
static_assert(WS_P1 + (size_t)T * P1LD * 2 <= WS_OG && WS_G + (size_t)T * 3072 * 2 <= WS_MRG && WS_MRG + (size_t)T * 1024 * 2 <= WS_OG, "arena");
static_assert(WS_YC + (size_t)T * 512 * 2 <= WS_END && WS_WMGU + (size_t)8 * 7168 * 1024 <= WS_WMDN && WS_WMDN + (size_t)8 * 1024 * DFFE <= WS_END, "arena end");
static_assert(WS_XS + (size_t)MAXROWS_MOE * 1024 <= WS_WMGU && WS_HS + (size_t)MAXROWS_MOE * DFFE <= WS_XS && WS_HID + (size_t)T * DFF * 2 <= WS_END, "moe");

constexpr int LDS_BYTES = 147456;
constexpr int LDS_MISC = 139264;
constexpr int LDS_BARW = LDS_BYTES - 16;

struct Params {
    const float *x, *c, *ctx, *c_ctx, *w_ada, *b_ada, *g_norm1, *g_norm2, *w_in, *hgrn_lb, *hgrn_gnorm, *mlp_vnorm, *mlp_ws, *mlp_bs,
        *diff_lambda, *diff_subln, *w_branch, *w_out, *ffn_wg, *ffn_wu, *ffn_wd, *moe_router, *moe_wg, *moe_wu, *moe_wd, *g_final;
    float* out; unsigned char* ws; int lo, hi;
};

DI unsigned pk2(float lo, float hi) { f32x2 v = {lo, hi}; bf16x2_t b = __builtin_convertvector(v, bf16x2_t); return __builtin_bit_cast(unsigned, b); }
DI float bflo(unsigned u) { return __uint_as_float(u << 16); }
DI float bfhi(unsigned u) { return __uint_as_float(u & 0xffff0000u); }
DI float bf1(bf16_t u) { return __uint_as_float((unsigned)u << 16); }
DI float wave_sum(float v) {
#pragma unroll
    for (int o = 1; o < 64; o <<= 1) v += __shfl_xor(v, o);
    return v;
}
DI float sigm(float x) { return __builtin_amdgcn_rcpf(1.f + __builtin_amdgcn_exp2f(-1.4426950408889634f * x)); }
DI float gelu_tanh(float x) { const float u = 0.7978845608028654f * (x + 0.044715f * x * x * x); return x * __builtin_amdgcn_rcpf(1.f + __builtin_amdgcn_exp2f(-2.885390081777927f * u)); }
DI f32x4 exp2_4(f32x4 a) { return (f32x4){__builtin_amdgcn_exp2f(a[0]), __builtin_amdgcn_exp2f(a[1]), __builtin_amdgcn_exp2f(a[2]), __builtin_amdgcn_exp2f(a[3])}; }
DI f32x4 rcp_4(f32x4 a) { return (f32x4){__builtin_amdgcn_rcpf(a[0]), __builtin_amdgcn_rcpf(a[1]), __builtin_amdgcn_rcpf(a[2]), __builtin_amdgcn_rcpf(a[3])}; }
DI f32x4 sigm4(f32x4 x) { return rcp_4(exp2_4(x * (-1.4426950408889634f)) + 1.0f); }
DI f32x4 gelu_tanh4(f32x4 x) { const f32x4 q = (x * x) * (-0.10294324f) + (-2.3022082f); return x * rcp_4(exp2_4(x * q) + 1.0f); }
#define LDS_WAIT() asm volatile("s_waitcnt lgkmcnt(0)" ::: "memory")
DI unsigned pk4_fp8(float a, float b, float c, float d) {
    a = __builtin_amdgcn_fmed3f(a, -448.f, 448.f); b = __builtin_amdgcn_fmed3f(b, -448.f, 448.f); c = __builtin_amdgcn_fmed3f(c, -448.f, 448.f); d = __builtin_amdgcn_fmed3f(d, -448.f, 448.f);
    int w = __builtin_amdgcn_cvt_pk_fp8_f32(a, b, 0, false); w = __builtin_amdgcn_cvt_pk_fp8_f32(c, d, w, true); return (unsigned)w; }
constexpr float W8SCALE = 64.f;

namespace pg8 {
constexpr int BM = 256, BK = 64, HALF = 128, HTB = HALF * BK * 2, STAGE_BYTES = 8 * HTB;
__host__ __device__ __forceinline__ int lds_byte(int r, int c) { const int st = (r >> 4) * 2 + (c >> 5), rr = r & 15, cc = c & 31, ob = rr * 64 + cc * 2; return st * 1024 + (ob ^ (((ob >> 9) & 1) << 5)); }
__host__ __device__ __forceinline__ void stage_rc(int b, int& R, int& C) { const int st = b / 1024, sb = b % 1024, swz = sb ^ (((sb >> 9) & 1) << 5); R = (st >> 1) * 16 + swz / 64; C = (st & 1) * 32 + (swz % 64) / 2; }
__host__ __device__ __forceinline__ int perm32(int rho) { const int n = rho >> 4, i = rho & 15; return 8 * (i >> 2) + 4 * n + (i & 3); }

struct Unit { int pm, pn, pa, pb, aux, kt0, nkt; };
struct Gemm { const bf16_t* A; const bf16_t* Bt; int K; };

template <class Epi, class Sched, bool ALIGN_EPI = true, bool FP8 = false, bool CHAIN = false, bool KSPLIT = false>
DI void gemm_phase(LAS unsigned char* lds, const Gemm g, const Sched& S, const Epi& E) {
    int tid_ = threadIdx.x; asm volatile("" : "+v"(tid_));
    const int tid = tid_, wid = __builtin_amdgcn_readfirstlane(tid >> 6), lane = tid & 63, wr = wid >> 2, wc = wid & 3, fr = lane & 15, fq = lane >> 4;
    const int K = g.K, nt = K / BK;
    unsigned voffA[2], voffB[2];
#pragma unroll
    for (int i = 0; i < 2; ++i) { int R, C; stage_rc(tid * 16 + i * 8192, R, C); const int Rb = Epi::PERM ? ((R & ~31) + perm32(R & 31)) : R;
        voffA[i] = (unsigned)(R * K + C) * 2u; voffB[i] = (unsigned)(Rb * K + C) * 2u; }
    const size_t kstep = (size_t)(BK * 2);
    const size_t hstep = (size_t)HALF * K * 2;
    const size_t tstep = 2 * hstep;
    const unsigned ldsw = (unsigned)wid * 1024u;
    const int aoff = lds_byte(wr * 64 + fr, fq * 8), boff = lds_byte(wc * 32 + fr, fq * 8);
#define PG8_SA(b, h) (((b) * 2 + (h)) * HTB)
#define PG8_SB(b, h) ((4 + (b) * 2 + (h)) * HTB)
#define PG8_STAGE(bufoff, gbase, voff) do { _Pragma("unroll") for (int _i = 0; _i < 2; ++_i) { unsigned vo_ = (voff)[_i]; asm volatile("" : "+v"(vo_));     \
        __builtin_amdgcn_global_load_lds((const unsigned*)((const char*)(gbase) + vo_), (LAS unsigned*)(lds + (bufoff) + ldsw + _i * 8192), 16, 0, 0); } } while (0)
typedef int v4i32_ __attribute__((ext_vector_type(4)));
#define PG8_LDA(dst, b, h) do { _Pragma("unroll") for (int m = 0; m < 4; ++m) { if constexpr (FP8) { const v4i32_ lo_ = *(const LAS v4i32_*)(lds + PG8_SA(b, h) + aoff + m * 2048), hi_ = *(const LAS v4i32_*)(lds + PG8_SA(b, h) + aoff + m * 2048 + 1024); \
            dst##8[m] = __builtin_shufflevector(lo_, hi_, 0, 1, 2, 3, 4, 5, 6, 7); } else { _Pragma("unroll") for (int k = 0; k < 2; ++k) dst[m][k] = *(const LAS bf16x8*)(lds + PG8_SA(b, h) + aoff + m * 2048 + k * 1024); } } } while (0)
#define PG8_LDB(dst, b, h) do { _Pragma("unroll") for (int n = 0; n < 2; ++n) { if constexpr (FP8) { const v4i32_ lo_ = *(const LAS v4i32_*)(lds + PG8_SB(b, h) + boff + n * 2048), hi_ = *(const LAS v4i32_*)(lds + PG8_SB(b, h) + boff + n * 2048 + 1024); \
            dst##8[n] = __builtin_shufflevector(lo_, hi_, 0, 1, 2, 3, 4, 5, 6, 7); } else { _Pragma("unroll") for (int k = 0; k < 2; ++k) dst[n][k] = *(const LAS bf16x8*)(lds + PG8_SB(b, h) + boff + n * 2048 + k * 1024); } } } while (0)
#define PG8_MMA(ai, bj, At, Bt) do { __builtin_amdgcn_s_setprio(1); _Pragma("unroll") for (int m = 0; m < 4; ++m) _Pragma("unroll") for (int n = 0; n < 2; ++n) { \
        if constexpr (FP8) asm volatile("v_mfma_scale_f32_16x16x128_f8f6f4 %0, %1, %2, %0, %3, %3 op_sel_hi:[0,0,0]" : "+v"(acc[ai][bj][m][n]) : "v"(Bt##8[n]), "v"(At##8[m]), "v"(sc7f));   \
        else { _Pragma("unroll") for (int k = 0; k < 2; ++k) acc[ai][bj][m][n] = __builtin_amdgcn_mfma_f32_16x16x32_bf16(Bt[n][k], At[m][k], acc[ai][bj][m][n], 0, 0, 0); } } \
        __builtin_amdgcn_s_setprio(0); } while (0)
#define PG8_WAIT_V(n) asm volatile("s_waitcnt vmcnt(" #n ")" ::: "memory")
#define PG8_WAIT_L(n) asm volatile("s_waitcnt lgkmcnt(" #n ")" ::: "memory")
#define PG8_BAR __builtin_amdgcn_s_barrier()
#define PG8_SCHED __builtin_amdgcn_sched_barrier(0)
    Unit cur, nxt; int ui = 0;
    if (!S.next(0, cur)) return;
    f32x4 acc[2][2][4][2];
#pragma unroll
    for (int a = 0; a < 2; ++a)
#pragma unroll
        for (int b = 0; b < 2; ++b)
#pragma unroll
            for (int m = 0; m < 4; ++m)
#pragma unroll
                for (int n = 0; n < 2; ++n) acc[a][b][m][n] = (f32x4){0.f, 0.f, 0.f, 0.f};
    bf16x8 At[4][2], B0[2][2], B1[2][2]; v8i32 At8[4], B08[2], B18[2];
    const int sc7f = 0x7F7F7F7F;
    const char* cA = (const char*)g.A + (size_t)cur.pa * tstep; const char* cB = (const char*)g.Bt + (size_t)cur.pb * tstep;
    if constexpr (KSPLIT) { cA += (size_t)cur.kt0 * kstep; cB += (size_t)cur.kt0 * kstep; }
    PG8_STAGE(PG8_SB(0, 0), cB, voffB); PG8_STAGE(PG8_SB(0, 1), cB + hstep, voffB); PG8_STAGE(PG8_SA(0, 0), cA, voffA); PG8_STAGE(PG8_SA(0, 1), cA + hstep, voffA);
    if (wr == 1) PG8_BAR;
    PG8_WAIT_V(2); PG8_BAR;
    PG8_STAGE(PG8_SB(1, 0), cB + kstep, voffB); PG8_STAGE(PG8_SA(1, 0), cA + kstep, voffA); PG8_STAGE(PG8_SB(1, 1), cB + hstep + kstep, voffB);
    PG8_WAIT_V(6); PG8_BAR;
    for (;;) {
        const bool has_next = S.next(ui + 1, nxt);
        const char* nA = has_next ? (const char*)g.A + (size_t)nxt.pa * tstep : cA; const char* nB = has_next ? (const char*)g.Bt + (size_t)nxt.pb * tstep : cB;
        if constexpr (KSPLIT) { if (has_next) { nA += (size_t)nxt.kt0 * kstep; nB += (size_t)nxt.kt0 * kstep; } }
        const int ntu = KSPLIT ? cur.nkt : nt;
#pragma clang loop unroll(disable)
        for (int t = 0; t < ntu; t += 2) {
            const bool last = (t == ntu - 2);
            const char* a1 = cA + (size_t)(t + 1) * kstep;
            const char* a2 = last ? nA : cA + (size_t)(t + 2) * kstep; const char* b2 = last ? nB : cB + (size_t)(t + 2) * kstep;
            const char* a3 = a2 + kstep; const char* b3 = b2 + kstep;
            PG8_LDB(B0, 0, 0); PG8_LDB(B1, 0, 1); PG8_SCHED; PG8_LDA(At, 0, 0); PG8_STAGE(PG8_SA(1, 1), a1 + hstep, voffA);
            PG8_WAIT_V(8); PG8_WAIT_L(0); PG8_BAR; PG8_MMA(0, 0, At, B0); PG8_MMA(0, 1, At, B1); PG8_BAR; PG8_SCHED;
            PG8_LDA(At, 0, 1); PG8_STAGE(PG8_SB(0, 0), b2, voffB); PG8_STAGE(PG8_SB(0, 1), b2 + hstep, voffB); PG8_STAGE(PG8_SA(0, 0), a2, voffA);
            PG8_WAIT_V(8); PG8_WAIT_L(0); PG8_BAR; PG8_MMA(1, 0, At, B0); PG8_MMA(1, 1, At, B1); PG8_BAR; PG8_SCHED;
            PG8_LDB(B0, 1, 0); PG8_LDB(B1, 1, 1); PG8_SCHED; PG8_LDA(At, 1, 0); PG8_STAGE(PG8_SA(0, 1), a2 + hstep, voffA);
            PG8_WAIT_V(8); PG8_WAIT_L(0); PG8_BAR; PG8_MMA(0, 0, At, B0); PG8_MMA(0, 1, At, B1); PG8_BAR; PG8_SCHED;
            PG8_LDA(At, 1, 1); PG8_STAGE(PG8_SB(1, 0), b3, voffB); PG8_STAGE(PG8_SB(1, 1), b3 + hstep, voffB); PG8_STAGE(PG8_SA(1, 0), a3, voffA);
            PG8_WAIT_V(8); PG8_WAIT_L(0); PG8_BAR; PG8_MMA(1, 0, At, B0); PG8_MMA(1, 1, At, B1); PG8_BAR; PG8_SCHED;
        }
        if constexpr (ALIGN_EPI) { if (wr == 0) PG8_BAR; }
        if constexpr (FP8) asm volatile("s_nop 15\n\ts_nop 7" : "+v"(acc[1][1][0][0]), "+v"(acc[1][1][0][1]), "+v"(acc[1][1][1][0]), "+v"(acc[1][1][1][1]), "+v"(acc[1][1][2][0]), "+v"(acc[1][1][2][1]), "+v"(acc[1][1][3][0]), "+v"(acc[1][1][3][1]) :: "memory");
        E(acc, cur, wr, wc, fr, fq);
        if (!has_next) break;
        if (!(CHAIN && cur.aux < 2)) {
#pragma unroll
        for (int a = 0; a < 2; ++a)
#pragma unroll
            for (int b = 0; b < 2; ++b)
#pragma unroll
                for (int m = 0; m < 4; ++m)
#pragma unroll
                    for (int n = 0; n < 2; ++n) acc[a][b][m][n] = (f32x4){0.f, 0.f, 0.f, 0.f};
        }
        cur = nxt; cA = nA; cB = nB; ++ui;
        if constexpr (ALIGN_EPI) { if (wr == 1) PG8_BAR; }
    }
    PG8_WAIT_V(0);
    if constexpr (!ALIGN_EPI) { if (wr == 0) PG8_BAR; }
    PG8_BAR;
#undef PG8_SA
#undef PG8_SB
#undef PG8_STAGE
#undef PG8_LDA
#undef PG8_LDB
#undef PG8_MMA
#undef PG8_WAIT_V
#undef PG8_WAIT_L
#undef PG8_BAR
#undef PG8_SCHED
}
}
using pg8::Unit;

struct TileOrder {
    int nM, nN, nwg, G, c, skipctx, pboff, reps = 1;
    DI void init(int nM_, int nN_, int G_, int c_, int skipctx_, int pboff_) { nM = nM_; nN = nN_; nwg = nM * nN; G = G_; c = c_; skipctx = skipctx_; pboff = pboff_; }
    DI bool tile(long L, int& pm, int& pn) const {
        if (L >= (long)nwg * reps) return false;
        if (reps > 1) L %= nwg;
        int wgid = (int)L; { const int q = nwg / 8, r = nwg % 8, xcd = wgid % 8, off = wgid / 8; wgid = (xcd < r ? xcd * (q + 1) : r * (q + 1) + (xcd - r) * q) + off; }
        const int nig = 8 * nN, gid = wgid / nig, fm = gid * 8, gsz = (nM - fm) < 8 ? (nM - fm) : 8;
        int m = fm + ((wgid % nig) % gsz); pn = (wgid % nig) / gsz;
        pm = skipctx ? (m + (m >> 4) + 1) : m; return true;
    }
    DI bool next(int i, Unit& u) const { int pm, pn; if (!tile((long)i * G + c, pm, pn)) return false; u.pm = pm; u.pn = pn; u.pa = pm; u.pb = pboff + pn; u.aux = 0; return true; }
};
struct MergeOrder {
    TileOrder t;
    int nctx = 0;
    DI bool next(int i, Unit& u) const {
        if (nctx) { const int nk = (t.nwg - t.c + t.G - 1) / t.G;
            if (i >= 3 * nk) { const int q = (i - 3 * nk) * t.G + t.c; if (q >= 3 * nctx) return false; const int cu = q / 3, br = q - 3 * cu;
                u.pm = (cu >> 2) * 17; u.pn = cu & 3; u.pa = br * NMT + u.pm; u.pb = br * 4 + u.pn; u.aux = 4 + br; return true; } }
        const int br = i % 3; int pm, pn; if (!t.tile((long)(i / 3) * t.G + t.c, pm, pn)) return false;
        u.pm = pm; u.pn = pn; u.pa = br * NMT + pm; u.pb = br * 4 + pn; u.aux = br; return true; }
};
struct OpOrder {
    TileOrder t; int G, c;
    DI bool next(int i, Unit& u) const {
        const int L = i * G + c;
        if (L < 512) { int pm, pn; if (!t.tile(L, pm, pn)) return false; u.pm = pm; u.pn = pn; u.pa = pm; u.pb = pn; u.aux = 0; u.kt0 = 0; u.nkt = 16; return true; }
        const int q = L - 512; if (q >= 192) return false;
        const int cu = q / 6, r = q - 6 * cu;
        u.pm = (cu >> 2) * 17; u.pn = cu & 3; u.pa = NMT + (r >> 1) * 8 + (cu >> 2); u.pb = u.pn; u.aux = 1 + r; u.kt0 = (r & 1) * 8; u.nkt = 8; return true;
    }
};
struct FdOrder {
    TileOrder t; int G, c;
    DI bool next(int i, Unit& u) const {
        const int L = i * G + c;
        if (L < 512) { int pm, pn; if (!t.tile(L, pm, pn)) return false; u.pm = pm; u.pn = pn; u.pa = pm; u.pb = pn; u.aux = 0; u.kt0 = 0; u.nkt = DFF / 64; return true; }
        const int q = L - 512; if (q >= 256) return false;
        const int cu = q >> 3, s = q & 7;
        u.pm = (cu >> 2) * 17; u.pn = cu & 3; u.pa = u.pm; u.pb = u.pn; u.aux = 1 + s;
        u.kt0 = 2 * (s < 6 ? 3 * s : 18 + 2 * (s - 6)); u.nkt = s < 6 ? 6 : 4; return true;
    }
};
struct MoeOrder {
    const LAS int* tab;
    int ng, npn, G, c, g0;
    int ksplit = 0;
    DI bool next(int i, Unit& u) const {
        int L = i * G + c; const int total = __builtin_amdgcn_readfirstlane(tab[ng]); int sl = -1;
        if (ksplit && L >= 1024) { const int q = L - 1024; L = 1024 + (q >> 2); sl = q & 3; }
        if (L >= total) return false;
        int ln = (int)(threadIdx.x & 63); asm volatile("" : "+v"(ln)); const int tv = tab[ln & 15];
        const int j = __builtin_amdgcn_readfirstlane((int)__popcll(__ballot(ln >= 1 && ln < ng && L >= tv)));
        const int tj = __builtin_amdgcn_readfirstlane(tab[j]), tbj = __builtin_amdgcn_readfirstlane(tab[32 + j]), e = (g0 + j) & 7;
        const int r = L - tj, mt = r / npn, pn = r % npn, gt = tbj + mt;
        u.pm = gt; u.pa = gt; u.pn = pn; u.pb = e * npn + pn; u.aux = (g0 + j) >> 3;
        u.kt0 = 0; u.nkt = DFFE / 128;
        if (sl >= 0) { u.aux += 2 * (1 + sl); u.kt0 = sl < 2 ? 8 * sl : 16 + 6 * (sl - 2); u.nkt = sl < 2 ? 8 : 6; }
        return true;
    }
};

DI void row_bs(int R, int& b, int& s) { b = R / SB; s = R - b * SB; }

struct EpiInproj {
    static constexpr bool PERM = true;
    bf16_t* P1; bf16_t* OG; const LAS f32x2* rope; const LAS float* lbt;
    template <int OP> DI void run(const f32x4 (&acc)[2][2][4][2], const Unit& u, int wr, int wc, int fr, int fq, bf16_t* base, int ldc, int colt, float qs) const {
        f32x4 lb0[2], lb1[2];
        if (OP == 3) {
#pragma unroll
            for (int bj = 0; bj < 2; ++bj) { const LAS float* lp = lbt + (u.pn - 2) * 256 + bj * 128 + wc * 32 + 8 * fq; lb0[bj] = *(const LAS f32x4*)lp; lb1[bj] = *(const LAS f32x4*)(lp + 4); }
        }
#pragma unroll
        for (int ai = 0; ai < 2; ++ai)
#pragma unroll
            for (int m = 0; m < 4; ++m) {
                const int R = u.pm * 256 + ai * 128 + wr * 64 + m * 16 + fr;
                bf16_t* rowp = base + (size_t)R * ldc + colt + wc * 32 + 8 * fq;
                f32x4 c0 = {1.f, 1.f, 1.f, 1.f}, s0 = {0.f, 0.f, 0.f, 0.f}, c1 = c0, s1 = s0;
                if (OP == 2) {
                    int b, s; row_bs(R, b, s);
                    const int t = s - CTXL; const int pos = (wc & 1) ? (t & 63) : (t >> 6);
                    if (s >= CTXL) { const LAS f32x4* rp = (const LAS f32x4*)(rope + pos * 16 + 8 * (fq & 1)); const f32x4 a = rp[0], bq = rp[1], cq = rp[2], dq = rp[3];
                        c0 = (f32x4){a[0], a[2], bq[0], bq[2]}; s0 = (f32x4){a[1], a[3], bq[1], bq[3]}; c1 = (f32x4){cq[0], cq[2], dq[0], dq[2]}; s1 = (f32x4){cq[1], cq[3], dq[1], dq[3]}; }
                }
#pragma unroll
                for (int bj = 0; bj < 2; ++bj) {
                    f32x4 v0 = acc[ai][bj][m][0], v1 = acc[ai][bj][m][1];
                    if (OP == 1) { v0 = gelu_tanh4(v0); v1 = gelu_tanh4(v1); }
                    else if (OP == 3) {
                        const f32x4 f0 = sigm4(v0) * (1.0f - lb0[bj]) + lb0[bj], f1 = sigm4(v1) * (1.0f - lb1[bj]) + lb1[bj];
#pragma unroll
                        for (int i = 0; i < 4; ++i) { v0[i] = __builtin_amdgcn_logf(f0[i]); v1[i] = __builtin_amdgcn_logf(f1[i]); }
                    } else if (OP == 2) {
                        f32x4 x1a, x2a, x1b, x2b;
#pragma unroll
                        for (int i = 0; i < 4; ++i) {
                            auto ra = __builtin_amdgcn_permlane32_swap(__float_as_uint(v0[i]), __float_as_uint(v0[i]), false, false); x1a[i] = __uint_as_float(ra[0]); x2a[i] = __uint_as_float(ra[1]);
                            auto rb = __builtin_amdgcn_permlane32_swap(__float_as_uint(v1[i]), __float_as_uint(v1[i]), false, false); x1b[i] = __uint_as_float(rb[0]); x2b[i] = __uint_as_float(rb[1]); }
                        if (fq < 2) { v0 = (x1a * c0 - x2a * s0) * qs; v1 = (x1b * c1 - x2b * s1) * qs; }
                        else { v0 = (x1a * s0 + x2a * c0) * qs; v1 = (x1b * s1 + x2b * c1) * qs; }
                    }
                    u32x4 w; w.x = pk2(v0[0], v0[1]); w.y = pk2(v0[2], v0[3]); w.z = pk2(v1[0], v1[1]); w.w = pk2(v1[2], v1[3]);
                    *(u32x4*)(rowp + bj * 128) = w;
                }
            }
    }
    DI void operator()(const f32x4 (&acc)[2][2][4][2], const Unit& u, int wr, int wc, int fr, int fq) const {
        const int pn = u.pn;
        bf16_t* base; int ldc, colt;
        if (pn == 8 || pn == 9) { base = OG; ldc = 512; colt = (pn - 8) * 256; }
        else { base = P1; ldc = P1LD; colt = pn * 256 - (pn >= 10 ? 512 : 0); }
        const float qs = (pn == 14 || pn == 15) ? 0.18033688011112042f : 1.0f;
        if (pn >= 10 && pn <= 13) run<1>(acc, u, wr, wc, fr, fq, base, ldc, colt, qs);
        else if (pn >= 14 && pn <= 17) run<2>(acc, u, wr, wc, fr, fq, base, ldc, colt, qs);
        else if (pn >= 2 && pn <= 5) run<3>(acc, u, wr, wc, fr, fq, base, ldc, colt, qs);
        else run<0>(acc, u, wr, wc, fr, fq, base, ldc, colt, qs);
    }
};

template <int ACT> struct EpiStore {
    static constexpr bool PERM = true;
    bf16_t* O; int ldc;
    DI void operator()(const f32x4 (&acc)[2][2][4][2], const Unit& u, int wr, int wc, int fr, int fq) const {
#pragma unroll
        for (int ai = 0; ai < 2; ++ai)
#pragma unroll
            for (int m = 0; m < 4; ++m) {
                bf16_t* rowp = O + (size_t)(u.pm * 256 + ai * 128 + wr * 64 + m * 16 + fr) * ldc + u.pn * 256 + wc * 32 + 8 * fq;
#pragma unroll
                for (int bj = 0; bj < 2; ++bj) {
                    f32x4 v0 = acc[ai][bj][m][0], v1 = acc[ai][bj][m][1];
                    if (ACT == 1) { v0 = sigm4(v0); v1 = sigm4(v1);
#pragma unroll
                        for (int i = 0; i < 4; ++i) { v0[i] = fmaxf(v0[i], 1e-6f); v1[i] = fmaxf(v1[i], 1e-6f); }
                    }
                    u32x4 w; w.x = pk2(v0[0], v0[1]); w.y = pk2(v0[2], v0[3]); w.z = pk2(v1[0], v1[1]); w.w = pk2(v1[2], v1[3]);
                    *(u32x4*)(rowp + bj * 128) = w;
                }
            }
    }
};

struct EpiMerge {
    static constexpr bool PERM = true;
    bf16_t* MRG; const bf16_t* G;
    DI void operator()(f32x4 (&acc)[2][2][4][2], const Unit& u, int wr, int wc, int fr, int fq) const {
        const int br = u.aux & 3; const bool chain = u.aux < 2;
        const int pmo = u.aux >= 4 ? NMT + br * 8 + u.pm / 17 : u.pm;
        const int c0 = u.pn * 256 + wc * 32 + 8 * fq;
#pragma unroll
        for (int ai = 0; ai < 2; ++ai) {
            u32x4 gv[4][2], hv[4][2];
#pragma unroll
            for (int m = 0; m < 4; ++m)
#pragma unroll
                for (int bj = 0; bj < 2; ++bj) { const bf16_t* gp = G + (size_t)(u.pm * 256 + ai * 128 + wr * 64 + m * 16 + fr) * 3072 + br * 1024 + c0 + bj * 128;
                    gv[m][bj] = *(const u32x4*)gp; if (chain) hv[m][bj] = *(const u32x4*)(gp + 1024); }
#pragma unroll
            for (int m = 0; m < 4; ++m)
#pragma unroll
                for (int bj = 0; bj < 2; ++bj) {
                    const u32x4 g4 = gv[m][bj];
                    const f32x4 ga = (f32x4){bflo(g4.x), bfhi(g4.x), bflo(g4.y), bfhi(g4.y)}, gb = (f32x4){bflo(g4.z), bfhi(g4.z), bflo(g4.w), bfhi(g4.w)};
                    if (chain) {
                        const u32x4 h4 = hv[m][bj];
                        const f32x4 ha = (f32x4){bflo(h4.x), bfhi(h4.x), bflo(h4.y), bfhi(h4.y)}, hb = (f32x4){bflo(h4.z), bfhi(h4.z), bflo(h4.w), bfhi(h4.w)};
                        acc[ai][bj][m][0] = acc[ai][bj][m][0] * (ga * rcp_4(ha)); acc[ai][bj][m][1] = acc[ai][bj][m][1] * (gb * rcp_4(hb));
                    } else {
                        const f32x4 v0 = acc[ai][bj][m][0] * ga, v1 = acc[ai][bj][m][1] * gb;
                        u32x4 w; w.x = pk2(v0[0], v0[1]); w.y = pk2(v0[2], v0[3]); w.z = pk2(v1[0], v1[1]); w.w = pk2(v1[2], v1[3]);
                        *(u32x4*)(MRG + (size_t)(pmo * 256 + ai * 128 + wr * 64 + m * 16 + fr) * 1024 + c0 + bj * 128) = w;
                    }
                }
        }
    }
};

struct EpiResid {
    static constexpr bool PERM = true;
    const float* in_l; const float* in_c; float* out_l; float* out_c; const float* gate;
    bf16_t* slab = nullptr;
    DI void operator()(const f32x4 (&acc)[2][2][4][2], const Unit& u, int wr, int wc, int fr, int fq) const {
        const int c0 = u.pn * 256 + wc * 32 + 8 * fq;
        if (u.aux) {
            bf16_t* sl = slab + ((size_t)(u.aux - 1) * (NBATCH * CTXL) + (size_t)(u.pm / 17) * CTXL + wr * 64 + fr) * D + c0;
#pragma unroll
            for (int ai = 0; ai < 2; ++ai)
#pragma unroll
                for (int m = 0; m < 4; ++m)
#pragma unroll
                    for (int bj = 0; bj < 2; ++bj) { const f32x4 a0 = acc[ai][bj][m][0], a1 = acc[ai][bj][m][1];
                        u32x4 w4; w4.x = pk2(a0[0], a0[1]); w4.y = pk2(a0[2], a0[3]); w4.z = pk2(a1[0], a1[1]); w4.w = pk2(a1[2], a1[3]); *(u32x4*)(sl + (size_t)(ai * 128 + m * 16) * D + bj * 128) = w4; }
            return;
        }
        const int bt = u.pm / 17, isc = (u.pm - bt * 17) == 0;
        const float* gp = gate + (size_t)(isc ? 8 : bt) * 6144 + c0;
        f32x4 g[2][2];
#pragma unroll
        for (int bj = 0; bj < 2; ++bj) { g[bj][0] = *(const f32x4*)(gp + bj * 128); g[bj][1] = *(const f32x4*)(gp + bj * 128 + 4); }
#pragma unroll
        for (int ai = 0; ai < 2; ++ai) {
            f32x4 xv[4][2][2]; size_t ro[4];
#pragma unroll
            for (int m = 0; m < 4; ++m) {
                const int R = u.pm * 256 + ai * 128 + wr * 64 + m * 16 + fr, s = R - bt * SB;
                ro[m] = isc ? (size_t)(bt * CTXL + s) * D : (size_t)(bt * SEQ + s - CTXL) * D;
                const float* xi = (isc ? in_c : in_l) + ro[m] + c0;
#pragma unroll
                for (int bj = 0; bj < 2; ++bj) { xv[m][bj][0] = *(const f32x4*)(xi + bj * 128); xv[m][bj][1] = *(const f32x4*)(xi + bj * 128 + 4); }
            }
#pragma unroll
            for (int m = 0; m < 4; ++m) {
                float* xo = (isc ? out_c : out_l) + ro[m] + c0;
#pragma unroll
                for (int bj = 0; bj < 2; ++bj) { *(f32x4*)(xo + bj * 128) = xv[m][bj][0] + g[bj][0] * acc[ai][bj][m][0]; *(f32x4*)(xo + bj * 128 + 4) = xv[m][bj][1] + g[bj][1] * acc[ai][bj][m][1]; }
            }
        }
    }
};

template <bool F8> struct EpiSwigluT {
    static constexpr bool PERM = true;
    bf16_t* Hd; int ldc;
    DI void operator()(const f32x4 (&acc)[2][2][4][2], const Unit& u, int wr, int wc, int fr, int fq) const {
#pragma unroll
        for (int ai = 0; ai < 2; ++ai)
#pragma unroll
            for (int m = 0; m < 4; ++m) {
                const size_t eo = (size_t)(u.pm * 256 + ai * 128 + wr * 64 + m * 16 + fr) * ldc + u.pn * 128 + wc * 32 + 8 * fq;
                constexpr float sc = F8 ? 1.f / W8SCALE : 1.f;
                float o[8];
#pragma unroll
                for (int n = 0; n < 2; ++n)
#pragma unroll
                    for (int ih = 0; ih < 2; ++ih) {
                        const f32x2 g2 = (f32x2){acc[ai][0][m][n][2 * ih], acc[ai][0][m][n][2 * ih + 1]}, u2 = (f32x2){acc[ai][1][m][n][2 * ih], acc[ai][1][m][n][2 * ih + 1]};
                        const f32x2 a2 = g2 * (-1.4426950408889634f * sc);
                        const f32x2 e2 = (f32x2){__builtin_amdgcn_exp2f(a2[0]), __builtin_amdgcn_exp2f(a2[1])};
                        const f32x2 d2 = e2 * (1.f / (sc * sc)) + (1.f / (sc * sc));
                        const f32x2 r2 = (f32x2){__builtin_amdgcn_rcpf(d2[0]), __builtin_amdgcn_rcpf(d2[1])};
                        const f32x2 o2 = (g2 * u2) * r2;
                        o[n * 4 + 2 * ih] = o2[0]; o[n * 4 + 2 * ih + 1] = o2[1]; }
                if constexpr (F8) { u32x2 w; w.x = pk4_fp8(o[0], o[1], o[2], o[3]); w.y = pk4_fp8(o[4], o[5], o[6], o[7]); *(u32x2*)((unsigned char*)Hd + eo) = w; }
                else { u32x4 w; w.x = pk2(o[0], o[1]); w.y = pk2(o[2], o[3]); w.z = pk2(o[4], o[5]); w.w = pk2(o[6], o[7]); *(u32x4*)(Hd + eo) = w; }
            }
    }
};
typedef EpiSwigluT<false> EpiSwiglu;

struct EpiMoeDown {
    static constexpr bool PERM = true;
    const int* tok; const float* wrow; bf16_t* y0; bf16_t* y1; bf16_t* dslab;
    DI void operator()(const f32x4 (&acc)[2][2][4][2], const Unit& u, int wr, int wc, int fr, int fq) const {
        const int c0 = u.pn * 256 + wc * 32 + 8 * fq;
        if (u.aux >= 2) {
            const int rb = u.pm * 256 + wr * 64 + fr;
            bf16_t* sl = dslab + ((size_t)((u.aux >> 1) - 1) * 4096 + (size_t)(rb - 65536)) * D + c0;
            float wv[2][4];
#pragma unroll
            for (int ai = 0; ai < 2; ++ai)
#pragma unroll
                for (int m = 0; m < 4; ++m) wv[ai][m] = wrow[rb + ai * 128 + m * 16] * (1.f / W8SCALE);
#pragma unroll
            for (int ai = 0; ai < 2; ++ai)
#pragma unroll
                for (int m = 0; m < 4; ++m)
#pragma unroll
                    for (int bj = 0; bj < 2; ++bj) { const f32x4 a0 = acc[ai][bj][m][0] * wv[ai][m], a1 = acc[ai][bj][m][1] * wv[ai][m];
                        u32x4 w4; w4.x = pk2(a0[0], a0[1]); w4.y = pk2(a0[2], a0[3]); w4.z = pk2(a1[0], a1[1]); w4.w = pk2(a1[2], a1[3]); *(u32x4*)(sl + (size_t)(ai * 128 + m * 16) * D + bj * 128) = w4; }
            return;
        }
        bf16_t* y = u.aux ? y1 : y0;
        int nn[2][4]; float ww[2][4];
#pragma unroll
        for (int ai = 0; ai < 2; ++ai)
#pragma unroll
            for (int m = 0; m < 4; ++m) { const int row = u.pm * 256 + ai * 128 + wr * 64 + m * 16 + fr; nn[ai][m] = tok[row]; ww[ai][m] = wrow[row] * (1.f / W8SCALE); }
#pragma unroll
        for (int ai = 0; ai < 2; ++ai)
#pragma unroll
            for (int m = 0; m < 4; ++m) if (nn[ai][m] >= 0) {
                const size_t o = (size_t)nn[ai][m] * D + c0; const float w = ww[ai][m];
#pragma unroll
                for (int bj = 0; bj < 2; ++bj) {
                    const f32x4 a0 = acc[ai][bj][m][0] * w, a1 = acc[ai][bj][m][1] * w;
                    u32x4 w4; w4.x = pk2(a0[0], a0[1]); w4.y = pk2(a0[2], a0[3]); w4.z = pk2(a1[0], a1[1]); w4.w = pk2(a1[2], a1[3]); *(u32x4*)(y + o + bj * 128) = w4;
                }
            }
    }
};

struct Ctx {
    LAS unsigned char* lds; int tid, lane, wid, G, c;
    unsigned char* ws;
};

struct ConvItem { const float* W; int N, k0, n0; bf16_t* Dst; int Kd, drow; };
template <bool F8> DI void conv_tile(const ConvItem& c, LAS float* scr, int lane) {
    const float* src = c.W + (size_t)c.k0 * c.N + c.n0 + (lane & 15) * 4;
#pragma unroll 4
    for (int i = 0; i < 16; ++i) { const int kk = 4 * i + (lane >> 4); const f32x4 v = *(const f32x4*)(src + (size_t)kk * c.N);
        LAS float* d = scr + kk * 65 + (lane & 15) * 4; d[0] = v[0]; d[1] = v[1]; d[2] = v[2]; d[3] = v[3]; }
    LDS_WAIT();
    const int kc = lane & 7;
#pragma unroll
    for (int i = 0; i < 8; ++i) { const int n = i * 8 + (lane >> 3); const LAS float* s = scr + (kc * 8) * 65 + n;
        if constexpr (F8) { u32x2 o; o.x = pk4_fp8(s[0] * W8SCALE, s[65] * W8SCALE, s[2 * 65] * W8SCALE, s[3 * 65] * W8SCALE); o.y = pk4_fp8(s[4 * 65] * W8SCALE, s[5 * 65] * W8SCALE, s[6 * 65] * W8SCALE, s[7 * 65] * W8SCALE);
            *(u32x2*)((unsigned char*)c.Dst + (size_t)(c.drow + n) * c.Kd + c.k0 + kc * 8) = o; }
        else { u32x4 o; o.x = pk2(s[0], s[65]); o.y = pk2(s[2 * 65], s[3 * 65]); o.z = pk2(s[4 * 65], s[5 * 65]); o.w = pk2(s[6 * 65], s[7 * 65]);
            *(u32x4*)(c.Dst + (size_t)(c.drow + n) * c.Kd + c.k0 + kc * 8) = o; } }
    LDS_WAIT();
}
constexpr int CV_WIN = 2 * 16 * 128, CV_WBR = 6 * 128, CV_WOUT = 2 * 256, CV_FF = 704, CV_N0 = CV_WIN + CV_WBR + CV_WOUT + 3 * CV_FF;
constexpr int CV_ME = 896, CV_N1 = 3 * 8 * CV_ME;
DI void conv_decode0(const Params& p, int r, ConvItem& c) {
    unsigned char* ws = p.ws;
    if (r < CV_WIN) { const int l = r / 2048, rr = r % 2048; c.W = p.w_in + (size_t)l * 1024 * 8192; c.N = 8192; c.k0 = (rr / 128) * 64; c.n0 = (rr % 128) * 64;
        c.Dst = (bf16_t*)(ws + WS_WIN) + (size_t)l * 8192 * 1024; c.Kd = 1024; c.drow = c.n0; return; } r -= CV_WIN;
    if (r < CV_WBR) { const int m6 = r / 128, rr = r % 128; c.W = p.w_branch + (size_t)m6 * 512 * 1024; c.N = 1024; c.k0 = (rr / 16) * 64; c.n0 = (rr % 16) * 64;
        c.Dst = (bf16_t*)(ws + WS_WBR) + (size_t)m6 * 1024 * 512; c.Kd = 512; c.drow = c.n0; return; } r -= CV_WBR;
    if (r < CV_WOUT) { const int l = r / 256, rr = r % 256; c.W = p.w_out + (size_t)l * 1024 * 1024; c.N = 1024; c.k0 = (rr / 16) * 64; c.n0 = (rr % 16) * 64;
        c.Dst = (bf16_t*)(ws + WS_WOUT) + (size_t)l * 1024 * 1024; c.Kd = 1024; c.drow = c.n0; return; } r -= CV_WOUT;
    if (r < 2 * CV_FF) { const int up = r / CV_FF, rr = r % CV_FF; c.W = up ? p.ffn_wu : p.ffn_wg; c.N = DFF; c.k0 = (rr / 44) * 64; c.n0 = (rr % 44) * 64;
        c.Dst = (bf16_t*)(ws + WS_WGU); c.Kd = 1024; c.drow = (c.n0 / 128) * 256 + (c.n0 % 128) + up * 128; return; } r -= 2 * CV_FF;
    { c.W = p.ffn_wd; c.N = 1024; c.k0 = (r / 16) * 64; c.n0 = (r % 16) * 64; c.Dst = (bf16_t*)(ws + WS_WDN); c.Kd = DFF; c.drow = c.n0; }
}
DI void conv_decode1(const Params& p, int r, ConvItem& c) {
    unsigned char* ws = p.ws;
    if (r < 16 * CV_ME) { const int up = r / (8 * CV_ME), r2 = r % (8 * CV_ME), e = r2 / CV_ME, rr = r2 % CV_ME;
        c.W = (up ? p.moe_wu : p.moe_wg) + (size_t)e * 1024 * DFFE; c.N = DFFE; c.k0 = (rr / 56) * 64; c.n0 = (rr % 56) * 64;
        c.Dst = (bf16_t*)(ws + WS_WMGU + (size_t)e * 7168 * 1024); c.Kd = 1024; c.drow = (c.n0 / 128) * 256 + (c.n0 % 128) + up * 128; return; } r -= 16 * CV_ME;
    { const int e = r / CV_ME, rr = r % CV_ME; c.W = p.moe_wd + (size_t)e * DFFE * 1024; c.N = 1024; c.k0 = (rr / 16) * 64; c.n0 = (rr % 16) * 64;
        c.Dst = (bf16_t*)(ws + WS_WMDN + (size_t)e * 1024 * DFFE); c.Kd = DFFE; c.drow = c.n0; }
}
template <int WHICH> DI void conv_range(const Params& p, const Ctx& X, int first, int last, int hidx, int nh) {
    LAS float* scr = (LAS float*)(X.lds + X.wid * 16640);
    const int gw = hidx * 8 + X.wid, ngw = nh * 8;
    for (int it = first + gw; it < last; it += ngw) { ConvItem c; if (WHICH) conv_decode1(p, it, c); else conv_decode0(p, it, c); conv_tile<WHICH != 0>(c, scr, X.lane); }
}
template <int WHICH> DI void conv_phase(const Params& p, const Ctx& X) { conv_range<WHICH>(p, X, 0, WHICH ? CV_N1 : CV_N0, X.c, X.G); }
DI bool conv_split(const Ctx& X) { return X.G == 256; }

DI void adaln_phase(const Params& p, const Ctx& X) {
    LAS float* sc = (LAS float*)X.lds;
    LAS float* part = sc + 9 * 1024;
    float* mod = (float*)(p.ws + WS_MOD);
    for (int g = X.c; g < 256; g += X.G) {
        const int l = g >> 7, n0 = (g & 127) * 48;
        for (int i = X.tid; i < 9 * 1024; i += 512) { const int r = i >> 10, k = i & 1023; const float cv = r < 8 ? p.c[r * 1024 + k] : p.c_ctx[k]; sc[i] = cv * sigm(cv); }
        __syncthreads();
        const int kq = X.tid >> 4, jq = X.tid & 15;
        float acc[9][3];
#pragma unroll
        for (int r = 0; r < 9; ++r) { acc[r][0] = 0.f; acc[r][1] = 0.f; acc[r][2] = 0.f; }
        const float* w = p.w_ada + (size_t)l * 1024 * 6144 + n0 + jq;
        float wv[32][3];
#pragma unroll
        for (int i = 0; i < 32; ++i) { const int k = kq + 32 * i; wv[i][0] = w[(size_t)k * 6144]; wv[i][1] = w[(size_t)k * 6144 + 16]; wv[i][2] = w[(size_t)k * 6144 + 32]; }
#pragma unroll
        for (int i = 0; i < 32; ++i) { const int k = kq + 32 * i;
#pragma unroll
            for (int r = 0; r < 9; ++r) { const float s = sc[r * 1024 + k]; acc[r][0] += s * wv[i][0]; acc[r][1] += s * wv[i][1]; acc[r][2] += s * wv[i][2]; } }
#pragma unroll
        for (int r = 0; r < 9; ++r)
#pragma unroll
            for (int j = 0; j < 3; ++j) part[kq * 432 + r * 48 + j * 16 + jq] = acc[r][j];
        __syncthreads();
        if (X.tid < 432) { const int r = X.tid / 48, j = X.tid % 48; float s = 0.f;
#pragma unroll 8
            for (int q = 0; q < 32; ++q) s += part[q * 432 + X.tid];
            mod[(size_t)(l * 9 + r) * 6144 + n0 + j] = s + p.b_ada[l * 6144 + n0 + j]; }
        __syncthreads();
    }
}
DI void rope_phase(const Params& p, const Ctx& X) {
    f32x2* tab = (f32x2*)(p.ws + WS_ROPE);
    float* lbt = (float*)(p.ws + WS_LB);
    for (int i = X.c * 512 + X.tid; i < 2048; i += X.G * 512) { const int l = i >> 10, dir = (i >> 9) & 1, ch = i & 511;
        const float p0 = p.hgrn_lb[(dir * 2 + 0) * 512 + ch], p1 = p.hgrn_lb[(dir * 2 + 1) * 512 + ch]; lbt[i] = l == 0 ? 0.f : 1.f / (1.f + expf(p0 - p1)); }
    for (int i = X.c * 512 + X.tid; i < 1024; i += X.G * 512) { const int pos = i >> 4, pp = i & 15;
        const float freq = powf(10000.f, -(float)pp / 16.f), ang = (float)pos * freq; tab[i] = (f32x2){cosf(ang), sinf(ang)}; }
}

template <bool F8> DI void norm_row(const float* xr, const float* g, const float* shift, const float* scale, bf16_t* orow, int lane, f32x4 (&hv)[4]) {
    f32x4 v[4]; float ss = 0.f;
#pragma unroll
    for (int j = 0; j < 4; ++j) { v[j] = *(const f32x4*)(xr + j * 256 + lane * 4); ss += (v[j][0] * v[j][0] + v[j][1] * v[j][1]) + (v[j][2] * v[j][2] + v[j][3] * v[j][3]); }
    const float rstd = rsqrtf(wave_sum(ss) * (1.f / D) + EPS);
#pragma unroll
    for (int j = 0; j < 4; ++j) { const int c = j * 256 + lane * 4;
        const f32x4 gg = *(const f32x4*)(g + c), sh = *(const f32x4*)(shift + c), sc = *(const f32x4*)(scale + c);
        const f32x4 h = (v[j] * rstd * gg) * (sc + 1.0f) + sh; hv[j] = h;
        if constexpr (F8) *(unsigned*)((unsigned char*)orow + c) = pk4_fp8(h[0], h[1], h[2], h[3]);
        else { u32x2 w; w.x = pk2(h[0], h[1]); w.y = pk2(h[2], h[3]); *(u32x2*)(orow + c) = w; } }
}
DI void norm_phase(const Params& p, const Ctx& X, int l, int which, bool first, int nslab = 0) {
    const bool addslab = nslab > 0;
    const float* xl = first ? p.x : p.out; const float* xc = (first || (addslab && which == 1)) ? p.ctx : (const float*)(p.ws + WS_CTX);
    const float* g = (which ? p.g_norm2 : p.g_norm1) + l * D;
    const float* mod = (const float*)(p.ws + WS_MOD) + (size_t)l * 9 * 6144 + (which ? 3072 : 0);
    bf16_t* H = (bf16_t*)(p.ws + WS_H);
    const int rpb = (T + X.G - 1) / X.G, r0 = X.c * rpb, r1 = (r0 + rpb < T) ? r0 + rpb : T;
    f32x4 gg[4];
#pragma unroll
    for (int j = 0; j < 4; ++j) gg[j] = *(const f32x4*)(g + j * 256 + X.lane * 4);
    const bool remap = addslab && X.G == 256;
    auto rowmap = [&](int vr) { if (!remap) return vr; const int blk = vr / 136, o = vr - blk * 136;
        if (o < 128) { const int n = blk * 128 + o; return (n >> 12) * SB + CTXL + (n & 4095); } const int jc = blk * 8 + (o - 128); return (jc >> 8) * SB + (jc & 255); };
    for (int Rv = r0 + X.wid; Rv < r1; Rv += 16) {
        const int Rvb = (Rv + 8 < r1) ? Rv + 8 : Rv;
        const int R = rowmap(Rv), Rb = rowmap(Rvb);
        f32x4 v[2][4], sh[2][4], sc[2][4]; float ss[2] = {0.f, 0.f};
#pragma unroll
        for (int q = 0; q < 2; ++q) { const int Rq = q ? Rb : R; int b, s; row_bs(Rq, b, s); const bool isc = s < CTXL;
            const float* xr = isc ? xc + (size_t)(b * CTXL + s) * D : xl + (size_t)(b * SEQ + s - CTXL) * D;
            const float* mr = mod + (size_t)(isc ? 8 : b) * 6144;
#pragma unroll
            for (int j = 0; j < 4; ++j) { const int c = j * 256 + X.lane * 4; v[q][j] = *(const f32x4*)(xr + c); sh[q][j] = *(const f32x4*)(mr + c); sc[q][j] = *(const f32x4*)(mr + 1024 + c); } }
        if (addslab) {
#pragma unroll
            for (int q = 0; q < 2; ++q) { const int Rq = q ? Rb : R; int b, s; row_bs(Rq, b, s);
                if (s < CTXL) {
                    const bf16_t* sl = (const bf16_t*)(p.ws + (which ? WS_OPSLAB : WS_SLAB)) + (size_t)(b * CTXL + s) * D + X.lane * 4;
                    const float* gr = (const float*)(p.ws + WS_MOD) + (size_t)8 * 6144 + (which ? 2048 : 5120) + X.lane * 4;
                    u32x2 pw[8][4]; f32x4 gt[4];
#pragma unroll
                    for (int k = 0; k < 8; ++k)
#pragma unroll
                        for (int j = 0; j < 4; ++j) pw[k][j] = (k < nslab) ? *(const u32x2*)(sl + (size_t)k * (NBATCH * CTXL) * D + j * 256) : (u32x2){0u, 0u};
#pragma unroll
                    for (int j = 0; j < 4; ++j) gt[j] = *(const f32x4*)(gr + j * 256);
#pragma unroll
                    for (int j = 0; j < 4; ++j) { f32x4 sum = (f32x4){0.f, 0.f, 0.f, 0.f};
#pragma unroll
                        for (int k = 0; k < 8; ++k) sum = sum + (f32x4){bflo(pw[k][j].x), bfhi(pw[k][j].x), bflo(pw[k][j].y), bfhi(pw[k][j].y)};
                        v[q][j] = v[q][j] + gt[j] * sum;
                        if (which) *(f32x4*)((float*)(p.ws + WS_CTX) + (size_t)(b * CTXL + s) * D + j * 256 + X.lane * 4) = v[q][j]; }
                } }
        }
#pragma unroll
        for (int q = 0; q < 2; ++q)
#pragma unroll
            for (int j = 0; j < 4; ++j) ss[q] += (v[q][j][0] * v[q][j][0] + v[q][j][1] * v[q][j][1]) + (v[q][j][2] * v[q][j][2] + v[q][j][3] * v[q][j][3]);
#pragma unroll
        for (int o = 1; o < 64; o <<= 1) { const float a = __shfl_xor(ss[0], o), b2 = __shfl_xor(ss[1], o); ss[0] += a; ss[1] += b2; }
#pragma unroll
        for (int q = 0; q < 2; ++q) { const int Rq = q ? Rb : R; const float rstd = rsqrtf(ss[q] * (1.f / D) + EPS); bf16_t* orow = H + (size_t)Rq * D;
#pragma unroll
            for (int j = 0; j < 4; ++j) { const int c = j * 256 + X.lane * 4; const f32x4 h = (v[q][j] * rstd * gg[j]) * (sc[q][j] + 1.0f) + sh[q][j];
                u32x2 w; w.x = pk2(h[0], h[1]); w.y = pk2(h[2], h[3]); *(u32x2*)(orow + c) = w; } }
    }
}
DI void norm2_router_phase(const Params& p, const Ctx& X) {
    const int l = 1;
    const float* g = p.g_norm2 + l * D;
    const float* mod = (const float*)(p.ws + WS_MOD) + (size_t)l * 9 * 6144 + 3072;
    bf16_t* H = (bf16_t*)(p.ws + WS_H);
    LAS float* wr = (LAS float*)X.lds;
    LAS int* hist = (LAS int*)(X.lds + 32768);
    for (int i = X.tid; i < 8192; i += 512) wr[i] = p.moe_router[i];
    if (X.tid < 16) hist[X.tid] = 0;
    int* tokt = (int*)(p.ws + WS_TOK);
    for (int i = X.c * 512 + X.tid; i < MAXROWS_MOE; i += X.G * 512) tokt[i] = -1;
    __syncthreads();
    const int tpb = (NLAT + X.G - 1) / X.G, n0 = X.c * tpb, n1 = (n0 + tpb < NLAT) ? n0 + tpb : NLAT;
    f32x4* route = (f32x4*)(p.ws + WS_ROUTE);
    f32x4 gg[4];
#pragma unroll
    for (int j = 0; j < 4; ++j) gg[j] = *(const f32x4*)(g + j * 256 + X.lane * 4);
    for (int n = n0 + X.wid; n < n1; n += 16) {
        const int nb = (n + 8 < n1) ? n + 8 : n, nq = (nb == n) ? 1 : 2;
        f32x4 v[2][4], sh[2][4], sc[2][4]; float ss[2] = {0.f, 0.f};
#pragma unroll
        for (int q = 0; q < 2; ++q) { const int nn = q ? nb : n; const float* xr = p.out + (size_t)nn * D; const float* mr = mod + (size_t)(nn >> 12) * 6144;
#pragma unroll
            for (int j = 0; j < 4; ++j) { const int c = j * 256 + X.lane * 4; v[q][j] = *(const f32x4*)(xr + c); sh[q][j] = *(const f32x4*)(mr + c); sc[q][j] = *(const f32x4*)(mr + 1024 + c); } }
#pragma unroll
        for (int q = 0; q < 2; ++q)
#pragma unroll
            for (int j = 0; j < 4; ++j) ss[q] += (v[q][j][0] * v[q][j][0] + v[q][j][1] * v[q][j][1]) + (v[q][j][2] * v[q][j][2] + v[q][j][3] * v[q][j][3]);
#pragma unroll
        for (int o = 1; o < 64; o <<= 1) { const float a = __shfl_xor(ss[0], o), b2 = __shfl_xor(ss[1], o); ss[0] += a; ss[1] += b2; }
        float lg[2][8];
#pragma unroll
        for (int q = 0; q < 2; ++q) {
            const int nn = q ? nb : n; const float rstd = rsqrtf(ss[q] * (1.f / D) + EPS);
            unsigned char* orow = (unsigned char*)H + (size_t)((nn >> 12) * SB + CTXL + (nn & 4095)) * D;
#pragma unroll
            for (int j = 0; j < 4; ++j) { const f32x4 h = (v[q][j] * rstd * gg[j]) * (sc[q][j] + 1.0f) + sh[q][j]; v[q][j] = h;
                if (q < nq) *(unsigned*)(orow + j * 256 + X.lane * 4) = pk4_fp8(h[0], h[1], h[2], h[3]); }
#pragma unroll
            for (int e = 0; e < 8; ++e) lg[q][e] = 0.f;
        }
#pragma unroll
        for (int j = 0; j < 4; ++j)
#pragma unroll
            for (int i = 0; i < 4; ++i) { const LAS f32x4* wp = (const LAS f32x4*)(wr + (j * 256 + X.lane * 4 + i) * 8); const f32x4 w0 = wp[0], w1 = wp[1];
#pragma unroll
                for (int q = 0; q < 2; ++q) { const float h = v[q][j][i];
                    lg[q][0] += h * w0[0]; lg[q][1] += h * w0[1]; lg[q][2] += h * w0[2]; lg[q][3] += h * w0[3]; lg[q][4] += h * w1[0]; lg[q][5] += h * w1[1]; lg[q][6] += h * w1[2]; lg[q][7] += h * w1[3]; } }
#pragma unroll
        for (int o = 1; o < 64; o <<= 1)
#pragma unroll
            for (int q = 0; q < 2; ++q)
#pragma unroll
                for (int e = 0; e < 8; ++e) lg[q][e] += __shfl_xor(lg[q][e], o);
        for (int q = 0; q < nq; ++q) {
            int e1 = 0; float v1 = lg[q][0];
#pragma unroll
            for (int e = 1; e < 8; ++e) if (lg[q][e] > v1) { v1 = lg[q][e]; e1 = e; }
            int e2 = -1; float v2 = -3.0e38f;
#pragma unroll
            for (int e = 0; e < 8; ++e) if (e != e1 && lg[q][e] > v2) { v2 = lg[q][e]; e2 = e; }
            const float w2 = 1.f / (1.f + expf(v1 - v2)), w1 = 1.f - w2;
            if (X.lane == 0) { route[q ? nb : n] = (f32x4){__int_as_float(e1), __int_as_float(e2), w1, w2}; atomicAdd((int*)&hist[e1], 1); atomicAdd((int*)&hist[8 + e2], 1); }
        }
    }
    __syncthreads();
    if (X.tid < 16) ((int*)(p.ws + WS_HIST))[X.c * 16 + X.tid] = hist[X.tid];
}

DI void readout_phase(const Params& p, const Ctx& X, int l) {
    const bf16_t* OF = (const bf16_t*)(p.ws + WS_OF); bf16_t* OB = (bf16_t*)(p.ws + WS_OB); const bf16_t* OG = (const bf16_t*)(p.ws + WS_OG);
    const float* gn = p.hgrn_gnorm + l * 512 + X.lane * 8;
    const f32x4 g0 = *(const f32x4*)gn, g1 = *(const f32x4*)(gn + 4);
    const int rpb = (T + X.G - 1) / X.G, r0 = X.c * rpb, r1 = (r0 + rpb < T) ? r0 + rpb : T;
    for (int R = r0 + X.wid; R < r1; R += 16) {
        const int Rb = (R + 8 < r1) ? R + 8 : R;
        u32x4 a[2], bb[2], gg[2];
#pragma unroll
        for (int q = 0; q < 2; ++q) { const size_t o = (size_t)(q ? Rb : R) * 512 + X.lane * 8; a[q] = *(const u32x4*)(OF + o); bb[q] = *(const u32x4*)(OB + o); gg[q] = *(const u32x4*)(OG + o); }
        const int nq = (Rb == R) ? 1 : 2;
        for (int q = 0; q < nq; ++q) {
            const int Rq = q ? Rb : R;
            if (l == 1) { int b, s; row_bs(Rq, b, s); if (s < CTXL) continue; }
            float v[8], qv[8];
            v[0] = bflo(a[q].x) + bflo(bb[q].x); v[1] = bfhi(a[q].x) + bfhi(bb[q].x); v[2] = bflo(a[q].y) + bflo(bb[q].y); v[3] = bfhi(a[q].y) + bfhi(bb[q].y);
            v[4] = bflo(a[q].z) + bflo(bb[q].z); v[5] = bfhi(a[q].z) + bfhi(bb[q].z); v[6] = bflo(a[q].w) + bflo(bb[q].w); v[7] = bfhi(a[q].w) + bfhi(bb[q].w);
            qv[0] = bflo(gg[q].x); qv[1] = bfhi(gg[q].x); qv[2] = bflo(gg[q].y); qv[3] = bfhi(gg[q].y); qv[4] = bflo(gg[q].z); qv[5] = bfhi(gg[q].z); qv[6] = bflo(gg[q].w); qv[7] = bfhi(gg[q].w);
            float ss = 0.f;
#pragma unroll
            for (int i = 0; i < 8; ++i) ss += v[i] * v[i];
            ss += __shfl_xor(ss, 1); ss += __shfl_xor(ss, 2); ss += __shfl_xor(ss, 4); ss += __shfl_xor(ss, 8);
            const float rstd = rsqrtf(ss * (1.f / 128.f) + EPS);
            float y[8];
#pragma unroll
            for (int i = 0; i < 8; ++i) y[i] = v[i] * rstd * (i < 4 ? g0[i] : g1[i - 4]) * (qv[i] * sigm(qv[i]));
            u32x4 w; w.x = pk2(y[0], y[1]); w.y = pk2(y[2], y[3]); w.z = pk2(y[4], y[5]); w.w = pk2(y[6], y[7]);
            *(u32x4*)(OB + (size_t)Rq * 512 + X.lane * 8) = w;
        }
    }
}

DI void final_phase(const Params& p, const Ctx& X) {
    const bf16_t* y0 = (const bf16_t*)(p.ws + WS_Y0); const bf16_t* y1 = (const bf16_t*)(p.ws + WS_Y1);
    const float* gate = (const float*)(p.ws + WS_MOD) + (size_t)9 * 6144 + 5120;
    const int* posv = (const int*)(p.ws + WS_POS); const bf16_t* dslab = (const bf16_t*)(p.ws + WS_DSLAB);
    const int rpb = (NLAT + X.G - 1) / X.G, r0 = X.c * rpb, r1 = (r0 + rpb < NLAT) ? r0 + rpb : NLAT;
    f32x4 gf[4];
#pragma unroll
    for (int j = 0; j < 4; ++j) gf[j] = *(const f32x4*)(p.g_final + j * 256 + X.lane * 4);
    for (int n = r0 + X.wid; n < r1; n += 16) {
        const int nb = (n + 8 < r1) ? n + 8 : n;
        f32x4 v[2][4], gt[2][4]; u32x2 ya[2][4], yb[2][4]; float ss[2] = {0.f, 0.f};
#pragma unroll
        for (int q = 0; q < 2; ++q) { const int nq_ = q ? nb : n; const size_t o = (size_t)nq_ * D; const float* gr = gate + (size_t)(nq_ >> 12) * 6144;
#pragma unroll
            for (int j = 0; j < 4; ++j) { const int c = j * 256 + X.lane * 4; v[q][j] = *(const f32x4*)(p.out + o + c); ya[q][j] = *(const u32x2*)(y0 + o + c); yb[q][j] = *(const u32x2*)(y1 + o + c); gt[q][j] = *(const f32x4*)(gr + c); } }
#pragma unroll
        for (int q = 0; q < 2; ++q) { const int nq_ = q ? nb : n; const int p0 = posv[2 * nq_], p1 = posv[2 * nq_ + 1];
#pragma unroll
            for (int e = 0; e < 2; ++e) { const int pe = e ? p1 : p0;
                if (pe >= 65536) {
                    const bf16_t* sl = dslab + (size_t)(pe - 65536) * D + X.lane * 4;
                    u32x2 pw[4][4];
#pragma unroll
                    for (int k = 0; k < 4; ++k)
#pragma unroll
                        for (int j = 0; j < 4; ++j) pw[k][j] = *(const u32x2*)(sl + (size_t)k * 4096 * D + j * 256);
#pragma unroll
                    for (int j = 0; j < 4; ++j) { float s0 = 0.f, s1 = 0.f, s2 = 0.f, s3 = 0.f;
#pragma unroll
                        for (int k = 0; k < 4; ++k) { s0 += bflo(pw[k][j].x); s1 += bfhi(pw[k][j].x); s2 += bflo(pw[k][j].y); s3 += bfhi(pw[k][j].y); }
                        u32x2 o; o.x = pk2(s0, s1); o.y = pk2(s2, s3); if (e) yb[q][j] = o; else ya[q][j] = o; }
                } } }
#pragma unroll
        for (int q = 0; q < 2; ++q)
#pragma unroll
            for (int j = 0; j < 4; ++j) {
                const f32x4 ys = (f32x4){bflo(ya[q][j].x), bfhi(ya[q][j].x), bflo(ya[q][j].y), bfhi(ya[q][j].y)} + (f32x4){bflo(yb[q][j].x), bfhi(yb[q][j].x), bflo(yb[q][j].y), bfhi(yb[q][j].y)};
                v[q][j] = v[q][j] + gt[q][j] * ys;
                ss[q] += (v[q][j][0] * v[q][j][0] + v[q][j][1] * v[q][j][1]) + (v[q][j][2] * v[q][j][2] + v[q][j][3] * v[q][j][3]); }
#pragma unroll
        for (int o = 1; o < 64; o <<= 1) { const float a = __shfl_xor(ss[0], o), b2 = __shfl_xor(ss[1], o); ss[0] += a; ss[1] += b2; }
        const int nq = (nb == n) ? 1 : 2;
        for (int q = 0; q < nq; ++q) { const float rstd = rsqrtf(ss[q] * (1.f / D) + EPS); float* xr = p.out + (size_t)(q ? nb : n) * D;
#pragma unroll
            for (int j = 0; j < 4; ++j) *(f32x4*)(xr + j * 256 + X.lane * 4) = v[q][j] * rstd * gf[j]; }
    }
}

DI int crow(int r, int hi) { return (r & 3) + 8 * (r >> 2) + 4 * hi; }
DI void hgrn_phase(const Params& p, const Ctx& X, int l) {
    const bf16_t* P1 = (const bf16_t*)(p.ws + WS_P1);
    constexpr int BUFB = 54272;
    LAS unsigned char* SFb = X.lds + 2 * BUFB;
    const int tid = X.tid, lane = X.lane, wid = X.wid, l31 = lane & 31, hi = lane >> 5;
    const int pw = wid - 4;
    for (int un = X.c; un < 256; un += X.G) {
        const int unit = (X.G == 256) ? ((((un & 7) * 4 + (un >> 6)) << 3) | ((un >> 3) & 7)) : un;
        const int b = unit >> 5, h = (unit >> 3) & 3, dir = (unit >> 2) & 1, vs = unit & 3;
        bf16_t* O = (bf16_t*)(p.ws + (dir ? WS_OB : WS_OF));
        const size_t rowbase = (size_t)b * SB;
        auto srcrow = [&](int jp) -> int { return dir == 0 ? jp : (jp < CTXL ? (CTXL - 1 - jp) : (SB + CTXL - 1 - jp)); };
        struct Pref { u32x4 rl[4], rqv[4]; };
        Pref PA, PB;
        const int half = pw >> 1, khalf = pw & 1, sgn = dir ? -1 : 1;
        auto gload = [&](int c, Pref& P) {
            int ln = lane; asm volatile("" : "+v"(ln)); const int kch = ln & 7, tseg = ln >> 3;
            const size_t R0 = rowbase + srcrow(c * 64 + 32 * half + 4 * tseg); const bf16_t* rp = P1 + R0 * P1LD + h * 128 + 64 * khalf + 8 * kch;
#pragma unroll
            for (int i = 0; i < 4; ++i) { P.rl[i] = *(const u32x4*)(rp + (ptrdiff_t)(i * sgn) * P1LD + 512 + dir * 512); P.rqv[i] = *(const u32x4*)(rp + (ptrdiff_t)(i * sgn) * P1LD); }
        };
        constexpr int NCH = SB / 64;
        if (wid >= 4) {
            auto produce = [&](int c, Pref& P) {
                if (c < NCH) {
                    LAS unsigned char* B = X.lds + (c & 1) * BUFB;
#pragma unroll
                    for (int i = 0; i < 4; ++i) asm volatile("" : "+v"(P.rl[i]), "+v"(P.rqv[i]) :: "memory");
                    int ln = lane; asm volatile("" : "+v"(ln)); const int kch = ln & 7, tseg = ln >> 3;
                    const bool first = half == 0; const int sig = first ? 7 - tseg : tseg, sdir = first ? 8 : -8;
                    float f[4][8];
#pragma unroll
                    for (int i = 0; i < 4; ++i) { const unsigned w[4] = {P.rl[i].x, P.rl[i].y, P.rl[i].z, P.rl[i].w};
#pragma unroll
                        for (int e = 0; e < 8; ++e) f[i][e] = __builtin_amdgcn_exp2f((e & 1) ? bfhi(w[e >> 1]) : bflo(w[e >> 1])); }
                    u32x4 qraw[4];
#pragma unroll
                    for (int i = 0; i < 4; ++i) qraw[i] = P.rqv[i];
                    if (c + 2 < NCH) gload(c + 2, P);
                    float Xp[8], Tt[8], yy[8];
                    const int a1 = (ln + sdir) << 2, a2 = (ln + 2 * sdir) << 2, a4 = (ln + 4 * sdir) << 2;
#pragma unroll
                    for (int e = 0; e < 8; ++e) Tt[e] = (f[0][e] * f[1][e]) * (f[2][e] * f[3][e]);
#pragma unroll
                    for (int e = 0; e < 8; ++e) yy[e] = __int_as_float(__builtin_amdgcn_ds_bpermute(a1, __float_as_int(Tt[e])));
#pragma unroll
                    for (int e = 0; e < 8; ++e) Xp[e] = (sig >= 1) ? yy[e] : 1.f;
#pragma unroll
                    for (int e = 0; e < 8; ++e) yy[e] = __int_as_float(__builtin_amdgcn_ds_bpermute(a1, __float_as_int(Xp[e])));
#pragma unroll
                    for (int e = 0; e < 8; ++e) Xp[e] = (sig >= 1) ? Xp[e] * yy[e] : Xp[e];
#pragma unroll
                    for (int e = 0; e < 8; ++e) yy[e] = __int_as_float(__builtin_amdgcn_ds_bpermute(a2, __float_as_int(Xp[e])));
#pragma unroll
                    for (int e = 0; e < 8; ++e) Xp[e] = (sig >= 2) ? Xp[e] * yy[e] : Xp[e];
#pragma unroll
                    for (int e = 0; e < 8; ++e) yy[e] = __int_as_float(__builtin_amdgcn_ds_bpermute(a4, __float_as_int(Xp[e])));
#pragma unroll
                    for (int e = 0; e < 8; ++e) Xp[e] = (sig >= 4) ? Xp[e] * yy[e] : Xp[e];
                    if (sig == 7) {
                        LAS f32x4* ep = (LAS f32x4*)(B + 53248) + (128 * half + 64 * khalf + 8 * kch) / 4;
                        ep[0] = (f32x4){Xp[0] * Tt[0], Xp[1] * Tt[1], Xp[2] * Tt[2], Xp[3] * Tt[3]}; ep[1] = (f32x4){Xp[4] * Tt[4], Xp[5] * Tt[5], Xp[6] * Tt[6], Xp[7] * Tt[7]};
                    }
                    const int g16 = 4 * khalf + (kch >> 1), ka = kch & 1, sg = 2 * half + (tseg >> 2), sa = (tseg >> 1) & 1, sh = tseg & 1;
                    auto emit = [&](auto firstc) {
                        constexpr bool FIRST = decltype(firstc)::value;
#pragma unroll
                        for (int eh = 0; eh < 2; ++eh) {
                            float kt[4][4];
                            float esm[4][4], ebig[4][4];
#pragma unroll
                            for (int e4 = 0; e4 < 4; ++e4) { const int e = 4 * eh + e4;
                                if (FIRST) { esm[3][e4] = Xp[e]; esm[2][e4] = f[3][e] * esm[3][e4]; esm[1][e4] = f[2][e] * esm[2][e4]; esm[0][e4] = f[1][e] * esm[1][e4];
                                    ebig[0][e4] = __builtin_amdgcn_rcpf(fmaxf(esm[0][e4], 1e-30f)); ebig[1][e4] = ebig[0][e4] * f[1][e]; ebig[2][e4] = ebig[1][e4] * f[2][e]; ebig[3][e4] = ebig[2][e4] * f[3][e]; }
                                else { esm[0][e4] = f[0][e] * Xp[e]; esm[1][e4] = f[1][e] * esm[0][e4]; esm[2][e4] = f[2][e] * esm[1][e4]; esm[3][e4] = f[3][e] * esm[2][e4];
                                    ebig[3][e4] = __builtin_amdgcn_rcpf(fmaxf(esm[3][e4], 1e-30f)); ebig[2][e4] = ebig[3][e4] * f[3][e]; ebig[1][e4] = ebig[2][e4] * f[2][e]; ebig[0][e4] = ebig[1][e4] * f[1][e]; } }
#pragma unroll
                            for (int i = 0; i < 4; ++i) {
                                const unsigned qw0 = eh ? qraw[i].z : qraw[i].x, qw1 = eh ? qraw[i].w : qraw[i].y;
                                float qt[4];
#pragma unroll
                                for (int e4 = 0; e4 < 4; ++e4) { const int e = 4 * eh + e4;
                                    const float qq = (e4 == 0) ? bflo(qw0) : (e4 == 1) ? bfhi(qw0) : (e4 == 2) ? bflo(qw1) : bfhi(qw1);
                                    qt[e4] = qq * (FIRST ? ebig[i][e4] : esm[i][e4]); { const float F = FIRST ? esm[i][e4] : ebig[i][e4]; kt[i][e4] = __builtin_fmaf(-f[i][e], F, F); } }
                                const int t = 32 * half + 4 * tseg + i, o = t * 256 + (((2 * g16 + eh) ^ (t & 15)) << 4) + ka * 8;
                                u32x2 qv, kv; qv.x = pk2(qt[0], qt[1]); qv.y = pk2(qt[2], qt[3]); kv.x = pk2(kt[i][0], kt[i][1]); kv.y = pk2(kt[i][2], kt[i][3]);
                                *(LAS u32x2*)(B + o) = qv; *(LAS u32x2*)(B + 16384 + o) = kv;
                            }
#pragma unroll
                            for (int e4 = 0; e4 < 4; ++e4) { const int k = 64 * khalf + 8 * kch + 4 * eh + e4; u32x2 w2; w2.x = pk2(kt[0][e4], kt[1][e4]); w2.y = pk2(kt[2][e4], kt[3][e4]);
                                *(LAS u32x2*)(B + 32768 + k * 128 + (((2 * sg + sh) ^ ((k >> 1) & 7)) << 4) + sa * 8) = w2; }
                        }
                    };
                    if (first) emit(std::true_type{}); else emit(std::false_type{});
                }
            };
            static_assert(NCH % 2 == 0, "producer loop is unrolled by two");
            gload(0, PA); gload(1, PB);
            for (int c = 0; c < NCH; c += 2) { produce(c, PA); __syncthreads(); produce(c + 1, PB); __syncthreads(); }
            __syncthreads();
        } else if (wid < 2) {
            f32x16 S[2];
#pragma unroll
            for (int r = 0; r < 16; ++r) { S[0][r] = 0.f; S[1][r] = 0.f; }
            u32x4 rvv[2];
            auto vload = [&](int c) {
                int tq = tid; asm volatile("" : "+v"(tq));
#pragma unroll
                for (int j = 0; j < 2; ++j) { const int pc = tq + 128 * j; const size_t Rv = rowbase + srcrow(c * 64 + (pc >> 2));
                    rvv[j] = *(const u32x4*)(P1 + Rv * P1LD + 1536 + h * 128 + vs * 32 + (pc & 3) * 8); }
            };
            vload(0);
            for (int c = 0; c <= NCH; ++c) {
                if (c < NCH) {
                    asm volatile("" : "+v"(rvv[0]), "+v"(rvv[1]) :: "memory");
                    LAS unsigned char* Bw = X.lds + (c & 1) * BUFB;
                    int tq = tid; asm volatile("" : "+v"(tq));
#pragma unroll
                    for (int j = 0; j < 2; ++j) { const int pc = tq + 128 * j, s = pc >> 2, sl = s & 15, sa = sl >> 3, sh = (sl >> 2) & 1, si = sl & 3, sc = (s >> 4) * 2 + sh;
                        const unsigned w[4] = {rvv[j].x, rvv[j].y, rvv[j].z, rvv[j].w};
#pragma unroll
                        for (int e = 0; e < 8; ++e) { const int v = (pc & 3) * 8 + e; const bf16_t val = (bf16_t)((e & 1) ? (w[e >> 1] >> 16) : (w[e >> 1] & 0xffffu));
                            *(LAS bf16_t*)(Bw + 49152 + v * 128 + ((sc ^ ((v >> 1) & 7)) << 4) + (4 * sa + si) * 2) = val; } }
                    if (c + 1 < NCH) vload(c + 1);
                }
                if (c >= 1) {
                    const LAS unsigned char* B = X.lds + ((c - 1) & 1) * BUFB;
                    const LAS float* ERC = (const LAS float*)(B + 53248);
#pragma unroll
                    for (int j = 0; j < 2; ++j) {
                        const int kr = 32 * (2 * wid + j), k = kr + l31;
                        f32x16 W;
#pragma unroll
                        for (int g = 0; g < 4; ++g) { const f32x4 er = *(const LAS f32x4*)(ERC + kr + 8 * g + 4 * hi);
#pragma unroll
                            for (int i = 0; i < 4; ++i) W[4 * g + i] = S[j][4 * g + i] * er[i]; }
#pragma unroll
                        for (int ks = 0; ks < 4; ++ks) {
                            const bf16x8 ak = *(const LAS bf16x8*)(B + 32768 + k * 128 + (((2 * ks + hi) ^ ((k >> 1) & 7)) << 4));
                            const bf16x8 bv = *(const LAS bf16x8*)(B + 49152 + l31 * 128 + (((2 * ks + hi) ^ ((l31 >> 1) & 7)) << 4));
                            W = __builtin_amdgcn_mfma_f32_32x32x16_bf16(ak, bv, W, 0, 0, 0);
                        }
#pragma unroll
                        for (int g = 0; g < 4; ++g) { const f32x4 ec = *(const LAS f32x4*)(ERC + 128 + kr + 8 * g + 4 * hi);
#pragma unroll
                            for (int i = 0; i < 4; ++i) S[j][4 * g + i] = W[4 * g + i] * ec[i]; }
                    }
                }
                if (c < NCH) {
                    LAS unsigned char* SF = SFb + (c & 1) * 8192;
#pragma unroll
                    for (int j = 0; j < 2; ++j)
#pragma unroll
                        for (int s = 0; s < 2; ++s) { u32x4 aw; aw.x = pk2(S[j][8 * s], S[j][8 * s + 1]); aw.y = pk2(S[j][8 * s + 2], S[j][8 * s + 3]);
                            aw.z = pk2(S[j][8 * s + 4], S[j][8 * s + 5]); aw.w = pk2(S[j][8 * s + 6], S[j][8 * s + 7]);
                            *(LAS u32x4*)(SF + (((2 * wid + j) * 2 + s) * 64 + lane) * 16) = aw; }
                }
                __syncthreads();
            }
        } else {
            for (int c = 0; c <= NCH; ++c) {
                if (c >= 1) {
                    const LAS unsigned char* B = X.lds + ((c - 1) & 1) * BUFB;
                    const LAS float* ERC = (const LAS float*)(B + 53248);
                    const LAS unsigned char* SF = SFb + ((c - 1) & 1) * 8192;
                    const int tb = wid - 2, t = 32 * tb + l31;
                    f32x16 oacc;
#pragma unroll
                    for (int r = 0; r < 16; ++r) oacc[r] = 0.f;
                    for (int sb = 0; sb <= tb; ++sb) {
                        f32x16 at;
#pragma unroll
                        for (int r = 0; r < 16; ++r) at[r] = 0.f;
                        const int s = 32 * sb + l31;
#pragma unroll
                        for (int ks = 0; ks < 8; ++ks) {
                            const bf16x8 ak = *(const LAS bf16x8*)(B + 16384 + s * 256 + (((2 * ks + hi) ^ (s & 15)) << 4));
                            const bf16x8 bq = *(const LAS bf16x8*)(B + t * 256 + (((2 * ks + hi) ^ (t & 15)) << 4));
                            at = __builtin_amdgcn_mfma_f32_32x32x16_bf16(ak, bq, at, 0, 0, 0);
                        }
                        if (sb == tb) {
#pragma unroll
                            for (int r = 0; r < 16; ++r) at[r] = (crow(r, hi) <= l31) ? at[r] : 0.f;
                        }
#pragma unroll
                        for (int s2 = 0; s2 < 2; ++s2) {
                            u32x4 pw4; pw4.x = pk2(at[8 * s2], at[8 * s2 + 1]); pw4.y = pk2(at[8 * s2 + 2], at[8 * s2 + 3]); pw4.z = pk2(at[8 * s2 + 4], at[8 * s2 + 5]); pw4.w = pk2(at[8 * s2 + 6], at[8 * s2 + 7]);
                            const bf16x8 av = *(const LAS bf16x8*)(B + 49152 + l31 * 128 + ((((2 * sb + s2) * 2 + hi) ^ ((l31 >> 1) & 7)) << 4));
                            oacc = __builtin_amdgcn_mfma_f32_32x32x16_bf16(av, __builtin_bit_cast(bf16x8, pw4), oacc, 0, 0, 0);
                        }
                    }
#pragma unroll
                    for (int kb = 0; kb < 4; ++kb)
#pragma unroll
                        for (int s = 0; s < 2; ++s) {
                            const bf16x8 as = *(const LAS bf16x8*)(SF + ((kb * 2 + s) * 64 + lane) * 16);
                            const u32x4 bw = *(const LAS u32x4*)(B + t * 256 + ((((2 * kb + s) * 2 + hi) ^ (t & 15)) << 4));
                            const f32x4 e0 = *(const LAS f32x4*)(ERC + 32 * kb + 16 * s + 4 * hi), e1 = *(const LAS f32x4*)(ERC + 32 * kb + 16 * s + 8 + 4 * hi);
                            u32x4 bs; bs.x = pk2(bflo(bw.x) * e0[0], bfhi(bw.x) * e0[1]); bs.y = pk2(bflo(bw.y) * e0[2], bfhi(bw.y) * e0[3]);
                            bs.z = pk2(bflo(bw.z) * e1[0], bfhi(bw.z) * e1[1]); bs.w = pk2(bflo(bw.w) * e1[2], bfhi(bw.w) * e1[3]);
                            oacc = __builtin_amdgcn_mfma_f32_32x32x16_bf16(as, __builtin_bit_cast(bf16x8, bs), oacc, 0, 0, 0);
                        }
                    const size_t R = rowbase + srcrow((c - 1) * 64 + t);
                    bf16_t* orow = O + R * 512 + h * 128 + vs * 32 + 4 * hi;
#pragma unroll
                    for (int g = 0; g < 4; ++g) { u32x2 w2; w2.x = pk2(oacc[4 * g], oacc[4 * g + 1]); w2.y = pk2(oacc[4 * g + 2], oacc[4 * g + 3]); *(u32x2*)(orow + 8 * g) = w2; }
                }
                __syncthreads();
            }
        }
    }
}

DI void mlp_phase(const Params& p, const Ctx& X, int l) {
    const bf16_t* P1 = (const bf16_t*)(p.ws + WS_P1); bf16_t* YB = (bf16_t*)(p.ws + WS_YB);
    LAS unsigned char* vT = X.lds;
    const int tid = X.tid, lane = X.lane, wid = X.wid, hi = lane >> 5, l31 = lane & 31;
    const int nch = l ? 32 : 34, nunits = NBATCH * nch;
    for (int k = 0;; ++k) {
        const int u = k * X.G + (k == 0 ? X.c : X.G - 1 - X.c);
        if (u >= nunits) break;
        const int b = u / nch, ch = u % nch + (l ? 2 : 0);
        const size_t R0 = (size_t)b * SB + ch * 128;
        const int tok = tid >> 2, part = tid & 3;
        const bf16_t* vrow = P1 + (R0 + tok) * P1LD + 2560;
        u32x4 raw[4][4]; float ss = 0.f;
#pragma unroll
        for (int g = 0; g < 4; ++g)
#pragma unroll
            for (int q = 0; q < 4; ++q) raw[g][q] = *(const u32x4*)(vrow + g * 128 + part * 32 + q * 8);
#pragma unroll
        for (int g = 0; g < 4; ++g)
#pragma unroll
            for (int q = 0; q < 4; ++q) { const u32x4 r4 = raw[g][q];
                const float a0 = bflo(r4.x), a1 = bfhi(r4.x), a2 = bflo(r4.y), a3 = bfhi(r4.y), a4 = bflo(r4.z), a5 = bfhi(r4.z), a6 = bflo(r4.w), a7 = bfhi(r4.w);
                ss += (a0 * a0 + a1 * a1) + (a2 * a2 + a3 * a3) + (a4 * a4 + a5 * a5) + (a6 * a6 + a7 * a7); }
        ss += __shfl_xor(ss, 1); ss += __shfl_xor(ss, 2);
        const float rstd = rsqrtf(ss * (1.f / 512.f) + EPS);
        const int tblk = wid & 3, dp = wid >> 2;
#pragma unroll 1
        for (int g = 0; g < 4; ++g) {
#pragma unroll
            for (int q = 0; q < 4; ++q) {
                const int d0 = part * 32 + q * 8;
                const u32x4 r4 = raw[0][q];
                const float* vn = p.mlp_vnorm + l * 512 + g * 128 + d0;
                float a[8]; a[0] = bflo(r4.x); a[1] = bfhi(r4.x); a[2] = bflo(r4.y); a[3] = bfhi(r4.y); a[4] = bflo(r4.z); a[5] = bfhi(r4.z); a[6] = bflo(r4.w); a[7] = bfhi(r4.w);
#pragma unroll
                for (int e = 0; e < 8; ++e) { const int d = d0 + e; const unsigned w = pk2(a[e] * rstd * vn[e], 0.f);
                    *(LAS bf16_t*)(vT + g * 32768 + d * 256 + (((tok >> 3) ^ (d & 15)) << 4) + (tok & 7) * 2) = (bf16_t)(w & 0xffffu); }
            }
#pragma unroll
            for (int q = 0; q < 4; ++q) { raw[0][q] = raw[1][q]; raw[1][q] = raw[2][q]; raw[2][q] = raw[3][q]; }
        }
        __syncthreads();
#pragma unroll 1
        for (int g = 0; g < 4; ++g) {
            const float* wsr = p.mlp_ws + ((size_t)(l * 4 + g) * 128 + tblk * 32 + l31) * 128 + 8 * hi;
            f32x4 w0[8], w1[8];
#pragma unroll
            for (int ks = 0; ks < 8; ++ks) { w0[ks] = *(const f32x4*)(wsr + ks * 16); w1[ks] = *(const f32x4*)(wsr + ks * 16 + 4); }
            const int t = tblk * 32 + l31;
            const float bsv = p.mlp_bs[(l * 4 + g) * 128 + t];
            const bf16_t* urow = P1 + (R0 + t) * P1LD + 2048 + g * 128 + dp * 64 + 4 * hi;
            u32x2 uw[2][4];
#pragma unroll
            for (int j2 = 0; j2 < 2; ++j2)
#pragma unroll
                for (int rq = 0; rq < 4; ++rq) uw[j2][rq] = *(const u32x2*)(urow + j2 * 32 + rq * 8);
            f32x16 acc[2];
#pragma unroll
            for (int r = 0; r < 16; ++r) { acc[0][r] = 0.f; acc[1][r] = 0.f; }
            const LAS unsigned char* vTg = vT + g * 32768;
#pragma unroll
            for (int ks = 0; ks < 8; ++ks) {
                u32x4 aw; aw.x = pk2(w0[ks][0], w0[ks][1]); aw.y = pk2(w0[ks][2], w0[ks][3]); aw.z = pk2(w1[ks][0], w1[ks][1]); aw.w = pk2(w1[ks][2], w1[ks][3]);
                const bf16x8 Wf = __builtin_bit_cast(bf16x8, aw);
#pragma unroll
                for (int j2 = 0; j2 < 2; ++j2) { const int d = (dp * 2 + j2) * 32 + l31;
                    const bf16x8 Vf = *(const LAS bf16x8*)(vTg + d * 256 + (((2 * ks + hi) ^ (d & 15)) << 4));
                    acc[j2] = __builtin_amdgcn_mfma_f32_32x32x16_bf16(Vf, Wf, acc[j2], 0, 0, 0); }
            }
            bf16_t* yrow = YB + (R0 + t) * 512 + g * 128 + dp * 64 + 4 * hi;
#pragma unroll
            for (int j2 = 0; j2 < 2; ++j2)
#pragma unroll
                for (int rq = 0; rq < 4; ++rq) { const u32x2 u2 = uw[j2][rq]; u32x2 o;
                    o.x = pk2(bflo(u2.x) * (acc[j2][4 * rq] + bsv), bfhi(u2.x) * (acc[j2][4 * rq + 1] + bsv)); o.y = pk2(bflo(u2.y) * (acc[j2][4 * rq + 2] + bsv), bfhi(u2.y) * (acc[j2][4 * rq + 3] + bsv));
                    *(u32x2*)(yrow + j2 * 32 + rq * 8) = o; }
        }
        __syncthreads();
    }
}

typedef short v4i16_t __attribute__((ext_vector_type(4)));
DI s16x4 vtr(const LAS unsigned char* pp) { return __builtin_bit_cast(s16x4, __builtin_amdgcn_ds_read_tr16_b64_v4i16((LAS v4i16_t*)pp)); }
DI void glds16(const void* gsrc, unsigned lds_dst) { unsigned keep;
    asm volatile("s_mov_b32 %0, m0\n\ts_mov_b32 m0, %2\n\ts_nop 0\n\tglobal_load_lds_dwordx4 %1, off\n\ts_mov_b32 m0, %0" : "=&s"(keep) : "v"(gsrc), "s"(lds_dst) : "memory"); }
DI void attn_unit(const Params& p, const Ctx& X, int l, int b, int h, int s0, int kbeg, int nk, float lam, float lam_init) {
    const bf16_t* P1 = (const bf16_t*)(p.ws + WS_P1); bf16_t* YC = (bf16_t*)(p.ws + WS_YC);
    int ln_ = X.lane; asm volatile("" : "+v"(ln_));
    const int lane = ln_, wid = X.wid, hi = lane >> 5, l31 = lane & 31;
    const int cc = wid >> 2, qs = s0 + (wid & 3) * 32;
    const size_t rowbase = (size_t)b * SB;
    LAS unsigned char* Kbuf = X.lds;
    LAS unsigned char* Vbuf = X.lds + 65536;
    LAS float* Xb = (LAS float*)X.lds + (wid & 3) * 4096;
    bf16x8 bq[4];
    { const bf16_t* qp = P1 + (rowbase + qs + l31) * P1LD + 3072 + h * 128 + cc * 64 + 8 * hi;
#pragma unroll
      for (int s = 0; s < 4; ++s) bq[s] = *(const bf16x8*)(qp + 16 * s); }
    const bf16_t* kbase = P1 + (rowbase + kbeg) * P1LD + 3584 + h * 128;
    const int krow = 8 * wid + (lane >> 3), kch = (lane & 7) ^ ((krow >> 1) & 7);
    const unsigned koff = (unsigned)(krow * P1LD + kch * 8) * 2u;
    const unsigned voff0 = (unsigned)((((wid & 3) * 16 + (lane >> 2)) * P1LD) + 512 + (wid >> 2) * 32 + (lane & 3) * 8) * 2u;
    const unsigned kl0 = (unsigned)(size_t)Kbuf + wid * 1024, vl0 = (unsigned)(size_t)Vbuf + wid * 1024;
    auto dma_k = [&](int kt, int slot) {
        const char* g = (const char*)(kbase + (size_t)kt * 64 * P1LD);
#pragma unroll
        for (int c2 = 0; c2 < 2; ++c2) glds16(g + koff + c2 * 128, (unsigned)__builtin_amdgcn_readfirstlane((int)(kl0 + slot * 16384 + c2 * 8192)));
    };
    auto dma_v = [&](int kt, int slot) {
        const char* g = (const char*)(kbase + (size_t)kt * 64 * P1LD);
#pragma unroll
        for (int j = 0; j < 2; ++j) glds16(g + voff0 + j * 128, (unsigned)__builtin_amdgcn_readfirstlane((int)(vl0 + slot * 16384 + j * 8192)));
    };
    f32x16 negm;
#pragma unroll
    for (int r = 0; r < 16; ++r) negm[r] = 0.f;
    auto qk = [&](f32x16 (&st)[2], int slot) {
        const LAS unsigned char* Kb = Kbuf + slot * 16384 + cc * 8192;
#pragma unroll
        for (int kb = 0; kb < 2; ++kb) {
            const int row = 32 * kb + l31;
#pragma unroll
            for (int s = 0; s < 4; ++s) { const bf16x8 a = *(const LAS bf16x8*)(Kb + row * 128 + (((2 * s + hi) ^ ((row >> 1) & 7)) << 4));
                if (s == 0) st[kb] = __builtin_amdgcn_mfma_f32_32x32x16_bf16(a, bq[s], negm, 0, 0, 0);
                else st[kb] = __builtin_amdgcn_mfma_f32_32x32x16_bf16(a, bq[s], st[kb], 0, 0, 0); }
        }
    };
    float lsum = 0.f;
    f32x16 ot[4];
#pragma unroll
    for (int k = 0; k < 4; ++k)
#pragma unroll
        for (int r = 0; r < 16; ++r) ot[k][r] = 0.f;
    const int vbase = (4 * hi + ((lane & 15) >> 2)) * 64 + ((lane >> 4) & 1) * 32 + (lane & 3) * 8;
    f32x16 sc[2];
    u32x4 pfw[4];
    bf16x8 vf[4][4];
    auto softmax_seg = [&](const bool first, const int vslot) {
        { const LAS unsigned char* Vb = Vbuf + vslot * 16384 + vbase;
#pragma unroll
          for (int ks = 0; ks < 4; ++ks)
#pragma unroll
            for (int blk = 0; blk < 4; ++blk) { const s16x4 lo = vtr(Vb + (blk * 4 + ks) * 1024), hh = vtr(Vb + (blk * 4 + ks) * 1024 + 512);
                vf[ks][blk] = (bf16x8){lo[0], lo[1], lo[2], lo[3], hh[0], hh[1], hh[2], hh[3]}; } }
        float mx = sc[0][0];
#pragma unroll
        for (int r = 0; r < 16; ++r) { mx = fmaxf(mx, sc[0][r]); mx = fmaxf(mx, sc[1][r]); }
        if (first || __any(mx > 8.0f)) {
            mx = fmaxf(mx, __shfl_xor(mx, 32));
            const float d = first ? mx : fmaxf(mx, 0.f), alpha = __builtin_amdgcn_exp2f(-d);
            lsum *= alpha;
#pragma unroll
            for (int k = 0; k < 4; ++k)
#pragma unroll
                for (int r = 0; r < 16; ++r) ot[k][r] *= alpha;
#pragma unroll
            for (int r = 0; r < 16; ++r) { sc[0][r] -= d; sc[1][r] -= d; negm[r] -= d; }
        }
        float ps = 0.f;
#pragma unroll
        for (int kb = 0; kb < 2; ++kb)
#pragma unroll
            for (int r = 0; r < 16; ++r) { const float e = __builtin_amdgcn_exp2f(sc[kb][r]); sc[kb][r] = e; ps += e; }
        lsum += ps;
#pragma unroll
        for (int ks = 0; ks < 4; ++ks) { const int kb = ks >> 1, s2 = ks & 1;
            pfw[ks].x = pk2(sc[kb][8 * s2 + 0], sc[kb][8 * s2 + 1]); pfw[ks].y = pk2(sc[kb][8 * s2 + 2], sc[kb][8 * s2 + 3]);
            pfw[ks].z = pk2(sc[kb][8 * s2 + 4], sc[kb][8 * s2 + 5]); pfw[ks].w = pk2(sc[kb][8 * s2 + 6], sc[kb][8 * s2 + 7]); }
    };
    auto matrix_seg = [&](int tqk) {
        bf16x8 ak[2][4];
        { const LAS unsigned char* Kb = Kbuf + (tqk & 3) * 16384 + cc * 8192;
#pragma unroll
          for (int kb = 0; kb < 2; ++kb) { const int row = 32 * kb + l31;
#pragma unroll
            for (int s = 0; s < 4; ++s) ak[kb][s] = *(const LAS bf16x8*)(Kb + row * 128 + (((2 * s + hi) ^ ((row >> 1) & 7)) << 4)); } }
#pragma unroll
        for (int ks = 0; ks < 4; ++ks) { const bf16x8 pf = __builtin_bit_cast(bf16x8, pfw[ks]);
#pragma unroll
            for (int blk = 0; blk < 4; ++blk) ot[blk] = __builtin_amdgcn_mfma_f32_32x32x16_bf16(vf[ks][blk], pf, ot[blk], 0, 0, 0); }
#pragma unroll
        for (int kb = 0; kb < 2; ++kb) {
            sc[kb] = __builtin_amdgcn_mfma_f32_32x32x16_bf16(ak[kb][0], bq[0], negm, 0, 0, 0);
#pragma unroll
            for (int s = 1; s < 4; ++s) sc[kb] = __builtin_amdgcn_mfma_f32_32x32x16_bf16(ak[kb][s], bq[s], sc[kb], 0, 0, 0);
        }
    };
#pragma unroll
    for (int ks = 0; ks < 4; ++ks) pfw[ks] = (u32x4){0u, 0u, 0u, 0u};
    dma_k(0, 0); dma_v(0, 0); dma_k(1, 1);
    dma_k(2, 2); dma_v(1, 1);
    dma_k(3, 3); dma_v(2, 2);
    asm volatile("s_waitcnt vmcnt(8)" ::: "memory"); __builtin_amdgcn_s_barrier();
    if (cc == 0) qk(sc, 0);
    int nprev = 4;
    auto odd_issue = [&](int t, int& ncur) { ncur = 0; if (t + 4 < nk) { dma_k(t + 4, t & 3); ncur += 2; } if (t + 3 < nk) { dma_v(t + 3, (t + 3) & 3); ncur += 2; } };
    auto odd_wait = [&](int ncur) {
        const int keep = ncur + nprev; nprev = ncur;
        if (keep == 8) asm volatile("s_waitcnt vmcnt(8) lgkmcnt(0)" ::: "memory"); else if (keep == 6) asm volatile("s_waitcnt vmcnt(6) lgkmcnt(0)" ::: "memory");
        else if (keep == 4) asm volatile("s_waitcnt vmcnt(4) lgkmcnt(0)" ::: "memory"); else if (keep == 2) asm volatile("s_waitcnt vmcnt(2) lgkmcnt(0)" ::: "memory");
        else asm volatile("s_waitcnt vmcnt(0) lgkmcnt(0)" ::: "memory");
        __builtin_amdgcn_s_barrier(); };
    auto even_end = [&]() { asm volatile("s_waitcnt lgkmcnt(0)" ::: "memory"); __builtin_amdgcn_s_barrier(); };
    if (cc == 0) {
#pragma clang loop unroll(disable)
        for (int t = 0; t < nk; ++t) {
            softmax_seg(t == 0, t & 3); even_end();
            int nc; odd_issue(t, nc); matrix_seg(t + 1); odd_wait(nc);
        }
        even_end();
    } else {
        qk(sc, 0); even_end();
#pragma clang loop unroll(disable)
        for (int t = 0; t < nk; ++t) {
            int nc; odd_issue(t, nc); softmax_seg(t == 0, t & 3); odd_wait(nc);
            matrix_seg(t + 1); even_end();
        }
    }
    const float ltot = lsum + __shfl_xor(lsum, 32), inv = 1.f / ltot;
    if (cc == 1) {
#pragma unroll
        for (int k = 0; k < 4; ++k)
#pragma unroll
            for (int r = 0; r < 16; ++r) Xb[(k * 16 + r) * 64 + lane] = ot[k][r] * inv;
    }
    __syncthreads();
    if (cc == 0) {
        float ss = 0.f;
#pragma unroll
        for (int k = 0; k < 4; ++k)
#pragma unroll
            for (int r = 0; r < 16; ++r) { const float o = ot[k][r] * inv - lam * Xb[(k * 16 + r) * 64 + lane]; ot[k][r] = o; ss += o * o; }
        ss += __shfl_xor(ss, 32);
        const float scl = rsqrtf(ss * (1.f / 128.f) + EPS) * (1.f - lam_init);
        bf16_t* yrow = YC + (rowbase + qs + l31) * 512 + h * 128;
        const float* gsub = p.diff_subln + l * 512 + h * 128;
#pragma unroll
        for (int k = 0; k < 4; ++k)
#pragma unroll
            for (int r4 = 0; r4 < 4; ++r4) { const int dv = 32 * k + 8 * r4 + 4 * hi; const f32x4 gg = *(const f32x4*)(gsub + dv);
                u32x2 w; w.x = pk2(ot[k][4 * r4] * scl * gg[0], ot[k][4 * r4 + 1] * scl * gg[1]); w.y = pk2(ot[k][4 * r4 + 2] * scl * gg[2], ot[k][4 * r4 + 3] * scl * gg[3]);
                *(u32x2*)(yrow + dv) = w; }
    }
    __syncthreads();
}
DI void attn_phase(const Params& p, const Ctx& X, int l) {
    const float lam_init = 0.8f - 0.6f * expf(-0.3f * (float)l);
    LAS float* misc = (LAS float*)(X.lds + LDS_MISC);
    if (X.wid == 0) { const float* lp = p.diff_lambda + l * 256; float a = lp[X.lane] * lp[64 + X.lane], b2 = lp[128 + X.lane] * lp[192 + X.lane];
        a = wave_sum(a); b2 = wave_sum(b2); if (X.lane == 0) misc[0] = expf(a) - expf(b2) + lam_init; }
    __syncthreads();
    const float lam = misc[0];
    const int nlat = (1024 - X.c + X.G - 1) / X.G, nctx = (l == 0 && X.c < 64) ? (64 - X.c + X.G - 1) / X.G : 0;
    for (int it = 0; it < nlat + nctx; ++it) {
        int b, h, s0, nk;
        if (it < nlat) {
            int bh, qb;
            if (X.G == 256) { bh = 4 * (X.c & 7) + it; qb = X.c >> 3; } else { const int U = it * X.G + X.c; bh = U >> 5; qb = U & 31; }
            b = bh >> 2; h = bh & 3; s0 = CTXL + qb * 128; nk = SB / 64;
        } else { const int U = (it - nlat) * X.G + X.c; b = U >> 3; h = (U >> 1) & 3; s0 = (U & 1) * 128; nk = CTXL / 64; }
        attn_unit(p, X, l, b, h, s0, 0, nk, lam, lam_init);
    }
}

DI void moe_scatter_phase(const Params& p, const Ctx& X) {
    LAS int* tot = (LAS int*)X.lds;
    LAS int* e1s = tot + 64;
    LAS int* e2s = e1s + 128;
    LAS int* pos0 = e2s + 128;
    LAS int* pos1 = pos0 + 128;
    const int* hist = (const int*)(p.ws + WS_HIST);
    const int tid = X.tid;
    LAS int* hl = tot + 1024;
    LAS int* ps = hl + 4096;
    for (int i = tid; i < X.G * 4; i += 512) ((LAS u32x4*)hl)[i] = ((const u32x4*)hist)[i];
    __syncthreads();
    { const int g = tid & 15, part = tid >> 4; int t = 0, mb = 0;
#pragma unroll
        for (int k = 0; k < 8; ++k) { const int cb = part * 8 + k; if (cb < X.G) { const int v = hl[cb * 16 + g]; t += v; mb += (cb < X.c) ? v : 0; } }
        ps[part * 32 + g] = t; ps[part * 32 + 16 + g] = mb; }
    __syncthreads();
    if (tid < 16) { int t = 0, mb = 0;
        for (int part = 0; part < 32; ++part) { t += ps[part * 32 + tid]; mb += ps[part * 32 + 16 + tid]; }
        tot[tid] = t; tot[16 + tid] = mb; }
    __syncthreads();
    if (tid == 0) { int tb = 0; for (int g = 0; g < 16; ++g) { tot[32 + g] = tb; tot[48 + g] = tb * 256; tb += (tot[g] + 255) >> 8; }
        if (X.c == 0) { int* grp = (int*)(p.ws + WS_GRP); for (int g = 0; g < 16; ++g) { grp[g] = tot[32 + g]; grp[16 + g] = (tot[g] + 255) >> 8; } } }
    const int tpb = (NLAT + X.G - 1) / X.G, n0 = X.c * tpb, n1 = (n0 + tpb < NLAT) ? n0 + tpb : NLAT, cnt = n1 - n0;
    const f32x4* route = (const f32x4*)(p.ws + WS_ROUTE);
    f32x4 rt = (f32x4){0.f, 0.f, 0.f, 0.f};
    if (tid < cnt) { rt = route[n0 + tid]; e1s[tid] = __float_as_int(rt[0]); e2s[tid] = __float_as_int(rt[1]); }
    __syncthreads();
    if (tid < cnt) {
        const int e1 = __float_as_int(rt[0]), e2 = __float_as_int(rt[1]); int r0 = 0, r1 = 0;
        for (int j = 0; j < tid; ++j) { r0 += (e1s[j] == e1) ? 1 : 0; r1 += (e2s[j] == e2) ? 1 : 0; }
        const int q0 = tot[48 + e1] + tot[16 + e1] + r0, q1 = tot[48 + 8 + e2] + tot[16 + 8 + e2] + r1;
        pos0[tid] = q0; pos1[tid] = q1;
        ((int*)(p.ws + WS_POS))[2 * (n0 + tid)] = q0; ((int*)(p.ws + WS_POS))[2 * (n0 + tid) + 1] = q1;
        int* tokt = (int*)(p.ws + WS_TOK); float* wrow = (float*)(p.ws + WS_WROW);
        tokt[q0] = n0 + tid; wrow[q0] = rt[2]; tokt[q1] = n0 + tid; wrow[q1] = rt[3];
    }
    __syncthreads();
    const unsigned char* H = p.ws + WS_H; unsigned char* Xs = p.ws + WS_XS;
    for (int j = X.wid; j < cnt; j += 32) {
        u32x4 v0[4];
#pragma unroll
        for (int q = 0; q < 4; ++q) { const int jq = j + 8 * q; if (jq < cnt) { const int n = n0 + jq, b = n >> 12, t = n & 4095; const size_t R = (size_t)b * SB + CTXL + t; v0[q] = *(const u32x4*)(H + R * D + X.lane * 16); } }
#pragma unroll
        for (int q = 0; q < 4; ++q) { const int jq = j + 8 * q; if (jq < cnt) { *(u32x4*)(Xs + (size_t)pos0[jq] * D + X.lane * 16) = v0[q]; *(u32x4*)(Xs + (size_t)pos1[jq] * D + X.lane * 16) = v0[q]; } }
    }
}
DI void moe_order_setup(const Params& p, const Ctx& X, int g0, int ng, int npn, LAS int* tab) {
    const int* grp = (const int*)(p.ws + WS_GRP);
    if (X.tid == 0) { int cu = 0; for (int j = 0; j < ng; ++j) { tab[j] = cu; cu += grp[16 + g0 + j] * npn; tab[32 + j] = grp[g0 + j]; } tab[ng] = cu; }
    __syncthreads();
}

#define XB_TMO      128
#define XB_XCNT(j)  (256  + 64 * (j))
#define XB_XSUB(j)  (1280 + 64 * (j))
#define XB_XGEN(j)  (2304 + 64 * (j))
#define XB_TOP      3328
#define XB_TOPGEN   3392
#define XCD_BAR_WORDS 3456
#define XB_SPIN_CAP (1u << 18)
__device__ __forceinline__ unsigned xb_ld(unsigned* p)              { return __hip_atomic_load(p, __ATOMIC_RELAXED, __HIP_MEMORY_SCOPE_AGENT); }
__device__ __forceinline__ unsigned xb_add(unsigned* p, unsigned v) { return __hip_atomic_fetch_add(p, v, __ATOMIC_RELAXED, __HIP_MEMORY_SCOPE_AGENT); }
__device__ __forceinline__ unsigned xb_xcc_id() { return (unsigned)__builtin_amdgcn_s_getreg((3 << 11) | 20) & 0xFu; }
#define XB_SPIN(cond, bar) do { unsigned _sp = 0; while (cond) { __builtin_amdgcn_s_sleep(1); \
    if ((++_sp & 255u) == 0u) { if (xb_ld(&(bar)[XB_TMO])) break; if (_sp > XB_SPIN_CAP) { atomicAdd(&(bar)[XB_TMO], 1u); break; } } } } while (0)
struct XcdBarrier { unsigned* bar; unsigned x; volatile LAS unsigned* st; };
__device__ __forceinline__ XcdBarrier xcd_barrier_post(unsigned* bar, volatile LAS unsigned* st) {
    XcdBarrier b; b.bar = bar; b.x = xb_xcc_id(); b.st = st;
    if (threadIdx.x == 0) (void)xb_add(&bar[XB_XCNT(b.x)], 1u);
    return b;
}
__device__ __forceinline__ void xcd_barrier_complete(unsigned* bar, unsigned x, unsigned& nloc, unsigned& nx) {
    const unsigned G = gridDim.x * gridDim.y * gridDim.z;
    unsigned sum, cnt, mine, sp = 0u;
    for (;;) {
        sum = 0u; cnt = 0u; mine = 0u;
#pragma unroll 1
        for (unsigned j = 0; j < 16; ++j) { const unsigned c = xb_ld(&bar[XB_XCNT(j)]); sum += c; cnt += (c > 0u) ? 1u : 0u; mine = (j == x) ? c : mine; }
        if (sum == G) break;
        __builtin_amdgcn_s_sleep(1);
        if ((++sp & 255u) == 0u) { if (xb_ld(&bar[XB_TMO])) break; if (sp > XB_SPIN_CAP) { atomicAdd(&bar[XB_TMO], 1u); break; } }
    }
    nloc = mine > 0u ? mine : 1u; nx = cnt > 0u ? cnt : 1u;
}
__device__ __forceinline__ void xcd_barrier(const XcdBarrier& b) {
    asm volatile("s_waitcnt vmcnt(0)" ::: "memory");
    __syncthreads();
    if (threadIdx.x == 0) {
        unsigned* bar = b.bar;
        __builtin_amdgcn_s_waitcnt(0);
        unsigned nloc = b.st[0], nx = b.st[1];
        if (nloc == 0u) { xcd_barrier_complete(bar, b.x, nloc, nx); b.st[0] = nloc; b.st[1] = nx; }
        const unsigned old = xb_add(&bar[XB_XSUB(b.x)], 1u);
        const unsigned gen = old / nloc;
        if (old + 1u == (gen + 1u) * nloc) {
            __builtin_amdgcn_fence(__ATOMIC_RELEASE, "agent");
            asm volatile("s_waitcnt vmcnt(0)" ::: "memory");
            const unsigned og = xb_add(&bar[XB_TOP], 1u);
            const unsigned tg = og / nx;
            if (og + 1u == (tg + 1u) * nx) xb_add(&bar[XB_TOPGEN], 1u);
            else XB_SPIN(xb_ld(&bar[XB_TOPGEN]) == tg, bar);
            __builtin_amdgcn_fence(__ATOMIC_ACQUIRE, "agent");
            xb_add(&bar[XB_XGEN(b.x)], 1u);
            asm volatile("s_waitcnt vmcnt(0)" ::: "memory");
        } else {
            XB_SPIN(xb_ld(&bar[XB_XGEN(b.x)]) == gen, bar);
            __builtin_amdgcn_fence(__ATOMIC_ACQUIRE, "agent");
            asm volatile("s_waitcnt vmcnt(0)" ::: "memory");
        }
    }
    __syncthreads();
}

constexpr int NPHASE = 21;
__global__ void __launch_bounds__(512, 2) mega(Params p) {
    extern __shared__ __attribute__((aligned(16))) unsigned char smem[];
    Ctx X; X.lds = (LAS unsigned char*)smem; X.tid = threadIdx.x; X.lane = X.tid & 63; X.wid = __builtin_amdgcn_readfirstlane(X.tid >> 6); X.G = gridDim.x; X.c = blockIdx.x; X.ws = p.ws;
    volatile LAS unsigned* barw = (volatile LAS unsigned*)(X.lds + LDS_BARW);
    if (X.tid < 4) barw[X.tid] = 0u;
    __syncthreads();
    XcdBarrier bar; bar.bar = (unsigned*)(p.ws + WS_CTL); bar.x = 0; bar.st = barw;
    const int lo = p.lo, hi = p.hi;
    long long tp0 = 0; if (TP_HIT(0)) tp0 = wall_clock64();
    if (hi - lo > 1) bar = xcd_barrier_post((unsigned*)(p.ws + WS_CTL), barw);
#define IN(k) (lo <= (k) && (k) < hi)
#define FRESH() do { int t_ = threadIdx.x; asm volatile("" : "+v"(t_)); X.tid = t_; X.lane = t_ & 63; X.wid = __builtin_amdgcn_readfirstlane(t_ >> 6); } while (0)
#define EN(s) (((EN_MASK) >> (s)) & 1)
#define NREP(s) ((((REP_MASK) >> (s)) & 1) ? 2 : 1)
#define TP_SPIN(dt) do { const long long t1_ = wall_clock64(); const long long w_ = (long long)(TP_MULT) * (dt); while (wall_clock64() - t1_ < w_) __builtin_amdgcn_s_sleep(16); } while (0)
#define SEAM(k) do { if (IN(k) && IN((k) + 1)) { xcd_barrier(bar); if (TP_HIT(k)) { const long long d_ = wall_clock64() - tp0; TP_SPIN(d_); xcd_barrier(bar); } if (TP_HIT((k) + 1)) tp0 = wall_clock64(); } } while (0)
#define TP_WRAP(sub, ll, call) do { long long s0_ = 0; if (TP_SUB == (sub) && TP_SUBL == (ll)) s0_ = wall_clock64(); call; if (TP_SUB == (sub) && TP_SUBL == (ll)) { const long long d_ = wall_clock64() - s0_; TP_SPIN(d_); } } while (0)
#define SITE_PTRS() unsigned char* ws = p.ws; asm volatile("" : "+s"(ws)); float* mod = (float*)(ws + WS_MOD); bf16_t* Hb = (bf16_t*)(ws + WS_H); (void)mod; (void)Hb

    if (EN(0) && IN(0)) { FRESH(); if (conv_split(X)) conv_range<0>(p, X, 0, 2048, X.c, X.G); else conv_phase<0>(p, X); __syncthreads(); if (NREP(0) == 2) { conv_phase<0>(p, X); __syncthreads(); } adaln_phase(p, X); rope_phase(p, X); __syncthreads(); }
    SEAM(0);
    auto layer = [&](auto lc) {
        constexpr int l = decltype(lc)::value;
        const int pb = 1 + 9 * l;
        if (EN(1) && IN(pb + 0)) for (int rep = 0; rep < NREP(1); ++rep) { FRESH(); norm_phase(p, X, l, 0, l == 0, l == 1 ? 8 : 0); }
        SEAM(pb + 0);
        if (EN(2) && IN(pb + 1)) {
            SITE_PTRS(); const bf16_t* Win = (const bf16_t*)(ws + WS_WIN) + (size_t)l * 8192 * 1024;
            pg8::Gemm g{Hb, Win, 1024}; TileOrder S; S.init(NMT, 20, X.G, X.c, 0, 0); S.reps = NREP(2);
            LAS float* ropeL = (LAS float*)(X.lds + 131072); LAS float* lbL = (LAS float*)(X.lds + LDS_MISC + 2048);
            __syncthreads();
            for (int i = threadIdx.x; i < 2048; i += 512) ropeL[i] = ((const float*)(ws + WS_ROPE))[i];
            for (int i = threadIdx.x; i < 1024; i += 512) lbL[i] = ((const float*)(ws + WS_LB))[l * 1024 + i];
            __syncthreads();
            EpiInproj E{(bf16_t*)(ws + WS_P1), (bf16_t*)(ws + WS_OG), (const LAS f32x2*)ropeL, (const LAS float*)lbL};
            pg8::gemm_phase<EpiInproj, TileOrder>(X.lds, g, S, E);
            if constexpr (l == 0) { if (conv_split(X) && X.c >= 160) { FRESH(); conv_range<0>(p, X, CV_WIN, CV_N0, X.c - 160, 96); } }
        }
        SEAM(pb + 1);
        if (IN(pb + 2)) { if (EN(3)) for (int rep = 0; rep < NREP(3); ++rep) { FRESH(); TP_WRAP(1, l, hgrn_phase(p, X, l)); } __syncthreads(); if (EN(4)) for (int rep = 0; rep < NREP(4); ++rep) { FRESH(); TP_WRAP(2, l, mlp_phase(p, X, l)); } __syncthreads(); if (EN(5)) for (int rep = 0; rep < NREP(5); ++rep) { FRESH(); TP_WRAP(3, l, attn_phase(p, X, l)); } }
        SEAM(pb + 2);
        if (EN(6) && IN(pb + 3)) {
            SITE_PTRS(); const bf16_t* Win = (const bf16_t*)(ws + WS_WIN) + (size_t)l * 8192 * 1024;
            FRESH(); readout_phase(p, X, l);
            pg8::Gemm g{Hb, Win, 1024}; TileOrder S; S.init(l ? 128 : NMT, 12, X.G, X.c, l, 20);
            EpiStore<1> E{(bf16_t*)(ws + WS_G), 3072};
            S.reps = NREP(6); pg8::gemm_phase<EpiStore<1>, TileOrder>(X.lds, g, S, E);
            if constexpr (l == 0) { if (conv_split(X) && X.c >= 96) { FRESH(); conv_range<0>(p, X, 2048, CV_WIN, X.c - 96, 160); } }
        }
        SEAM(pb + 3);
        if (EN(7) && IN(pb + 4)) for (int rep = 0; rep < NREP(7); ++rep) {
            SITE_PTRS();
            pg8::Gemm g{(const bf16_t*)(ws + WS_OB), (const bf16_t*)(ws + WS_WBR) + (size_t)l * 3 * 1024 * 512, 512};
            MergeOrder S; S.t.init(128, 4, X.G, X.c, 1, 0); S.nctx = l ? 0 : 32;
            EpiMerge E{(bf16_t*)(ws + WS_MRG), (const bf16_t*)(ws + WS_G)};
            pg8::gemm_phase<EpiMerge, MergeOrder, true, false, true>(X.lds, g, S, E);
        }
        SEAM(pb + 4);
        if (EN(8) && IN(pb + 5)) {
            SITE_PTRS();
            pg8::Gemm g{(const bf16_t*)(ws + WS_MRG), (const bf16_t*)(ws + WS_WOUT) + (size_t)l * 1024 * 1024, 1024};
            EpiResid E{l == 0 ? p.x : p.out, l == 0 ? p.ctx : (const float*)(ws + WS_CTX), p.out, (float*)(ws + WS_CTX), mod + (size_t)l * 9 * 6144 + 2048, (bf16_t*)(ws + WS_OPSLAB)};
            if constexpr (l == 0) { OpOrder S; S.t.init(128, 4, X.G, X.c, 1, 0); S.G = X.G; S.c = X.c; pg8::gemm_phase<EpiResid, OpOrder, true, false, false, true>(X.lds, g, S, E); }
            else { TileOrder S; S.init(128, 4, X.G, X.c, 1, 0); pg8::gemm_phase<EpiResid, TileOrder>(X.lds, g, S, E); }
        }
        SEAM(pb + 5);
        if (EN(9) && IN(pb + 6)) { __syncthreads(); FRESH(); if (l == 0) norm_phase(p, X, 0, 1, false, 6); else { norm2_router_phase(p, X); __syncthreads(); conv_phase<1>(p, X); if (NREP(9) == 2) { __syncthreads(); conv_phase<1>(p, X); } } }
        SEAM(pb + 6);
        if constexpr (l == 0) {
            if (EN(10) && IN(8)) {
                SITE_PTRS();
                pg8::Gemm g{Hb, (const bf16_t*)(ws + WS_WGU), 1024}; TileOrder S; S.init(NMT, 22, X.G, X.c, 0, 0); S.reps = NREP(10);
                EpiSwiglu E{(bf16_t*)(ws + WS_HID), DFF};
                pg8::gemm_phase<EpiSwiglu, TileOrder>(X.lds, g, S, E);
            }
            SEAM(8);
            if (EN(11) && IN(9)) {
                SITE_PTRS();
                pg8::Gemm g{(const bf16_t*)(ws + WS_HID), (const bf16_t*)(ws + WS_WDN), DFF}; FdOrder S; S.t.init(128, 4, X.G, X.c, 1, 0); S.G = X.G; S.c = X.c;
                EpiResid E{p.out, (const float*)(ws + WS_CTX), p.out, (float*)(ws + WS_CTX), mod + 5120, (bf16_t*)(ws + WS_SLAB)};
                pg8::gemm_phase<EpiResid, FdOrder, true, false, false, true>(X.lds, g, S, E);
            }
            SEAM(9);
        }
    };
    layer(std::integral_constant<int, 0>{}); layer(std::integral_constant<int, 1>{});
    if (EN(12) && IN(17)) for (int rep = 0; rep < NREP(12); ++rep) { __syncthreads(); FRESH(); moe_scatter_phase(p, X); }
    SEAM(17);
    {
        LAS int* tab = (LAS int*)(X.lds + LDS_MISC + 1024);
        if (EN(13) && IN(18)) for (int rep = 0; rep < NREP(13); ++rep) {
            SITE_PTRS();
            __syncthreads(); moe_order_setup(p, X, 0, 16, 28, tab);
            pg8::Gemm g{(const bf16_t*)(ws + WS_XS), (const bf16_t*)(ws + WS_WMGU), 512};
            MoeOrder S{tab, 16, 28, X.G, X.c, 0};
            EpiSwigluT<true> E{(bf16_t*)(ws + WS_HS), DFFE};
            pg8::gemm_phase<EpiSwigluT<true>, MoeOrder, true, true>(X.lds, g, S, E);
        }
        SEAM(18);
        if (EN(14) && IN(19)) {
            SITE_PTRS();
            __syncthreads(); moe_order_setup(p, X, 0, 16, 4, tab);
            pg8::Gemm g{(const bf16_t*)(ws + WS_HS), (const bf16_t*)(ws + WS_WMDN), DFFE / 2};
            MoeOrder S{tab, 16, 4, X.G, X.c, 0, 1};
            EpiMoeDown E{(const int*)(ws + WS_TOK), (const float*)(ws + WS_WROW), (bf16_t*)(ws + WS_Y0), (bf16_t*)(ws + WS_Y1), (bf16_t*)(ws + WS_DSLAB)};
            pg8::gemm_phase<EpiMoeDown, MoeOrder, true, true, false, true>(X.lds, g, S, E);
        }
        SEAM(19);
    }
    if (EN(15) && IN(20)) { FRESH(); final_phase(p, X); if (TP_HIT(20)) { const long long d_ = wall_clock64() - tp0; TP_SPIN(d_); } }
#undef IN
#undef SEAM
#undef TP_WRAP
#undef TP_SPIN
}

extern "C" void kernel_launch(void* const* d_in, const int* in_sizes, int n_in, void* d_out, int out_size, void* d_ws, size_t ws_size, hipStream_t stream) {
    static int grid = 0;
    if (grid == 0) {
        if (n_in != 26 || ws_size < WS_END) { fprintf(stderr, "kernel_launch: unexpected n_in %d / ws_size %zu (need %zu)\n", n_in, ws_size, (size_t)WS_END); grid = -1; return; }
        int dev = 0, cus = 0;
        if (hipGetDevice(&dev) != hipSuccess || hipDeviceGetAttribute(&cus, hipDeviceAttributeMultiprocessorCount, dev) != hipSuccess) { grid = -1; return; }
        if (hipFuncSetAttribute((const void*)mega, hipFuncAttributeMaxDynamicSharedMemorySize, LDS_BYTES) != hipSuccess) { fprintf(stderr, "kernel_launch: hipFuncSetAttribute failed\n"); grid = -1; return; }
        int per_cu = 0;
        if (hipOccupancyMaxActiveBlocksPerMultiprocessor(&per_cu, (const void*)mega, 512, LDS_BYTES) != hipSuccess || per_cu < 1) fprintf(stderr, "kernel_launch: occupancy query reports %d\n", per_cu);
        (void)hipGetLastError();
        grid = cus < 256 ? cus : 256;
    }
    if (grid < 0) return;
    (void)hipMemsetAsync((char*)d_ws + WS_CTL, 0, CTL_ZERO_BYTES, stream);
    Params p{};
    const float** pp = (const float**)&p;
    for (int i = 0; i < 26; ++i) pp[i] = (const float*)d_in[i];
    p.out = (float*)d_out; p.ws = (unsigned char*)d_ws;
#if MK_SPLIT
    for (int k = 0; k < NPHASE; ++k) { if (k == 16) {} p.lo = k; p.hi = k + 1; hipLaunchKernelGGL(mega, dim3(grid), dim3(512), LDS_BYTES, stream, p); }
#else
    p.lo = 0; p.hi = NPHASE;
    hipLaunchKernelGGL(mega, dim3(grid), dim3(512), LDS_BYTES, stream, p);
#endif
}
```
